# Optimizing an MI355X kernel written in HIP

```python
import jax
import jax.numpy as jnp
from jax import lax
import numpy as np

D_MODEL = 1024
BATCH = 16
SEQ = 4096
DEPTH = 4

HEAD_DIM = 64
N_HEADS_A = 8
N_HEADS_B = 8
WIDTH_A = N_HEADS_A * HEAD_DIM
WIDTH_B = N_HEADS_B * HEAD_DIM
DILATED_CONFIGS = ((128, 1), (512, 4), (2048, 16))
SEG = 128
Q_BLOCK = 128
RET_HEADS = 4
RET_QK_DIM = D_MODEL // RET_HEADS
RET_V_DIM = 2 * D_MODEL // RET_HEADS
RET_CHUNK = 128
MLP_HIDDEN = 4 * D_MODEL
RMS_EPS = 1e-6
GN_EPS = 1e-6
EVEN_IN = 3 * WIDTH_A + 3 * WIDTH_B + N_HEADS_B
ODD_IN = 6 * D_MODEL
N_EVEN = (DEPTH + 1) // 2
N_ODD = DEPTH // 2

kernel_name = "hybrid_dilated_fox_retention_trunk"


def _rms_norm(x, g):
    xf = x.astype(jnp.float32)
    y = xf * lax.rsqrt(jnp.mean(xf * xf, axis=-1, keepdims=True) + RMS_EPS)
    return (y * g.astype(jnp.float32)).astype(x.dtype)


def _split_heads(t, n):
    b, s, _ = t.shape
    return t.reshape(b, s, n, -1).transpose(0, 2, 1, 3)


def _merge_heads(t):
    b, h, s, e = t.shape
    return t.transpose(0, 2, 1, 3).reshape(b, s, h * e)


def _alibi_slopes(n):
    return 2.0 ** (-8.0 * (jnp.arange(n, dtype=jnp.float32) + 1.0) / n)


def _retention_gammas(n):
    return 1.0 - 2.0 ** (-5.0 - jnp.arange(n, dtype=jnp.float32))


def _to_streams(t, dilation, padded_len):
    b, h, s, e = t.shape
    t = jnp.pad(t, ((0, 0), (0, 0), (0, padded_len - s), (0, 0)))
    t = t.reshape(b, h, padded_len // dilation, dilation, e)
    t = jnp.swapaxes(t, 2, 3)
    return t.reshape(b, h, dilation, padded_len // (dilation * SEG), SEG, e)


def _from_streams(t, s):
    b, h, d, n, _, e = t.shape
    t = t.reshape(b, h, d, n * SEG, e)
    t = jnp.swapaxes(t, 2, 3).reshape(b, h, d * n * SEG, e)
    return t[:, :, :s]


def _dilated_branch(q, k, v, slopes, window, dilation):
    b, h, s, dh = q.shape
    n_steps = window // dilation
    span = dilation * SEG
    padded = -(-s // span) * span
    qs = _to_streams(q, dilation, padded)
    ks = _to_streams(k, dilation, padded)
    vs = _to_streams(v, dilation, padded)
    n_blk = qs.shape[3]
    prev_pad = ((0, 0), (0, 0), (0, 0), (1, 0), (0, 0), (0, 0))
    kk = jnp.concatenate([jnp.pad(ks, prev_pad)[:, :, :, :-1], ks], axis=4)
    vv = jnp.concatenate([jnp.pad(vs, prev_pad)[:, :, :, :-1], vs], axis=4)
    scores = jnp.einsum("bhrnqe,bhrnke->bhrnqk", qs, kk,
                        preferred_element_type=jnp.float32) * (dh ** -0.5)
    qi = jnp.arange(SEG)[:, None]
    ki = jnp.arange(2 * SEG)[None, :]
    steps = qi + SEG - ki
    band = (steps >= 0) & (steps <= n_steps)
    has_prev = (jnp.arange(n_blk) > 0)[:, None, None] | (ki >= SEG)[None]
    valid = band[None] & has_prev
    dist = (steps * dilation).astype(jnp.float32)
    logits = scores - slopes[None, :, None, None, None, None] * dist
    logits = jnp.where(valid, logits, -jnp.inf)
    m = jnp.max(logits, axis=-1, keepdims=True)
    p = jnp.exp(logits - m)
    den = jnp.sum(p, axis=-1, keepdims=True)
    o = jnp.einsum("bhrnqk,bhrnke->bhrnqe", p, vv.astype(jnp.float32)) / den
    lse = m + jnp.log(den)
    return _from_streams(o, s), _from_streams(lse, s)[..., 0]


def _dilated_attention(q, k, v, slopes):
    outs, lses = [], []
    for window, dilation in DILATED_CONFIGS:
        o, l = _dilated_branch(q, k, v, slopes, window, dilation)
        outs.append(o)
        lses.append(l)
    w = jax.nn.softmax(jnp.stack(lses, axis=0), axis=0)
    return jnp.einsum("gbhs,gbhse->bhse", w, jnp.stack(outs, axis=0))


def _forgetting_attention(q, k, v, log_f):
    b, h, s, dh = q.shape
    c = jnp.cumsum(log_f, axis=-1)
    nb = s // Q_BLOCK
    qb = q.reshape(b, h, nb, Q_BLOCK, dh).transpose(2, 0, 1, 3, 4)
    cb = c.reshape(b, h, nb, Q_BLOCK).transpose(2, 0, 1, 3)
    kpos = jnp.arange(s)
    vf = v.astype(jnp.float32)

    def block(args):
        i, q_i, c_i = args
        sc = jnp.einsum("bhqe,bhke->bhqk", q_i, k,
                        preferred_element_type=jnp.float32) * (dh ** -0.5)
        sc = sc + c_i[..., None] - c[:, :, None, :]
        qpos = i * Q_BLOCK + jnp.arange(Q_BLOCK)
        sc = jnp.where(kpos[None, :] <= qpos[:, None], sc, -jnp.inf)
        p = jax.nn.softmax(sc, axis=-1)
        return jnp.einsum("bhqk,bhke->bhqe", p, vf)

    o = lax.map(block, (jnp.arange(nb), qb, cb))
    return o.transpose(1, 2, 0, 3, 4).reshape(b, h, s, dh)


def _retention(q, k, v, gammas):
    b, h, s, dk = q.shape
    dv = v.shape[-1]
    C = RET_CHUNK
    n = s // C
    q = q.astype(jnp.float32)
    k = k.astype(jnp.float32) * (dk ** -0.5)
    v = v.astype(jnp.float32)
    log_g = jnp.log(gammas)
    idx = jnp.arange(C, dtype=jnp.float32)
    rel = idx[:, None] - idx[None, :]
    decay_in = jnp.where(rel >= 0, jnp.exp(log_g[:, None, None] * jnp.maximum(rel, 0.0)), 0.0)
    q_dec = jnp.exp(log_g[:, None] * (idx + 1.0))[None, :, :, None]
    k_dec = jnp.exp(log_g[:, None] * (C - 1.0 - idx))[None, :, :, None]
    chunk_dec = jnp.exp(log_g * C)[None, :, None, None]

    def chunks(t):
        return t.reshape(b, h, n, C, t.shape[-1]).transpose(2, 0, 1, 3, 4)

    def step(state, inp):
        q_i, k_i, v_i = inp
        inner = jnp.einsum("bhqd,bhkd->bhqk", q_i, k_i) * decay_in
        o = (jnp.einsum("bhqk,bhkv->bhqv", inner, v_i)
             + jnp.einsum("bhqd,bhdv->bhqv", q_i, state) * q_dec)
        state = chunk_dec * state + jnp.einsum("bhkd,bhkv->bhdv", k_i * k_dec, v_i)
        return state, o

    state0 = jnp.zeros((b, h, dk, dv), jnp.float32)
    _, o = lax.scan(step, state0, (chunks(q), chunks(k), chunks(v)))
    return o.transpose(1, 2, 0, 3, 4).reshape(b, h, s, dv)


def _even_mixer(h, w_in, b_f, w_out, slopes):
    proj = h @ w_in
    cuts = [WIDTH_A, 2 * WIDTH_A, 3 * WIDTH_A,
            3 * WIDTH_A + WIDTH_B, 3 * WIDTH_A + 2 * WIDTH_B, 3 * WIDTH_A + 3 * WIDTH_B]
    qa, ka, va, qb, kb, vb, f_logit = jnp.split(proj, cuts, axis=-1)
    oa = _dilated_attention(_split_heads(qa, N_HEADS_A), _split_heads(ka, N_HEADS_A),
                            _split_heads(va, N_HEADS_A), slopes)
    log_f = jax.nn.log_sigmoid(f_logit.astype(jnp.float32) + b_f.astype(jnp.float32))
    ob = _forgetting_attention(_split_heads(qb, N_HEADS_B), _split_heads(kb, N_HEADS_B),
                               _split_heads(vb, N_HEADS_B), jnp.swapaxes(log_f, 1, 2))
    o = jnp.concatenate([_merge_heads(oa), _merge_heads(ob)], axis=-1).astype(h.dtype)
    return o @ w_out


def _odd_mixer(h, w_in, w_out, gammas):
    proj = h @ w_in
    q, k, v, g = jnp.split(proj, [D_MODEL, 2 * D_MODEL, 4 * D_MODEL], axis=-1)
    o = _retention(_split_heads(q, RET_HEADS), _split_heads(k, RET_HEADS),
                   _split_heads(v, RET_HEADS), gammas)
    mu = jnp.mean(o, axis=-1, keepdims=True)
    var = jnp.mean(jnp.square(o - mu), axis=-1, keepdims=True)
    o = _merge_heads((o - mu) * lax.rsqrt(var + GN_EPS))
    y = (jax.nn.silu(g.astype(jnp.float32)) * o).astype(h.dtype)
    return y @ w_out


def _squared_relu_mlp(h, w1, w2):
    return jnp.square(jax.nn.relu(h @ w1)) @ w2


def setup_inputs(seed: int = 0) -> dict:
    key = jax.random.key(seed)
    ks = jax.random.split(key, 12)
    f32 = jnp.float32
    out_scale = (2.0 * DEPTH) ** -0.5

    def dense(k, shape, fan_in, scale=1.0):
        return jax.random.normal(k, shape, f32) * (scale * fan_in ** -0.5)

    return {
        "x": jax.random.normal(ks[0], (BATCH, SEQ, D_MODEL), f32),
        "norm_mix_g": 1.0 + 0.02 * jax.random.normal(ks[1], (DEPTH, D_MODEL), f32),
        "norm_ffn_g": 1.0 + 0.02 * jax.random.normal(ks[2], (DEPTH, D_MODEL), f32),
        "even_w_in": dense(ks[3], (N_EVEN, D_MODEL, EVEN_IN), D_MODEL),
        "even_b_f": 2.0 + 0.5 * jax.random.normal(ks[4], (N_EVEN, N_HEADS_B), f32),
        "even_w_out": dense(ks[5], (N_EVEN, WIDTH_A + WIDTH_B, D_MODEL), WIDTH_A + WIDTH_B, out_scale),
        "odd_w_in": dense(ks[6], (N_ODD, D_MODEL, ODD_IN), D_MODEL),
        "odd_w_out": dense(ks[7], (N_ODD, 2 * D_MODEL, D_MODEL), 2 * D_MODEL, out_scale),
        "ffn_w_in": dense(ks[8], (DEPTH, D_MODEL, MLP_HIDDEN), D_MODEL),
        "ffn_w_out": dense(ks[9], (DEPTH, MLP_HIDDEN, D_MODEL), MLP_HIDDEN, out_scale),
        "final_g": 1.0 + 0.02 * jax.random.normal(ks[10], (D_MODEL,), f32),
    }


def reference(x, norm_mix_g, norm_ffn_g, even_w_in, even_b_f, even_w_out,
              odd_w_in, odd_w_out, ffn_w_in, ffn_w_out, final_g):
    slopes = _alibi_slopes(N_HEADS_A)
    gammas = _retention_gammas(RET_HEADS)
    for layer in range(DEPTH):
        h = _rms_norm(x, norm_mix_g[layer])
        if layer % 2 == 0:
            i = layer // 2
            x = x + _even_mixer(h, even_w_in[i], even_b_f[i], even_w_out[i], slopes)
        else:
            i = layer // 2
            x = x + _odd_mixer(h, odd_w_in[i], odd_w_out[i], gammas)
        h = _rms_norm(x, norm_ffn_g[layer])
        x = x + _squared_relu_mlp(h, ffn_w_in[layer], ffn_w_out[layer])
    return _rms_norm(x, final_g)
```

```cpp
#include <hip/hip_runtime.h>
#include <cstdio>
#include <cstdint>
namespace pg8 {
#define PG8_LAS __attribute__((address_space(3)))
typedef unsigned short bf16_t;
typedef short bf16x8 __attribute__((ext_vector_type(8)));
typedef float f32x4 __attribute__((ext_vector_type(4)));
typedef unsigned u32x4 __attribute__((ext_vector_type(4)));
constexpr int BM = 256, BK = 64, HALF = 128, HTB = HALF * BK * 2  , STAGE_BYTES = 8 * HTB, NXCD = 8, WGM = 8;

__host__ __device__ __forceinline__ int lds_byte(int r, int c) { const int st = (r >> 4) * 2 + (c >> 5), rr = r & 15, cc = c & 31, ob = rr * 64 + cc * 2; return st * 1024 + (ob ^ (((ob >> 9) & 1) << 5)); }
__host__ __device__ __forceinline__ void stage_rc(int b, int& R, int& C) { const int st = b / 1024, sb = b % 1024, swz = sb ^ (((sb >> 9) & 1) << 5); R = (st >> 1) * 16 + swz / 64; C = (st & 1) * 32 + (swz % 64) / 2; }
__host__ __device__ __forceinline__ int perm32(int rho) { const int n = rho >> 4, i = rho & 15; return 8 * (i >> 2) + 4 * n + (i & 3); }

struct Unit { int pm, pn; };
struct Gemm { const bf16_t* A; const bf16_t* Bt; int M, N, K; };

struct StaticOrder {
    int nM, nN, nwg, G, c;
    __host__ __device__ void init(int M, int N, int G_, int c_) { nM = M / BM; nN = N / BM; nwg = nM * nN; G = G_; c = c_; }
    __host__ __device__ bool next(int i, Unit& u) const {
        const long L = (long)i * G + c; if (L >= nwg) return false;
        int wgid = (int)L; { const int q = nwg / NXCD, r = nwg % NXCD, xcd = wgid % NXCD, off = wgid / NXCD; wgid = (xcd < r ? xcd * (q + 1) : r * (q + 1) + (xcd - r) * q) + off; }
        const int nig = WGM * nN, gid = wgid / nig, fm = gid * WGM, gsz = (nM - fm) < WGM ? (nM - fm) : WGM;
        u.pm = fm + ((wgid % nig) % gsz); u.pn = (wgid % nig) / gsz; return true;
    }
    __device__ __forceinline__ void a_ready(const Unit&) const {}
    __device__ __forceinline__ void done(const Unit&) const {}
};

__device__ __forceinline__ unsigned cvt_pk_bf16(float lo, float hi) { unsigned r; asm volatile("v_cvt_pk_bf16_f32 %0, %1, %2" : "=v"(r) : "v"(lo), "v"(hi)); return r; }
typedef float f32x2 __attribute__((ext_vector_type(2)));
__device__ __forceinline__ f32x2 gelu_pk(f32x2 v) {
    const f32x2 av = __builtin_elementwise_abs(v), d = av * 0.2316418882f + 1.0f;
    f32x2 t; t.x = __builtin_amdgcn_rcpf(d.x); t.y = __builtin_amdgcn_rcpf(d.y);
    f32x2 q = t * 0.5307027145f + (-0.7265760135f); q = q * t + 0.7107068705f; q = q * t + (-0.142248368f); q = q * t + 0.127414796f; q = q * t;
    const f32x2 s = (v * v) * (-0.72134752044f);
    f32x2 e; e.x = __builtin_amdgcn_exp2f(s.x); e.y = __builtin_amdgcn_exp2f(s.y);
    const f32x2 m = v * (q * e), r = v - m;
    f32x2 o; o.x = v.x < 0.f ? m.x : r.x; o.y = v.y < 0.f ? m.y : r.y; return o;
}

template <int ACT  > struct EpiBf16 {
    static constexpr bool PERM = true, AFTER_DRAIN = false; static_assert(ACT == 0 || ACT == 1, "EpiBf16: ACT is 0 (none) or 1 (gelu_pk)");
    bf16_t* O; int ldc; const float* bias; int split_cols; size_t split_stride; float scale0;
    __device__ __forceinline__ void operator()(const f32x4 (&acc)[2][2][4][2], const Unit& u, int wr, int wc, int fr, int fq) const {
        const int row0 = u.pm * BM + wr * 64 + fr; int colt = u.pn * BM; bf16_t* base = O;
        float sc = 1.f; if (split_cols) { const int t = colt / split_cols; base += (size_t)t * split_stride; colt -= t * split_cols; if (t == 0) sc = scale0; }
        const int col0 = colt + wc * 32 + 8 * fq, bcol0 = u.pn * BM + wc * 32 + 8 * fq;
        f32x4 bv[2][2];
#pragma unroll
        for (int bj = 0; bj < 2; ++bj)
#pragma unroll
            for (int n = 0; n < 2; ++n) bv[bj][n] = bias ? *(const f32x4*)(bias + bcol0 + bj * HALF + 4 * n) : (f32x4){0.f, 0.f, 0.f, 0.f};
#pragma unroll
        for (int ai = 0; ai < 2; ++ai)
#pragma unroll
            for (int m = 0; m < 4; ++m) { bf16_t* rowp = base + (size_t)(row0 + ai * HALF + m * 16) * ldc + col0;
#pragma unroll
                for (int bj = 0; bj < 2; ++bj) { f32x4 v0 = acc[ai][bj][m][0] + bv[bj][0], v1 = acc[ai][bj][m][1] + bv[bj][1];
                    if (ACT == 1) { f32x2 a = gelu_pk((f32x2){v0[0], v0[1]}), b = gelu_pk((f32x2){v0[2], v0[3]}), c = gelu_pk((f32x2){v1[0], v1[1]}), d = gelu_pk((f32x2){v1[2], v1[3]});
                        v0 = (f32x4){a.x, a.y, b.x, b.y}; v1 = (f32x4){c.x, c.y, d.x, d.y}; }
                    v0 = v0 * sc; v1 = v1 * sc; u32x4 w; w.x = cvt_pk_bf16(v0[0], v0[1]); w.y = cvt_pk_bf16(v0[2], v0[3]); w.z = cvt_pk_bf16(v1[0], v1[1]); w.w = cvt_pk_bf16(v1[2], v1[3]);
                    *(u32x4*)(rowp + bj * HALF) = w; } }
    }
};

struct PanelStats {
    unsigned* xbuf;
    unsigned* cnt;
    unsigned* tmo;
    int ntn; float eps;
    unsigned code;
    __device__ __forceinline__ bool run(const f32x4 (&v)[2][2][4][2], const Unit& u, int wr, int wc, int fr, int fq, PG8_LAS unsigned char* lds, int wid, int lane) const {
        typedef float f32x2v __attribute__((ext_vector_type(2)));
        PG8_LAS f32x2v* P = (PG8_LAS f32x2v*)lds;
        PG8_LAS f32x2v* S = (PG8_LAS f32x2v*)(lds + 8192);
        PG8_LAS unsigned* flag = (PG8_LAS unsigned*)(lds + 8192 + 2048);
#pragma unroll
        for (int ai = 0; ai < 2; ++ai)
#pragma unroll
            for (int m = 0; m < 4; ++m) {
                float s = 0.f;
#pragma unroll
                for (int bj = 0; bj < 2; ++bj)
#pragma unroll
                    for (int n = 0; n < 2; ++n) { const f32x4 x = v[ai][bj][m][n]; s += (x[0] + x[1]) + (x[2] + x[3]); }
                s += __shfl_xor(s, 16); s += __shfl_xor(s, 32);
                const float mw = s * (1.0f / 64.0f); float q = 0.f;
#pragma unroll
                for (int bj = 0; bj < 2; ++bj)
#pragma unroll
                    for (int n = 0; n < 2; ++n) { const f32x4 d = v[ai][bj][m][n] - mw; q += (d[0] * d[0] + d[1] * d[1]) + (d[2] * d[2] + d[3] * d[3]); }
                q += __shfl_xor(q, 16); q += __shfl_xor(q, 32);
                if (fq == 0) P[(ai * HALF + wr * 64 + m * 16 + fr) * 4 + wc] = (f32x2v){mw, q};
            }
        asm volatile("s_waitcnt lgkmcnt(0)" ::: "memory"); __builtin_amdgcn_s_barrier(); asm volatile("" ::: "memory");
#if defined(BROKEN_EXCHANGE_NO_WAIT)
#warning BROKEN CONTROL BUILD: the row-statistics exchange does not wait; results are wrong by design
        if (blockIdx.x >= 64) { const long long t0_ = clock64(); while (clock64() - t0_ < 60000) __builtin_amdgcn_s_sleep(8); }
#endif
        const int row = wid * 32 + (lane & 31);
        if (lane < 32) {
            const f32x2v a = P[row * 4 + 0], b = P[row * 4 + 1], c = P[row * 4 + 2], d = P[row * 4 + 3];
            const float mt = (a.x + b.x + c.x + d.x) * 0.25f;
            const float da = a.x - mt, db = b.x - mt, dc = c.x - mt, dd = d.x - mt;
            const float m2 = (a.y + b.y) + (c.y + d.y) + 64.0f * ((da * da + db * db) + (dc * dc + dd * dd));
            unsigned long long* slot = (unsigned long long*)xbuf + ((size_t)(u.pm * BM + row) * 4 + u.pn);
            __hip_atomic_store(slot, ((unsigned long long)__float_as_uint(m2) << 32) | __float_as_uint(mt), __ATOMIC_RELAXED, __HIP_MEMORY_SCOPE_AGENT);
        }
        asm volatile("s_waitcnt vmcnt(0)" ::: "memory");
        if (lane == 0) __hip_atomic_fetch_add(cnt + 64 * u.pm, 1u, __ATOMIC_RELAXED, __HIP_MEMORY_SCOPE_AGENT);
        if (wid == 0) {
            bool dead = false; const unsigned long long t0 = __builtin_amdgcn_s_memrealtime(); const unsigned want = 8u * (unsigned)ntn;
            for (;;) {
#if defined(BROKEN_EXCHANGE_NO_WAIT)
                break;
#endif
                if ((unsigned)__builtin_amdgcn_readfirstlane(__hip_atomic_load(cnt + 64 * u.pm, __ATOMIC_RELAXED, __HIP_MEMORY_SCOPE_AGENT)) >= want) break;
                if (__builtin_amdgcn_s_memrealtime() - t0 > 2000000ull) {
                    if (lane == 0) { unsigned expect = 0u; __hip_atomic_compare_exchange_strong(tmo + 1, &expect, code | (unsigned)(u.pm & 0xff), __ATOMIC_RELAXED, __ATOMIC_RELAXED, __HIP_MEMORY_SCOPE_AGENT);
                                     __hip_atomic_store(tmo, 1u, __ATOMIC_RELAXED, __HIP_MEMORY_SCOPE_AGENT); }
                    dead = true; break; }
                __builtin_amdgcn_s_sleep(2);
            }
            __builtin_amdgcn_fence(__ATOMIC_ACQUIRE, "agent");
            if (lane == 0) flag[0] = dead ? 1u : 0u;
        }
        asm volatile("s_waitcnt vmcnt(0) lgkmcnt(0)" ::: "memory"); __builtin_amdgcn_s_barrier(); asm volatile("" ::: "memory");
        const bool bad = flag[0] != 0u;
        if (lane < 32) {
            const unsigned long long* slot = (const unsigned long long*)xbuf + (size_t)(u.pm * BM + row) * 4; float mt[4], m2[4]; float ms = 0.f;
#pragma unroll
            for (int t = 0; t < 4; ++t) { if (t < ntn) { const unsigned long long w = __hip_atomic_load(slot + t, __ATOMIC_RELAXED, __HIP_MEMORY_SCOPE_AGENT); mt[t] = __uint_as_float((unsigned)w); m2[t] = __uint_as_float((unsigned)(w >> 32)); } else { mt[t] = 0.f; m2[t] = 0.f; } ms += mt[t]; }
            const float mean = ms / (float)ntn; float q = 0.f;
#pragma unroll
            for (int t = 0; t < 4; ++t) if (t < ntn) { const float dm = mt[t] - mean; q += m2[t] + 256.0f * dm * dm; }
            S[row] = (f32x2v){mean, 1.0f / sqrtf(q / (256.0f * (float)ntn) + eps)};
        }
        asm volatile("s_waitcnt lgkmcnt(0)" ::: "memory"); __builtin_amdgcn_s_barrier(); asm volatile("" ::: "memory");
        return bad;
    }
};
struct EpiLnRes {
    static constexpr bool PERM = false, AFTER_DRAIN = true;
    const float* base; float* out; int ldc; const float* bias; PanelStats st; unsigned poison;
    __device__ __forceinline__ void fused(f32x4 (&acc)[2][2][4][2], const Unit& u, int wr, int wc, int fr, int fq, PG8_LAS unsigned char* lds, int wid, int lane) const {
        typedef float f32x2v __attribute__((ext_vector_type(2)));
        const PG8_LAS f32x2v* S = (const PG8_LAS f32x2v*)(lds + 8192);
        const int col0 = u.pn * BM + wc * 32 + 4 * fq;
#pragma unroll
        for (int bj = 0; bj < 2; ++bj)
#pragma unroll
            for (int n = 0; n < 2; ++n) { const f32x4 bv = bias ? *(const f32x4*)(bias + col0 + bj * HALF + n * 16) : (f32x4){0.f, 0.f, 0.f, 0.f};
#pragma unroll
                for (int ai = 0; ai < 2; ++ai)
#pragma unroll
                    for (int m = 0; m < 4; ++m) acc[ai][bj][m][n] += bv; }
        f32x4 pre[4][2][2];
#pragma unroll
        for (int m = 0; m < 4; ++m) { const size_t off = (size_t)(u.pm * BM + wr * 64 + m * 16 + fr) * ldc + col0;
#pragma unroll
            for (int bj = 0; bj < 2; ++bj)
#pragma unroll
                for (int n = 0; n < 2; ++n) pre[m][bj][n] = *(const f32x4*)(base + off + bj * HALF + n * 16); }
        const bool bad = st.run(acc, u, wr, wc, fr, fq, lds, wid, lane) || poison != 0u;
        const float qnan = __builtin_nanf("");
#pragma unroll
        for (int ai = 0; ai < 2; ++ai)
#pragma unroll
            for (int m = 0; m < 4; ++m) { const int r = ai * HALF + wr * 64 + m * 16 + fr; const f32x2v sr = S[r]; const size_t off = (size_t)(u.pm * BM + r) * ldc + col0;
#pragma unroll
                for (int bj = 0; bj < 2; ++bj)
#pragma unroll
                    for (int n = 0; n < 2; ++n) { const f32x4 bs = ai == 0 ? pre[m][bj][n] : *(const f32x4*)(base + off + bj * HALF + n * 16); f32x4 o = bs + (acc[ai][bj][m][n] - sr.x) * sr.y;
                        if (bad) o = (f32x4){qnan, qnan, qnan, qnan}; *(f32x4*)(out + off + bj * HALF + n * 16) = o; }
                if (m & 1) asm volatile("" ::: "memory"); }
    }
};
struct EpiLnResLn {
    static constexpr bool PERM = false, AFTER_DRAIN = true;
    const float* base; float* out; bf16_t* xn; int ldc; const float* bias; PanelStats st1, st2; unsigned poison;
    __device__ __forceinline__ void fused(f32x4 (&acc)[2][2][4][2], const Unit& u, int wr, int wc, int fr, int fq, PG8_LAS unsigned char* lds, int wid, int lane) const {
        typedef float f32x2v __attribute__((ext_vector_type(2))); typedef unsigned u32x2v __attribute__((ext_vector_type(2)));
        const PG8_LAS f32x2v* S = (const PG8_LAS f32x2v*)(lds + 8192);
        const int col0 = u.pn * BM + wc * 32 + 4 * fq;
#pragma unroll
        for (int bj = 0; bj < 2; ++bj)
#pragma unroll
            for (int n = 0; n < 2; ++n) { const f32x4 bv = bias ? *(const f32x4*)(bias + col0 + bj * HALF + n * 16) : (f32x4){0.f, 0.f, 0.f, 0.f};
#pragma unroll
                for (int ai = 0; ai < 2; ++ai)
#pragma unroll
                    for (int m = 0; m < 4; ++m) acc[ai][bj][m][n] += bv; }
        bool bad = st1.run(acc, u, wr, wc, fr, fq, lds, wid, lane) || poison != 0u;
        const float qnan = __builtin_nanf("");
#pragma unroll
        for (int ai = 0; ai < 2; ++ai)
#pragma unroll
            for (int m = 0; m < 4; ++m) { const int r = ai * HALF + wr * 64 + m * 16 + fr; const f32x2v sr = S[r]; const size_t off = (size_t)(u.pm * BM + r) * ldc + col0;
#pragma unroll
                for (int bj = 0; bj < 2; ++bj)
#pragma unroll
                    for (int n = 0; n < 2; ++n) { const f32x4 bs = *(const f32x4*)(base + off + bj * HALF + n * 16); acc[ai][bj][m][n] = bs + (acc[ai][bj][m][n] - sr.x) * sr.y; }
                asm volatile("" : "+v"(acc[ai][0][m][0]), "+v"(acc[ai][0][m][1]), "+v"(acc[ai][1][m][0]), "+v"(acc[ai][1][m][1]));
                if (m & 1) asm volatile("" ::: "memory"); }
        const bool bad1 = bad;
        bad = st2.run(acc, u, wr, wc, fr, fq, lds, wid, lane) || bad;
#pragma unroll
        for (int ai = 0; ai < 2; ++ai)
#pragma unroll
            for (int m = 0; m < 4; ++m) { const int r = ai * HALF + wr * 64 + m * 16 + fr; const f32x2v sr = S[r]; const size_t off = (size_t)(u.pm * BM + r) * ldc + col0;
#pragma unroll
                for (int bj = 0; bj < 2; ++bj)
#pragma unroll
                    for (int n = 0; n < 2; ++n) { const f32x4 x1 = acc[ai][bj][m][n]; *(f32x4*)(out + off + bj * HALF + n * 16) = bad1 ? (f32x4){qnan, qnan, qnan, qnan} : x1;
                        const f32x4 o = (x1 - sr.x) * sr.y; u32x2v w; w.x = cvt_pk_bf16(o[0], o[1]); w.y = cvt_pk_bf16(o[2], o[3]);
                        if (bad) { w.x = 0x7fc07fc0u; w.y = 0x7fc07fc0u; } *(u32x2v*)(xn + off + bj * HALF + n * 16) = w; }
                asm volatile("" ::: "memory"); }
    }
};

template <class Epi, class Sched, bool ALIGN_EPI = false, bool SP2 = false>
__device__ __forceinline__ void gemm_phase(PG8_LAS unsigned char* lds, const Gemm g, const Sched& S, const Epi& E) {
#ifdef NO_GEMM
    return;
#endif
    int tid_l = threadIdx.x; asm volatile("" : "+v"(tid_l));
    const int tid = tid_l, wid = __builtin_amdgcn_readfirstlane(tid >> 6), lane = tid & 63, wr = wid >> 2, wc = wid & 3, fr = lane & 15, fq = lane >> 4;
    const int K = g.K, nt = K / BK;
    unsigned voffA[2], voffB[2];
#pragma unroll
    for (int i = 0; i < 2; ++i) { int R, C; stage_rc(tid * 16 + i * 8192, R, C); const int Rb = Epi::PERM ? ((R & ~31) + perm32(R & 31)) : R;
        voffA[i] = (unsigned)(R * K + C) * 2u; voffB[i] = (unsigned)(Rb * K + C) * 2u; }
    const size_t kstep = (size_t)(BK * 2);
    const size_t hstep = (size_t)HALF * K * 2;
    const size_t tstep = 2 * hstep;
    const unsigned ldsw = (unsigned)wid * 1024u;
    const int aoff = lds_byte(wr * 64 + fr, fq * 8), boff = lds_byte(wc * 32 + fr, fq * 8);
#define PG8_SA(b, h) (((b) * 2 + (h)) * HTB)
#define PG8_SB(b, h) ((4 + (b) * 2 + (h)) * HTB)
#define PG8_STAGE(bufoff, gbase, voff) do { _Pragma("unroll") for (int _i = 0; _i < 2; ++_i) \
        __builtin_amdgcn_global_load_lds((const unsigned*)((const char*)(gbase) + (voff)[_i]), (PG8_LAS unsigned*)(lds + (bufoff) + ldsw + _i * 8192), 16, 0, 0); } while (0)
#define PG8_LDA(dst, b, h) do { _Pragma("unroll") for (int m = 0; m < 4; ++m) _Pragma("unroll") for (int k = 0; k < 2; ++k) dst[m][k] = *(const PG8_LAS bf16x8*)(lds + PG8_SA(b, h) + aoff + m * 2048 + k * 1024); } while (0)
#define PG8_LDB(dst, b, h) do { _Pragma("unroll") for (int n = 0; n < 2; ++n) _Pragma("unroll") for (int k = 0; k < 2; ++k) dst[n][k] = *(const PG8_LAS bf16x8*)(lds + PG8_SB(b, h) + boff + n * 2048 + k * 1024); } while (0)
#define PG8_MMA(ai, bj, At, Bt) do { __builtin_amdgcn_s_setprio(1); _Pragma("unroll") for (int m = 0; m < 4; ++m) _Pragma("unroll") for (int n = 0; n < 2; ++n) _Pragma("unroll") for (int k = 0; k < 2; ++k) \
        acc[ai][bj][m][n] = __builtin_amdgcn_mfma_f32_16x16x32_bf16(Bt[n][k], At[m][k], acc[ai][bj][m][n], 0, 0, 0); __builtin_amdgcn_s_setprio(0); } while (0)
#define PG8_WAIT_V(n) asm volatile("s_waitcnt vmcnt(" #n ")" ::: "memory")
#define PG8_WAIT_L(n) asm volatile("s_waitcnt lgkmcnt(" #n ")" ::: "memory")
#define PG8_BAR __builtin_amdgcn_s_barrier()
#define PG8_SCHED __builtin_amdgcn_sched_barrier(0)
    Unit cur, nxt; int ui = 0;
    if (!S.next(0, cur)) return;
    f32x4 acc[2][2][4][2];
#pragma unroll
    for (int a = 0; a < 2; ++a)
#pragma unroll
        for (int b = 0; b < 2; ++b)
#pragma unroll
            for (int m = 0; m < 4; ++m)
#pragma unroll
                for (int n = 0; n < 2; ++n) acc[a][b][m][n] = (f32x4){0.f, 0.f, 0.f, 0.f};
    bf16x8 At[4][2], B0[2][2], B1[2][2];
    const char* cA = (const char*)g.A + (size_t)cur.pm * tstep; const char* cB = (const char*)g.Bt + (size_t)cur.pn * tstep;
    S.a_ready(cur);
    if constexpr (SP2) {
        PG8_STAGE(PG8_SB(0, 0), cB, voffB); PG8_STAGE(PG8_SB(0, 1), cB + hstep, voffB); PG8_STAGE(PG8_SA(0, 0), cA, voffA); PG8_STAGE(PG8_SA(0, 1), cA + hstep, voffA);
        if (wr == 1) PG8_BAR;
        PG8_WAIT_V(2); PG8_BAR;
        PG8_STAGE(PG8_SB(1, 0), cB + kstep, voffB); PG8_STAGE(PG8_SA(1, 0), cA + kstep, voffA); PG8_STAGE(PG8_SB(1, 1), cB + hstep + kstep, voffB);
        PG8_WAIT_V(6); PG8_BAR;
    } else {
        PG8_STAGE(PG8_SB(0, 0), cB, voffB); PG8_STAGE(PG8_SA(0, 0), cA, voffA); PG8_STAGE(PG8_SB(0, 1), cB + hstep, voffB); PG8_STAGE(PG8_SA(0, 1), cA + hstep, voffA);
        if (wr == 1) PG8_BAR;
        PG8_WAIT_V(4); PG8_BAR;
        PG8_STAGE(PG8_SB(1, 0), cB + kstep, voffB); PG8_STAGE(PG8_SA(1, 0), cA + kstep, voffA); PG8_STAGE(PG8_SB(1, 1), cB + hstep + kstep, voffB);
        PG8_WAIT_V(6); PG8_BAR;
    }
    for (;;) {
        const bool has_next = S.next(ui + 1, nxt);
        const char* nA = has_next ? (const char*)g.A + (size_t)nxt.pm * tstep : cA; const char* nB = has_next ? (const char*)g.Bt + (size_t)nxt.pn * tstep : cB;
        for (int t = 0; t < nt; t += 2) {
            const bool last = (t == nt - 2);
            const char* a1 = cA + (size_t)(t + 1) * kstep;
            const char* a2 = last ? nA : cA + (size_t)(t + 2) * kstep; const char* b2 = last ? nB : cB + (size_t)(t + 2) * kstep;
            const char* a3 = a2 + kstep; const char* b3 = b2 + kstep;
            if (last && has_next) S.a_ready(nxt);
            if constexpr (SP2) {
            PG8_LDB(B0, 0, 0); PG8_LDB(B1, 0, 1); PG8_SCHED; PG8_LDA(At, 0, 0); PG8_STAGE(PG8_SA(1, 1), a1 + hstep, voffA);
            PG8_WAIT_V(8); PG8_WAIT_L(0); PG8_BAR; PG8_MMA(0, 0, At, B0); PG8_MMA(0, 1, At, B1); PG8_BAR; PG8_SCHED;
            PG8_LDA(At, 0, 1); PG8_STAGE(PG8_SB(0, 0), b2, voffB); PG8_STAGE(PG8_SB(0, 1), b2 + hstep, voffB); PG8_STAGE(PG8_SA(0, 0), a2, voffA);
            PG8_WAIT_V(8); PG8_WAIT_L(0); PG8_BAR; PG8_MMA(1, 0, At, B0); PG8_MMA(1, 1, At, B1); PG8_BAR; PG8_SCHED;
            PG8_LDB(B0, 1, 0); PG8_LDB(B1, 1, 1); PG8_SCHED; PG8_LDA(At, 1, 0); PG8_STAGE(PG8_SA(0, 1), a2 + hstep, voffA);
            PG8_WAIT_V(8); PG8_WAIT_L(0); PG8_BAR; PG8_MMA(0, 0, At, B0); PG8_MMA(0, 1, At, B1); PG8_BAR; PG8_SCHED;
            PG8_LDA(At, 1, 1); PG8_STAGE(PG8_SB(1, 0), b3, voffB); PG8_STAGE(PG8_SB(1, 1), b3 + hstep, voffB); PG8_STAGE(PG8_SA(1, 0), a3, voffA);
            PG8_WAIT_V(8); PG8_WAIT_L(0); PG8_BAR; PG8_MMA(1, 0, At, B0); PG8_MMA(1, 1, At, B1); PG8_BAR; PG8_SCHED;
            } else {
            PG8_LDB(B0, 0, 0); PG8_SCHED; PG8_LDA(At, 0, 0); PG8_STAGE(PG8_SA(1, 1), a1 + hstep, voffA);
            PG8_WAIT_L(8); PG8_BAR; PG8_WAIT_L(0); PG8_MMA(0, 0, At, B0); PG8_BAR; PG8_SCHED;
            PG8_LDB(B1, 0, 1); PG8_STAGE(PG8_SB(0, 0), b2, voffB);
            PG8_BAR; PG8_WAIT_L(0); PG8_MMA(0, 1, At, B1); PG8_BAR;
            PG8_LDA(At, 0, 1); PG8_STAGE(PG8_SA(0, 0), a2, voffA);
            PG8_BAR; PG8_WAIT_L(0); PG8_MMA(1, 0, At, B0); PG8_BAR; PG8_SCHED;
            PG8_STAGE(PG8_SB(0, 1), b2 + hstep, voffB);
            PG8_WAIT_V(6); PG8_BAR; PG8_MMA(1, 1, At, B1); PG8_BAR;
            PG8_LDB(B0, 1, 0); PG8_SCHED; PG8_LDA(At, 1, 0); PG8_STAGE(PG8_SA(0, 1), a2 + hstep, voffA);
            PG8_WAIT_L(8); PG8_BAR; PG8_WAIT_L(0); PG8_MMA(0, 0, At, B0); PG8_BAR; PG8_SCHED;
            PG8_LDB(B1, 1, 1); PG8_STAGE(PG8_SB(1, 0), b3, voffB);
            PG8_BAR; PG8_WAIT_L(0); PG8_MMA(0, 1, At, B1); PG8_BAR;
            PG8_LDA(At, 1, 1); PG8_STAGE(PG8_SA(1, 0), a3, voffA);
            PG8_BAR; PG8_WAIT_L(0); PG8_MMA(1, 0, At, B0); PG8_BAR; PG8_SCHED;
            PG8_STAGE(PG8_SB(1, 1), b3 + hstep, voffB);
            PG8_WAIT_V(6); PG8_BAR; PG8_MMA(1, 1, At, B1); PG8_BAR;
            }
        }
        if constexpr (ALIGN_EPI) { if (wr == 0) PG8_BAR; }
        if constexpr (!Epi::AFTER_DRAIN) { E(acc, cur, wr, wc, fr, fq); S.done(cur); }
        if (!has_next) break;
#pragma unroll
        for (int a = 0; a < 2; ++a)
#pragma unroll
            for (int b = 0; b < 2; ++b)
#pragma unroll
                for (int m = 0; m < 4; ++m)
#pragma unroll
                    for (int n = 0; n < 2; ++n) acc[a][b][m][n] = (f32x4){0.f, 0.f, 0.f, 0.f};
        cur = nxt; cA = nA; cB = nB; ++ui;
        if constexpr (ALIGN_EPI) { if (wr == 1) PG8_BAR; }
    }
    PG8_WAIT_V(0);
    if constexpr (!ALIGN_EPI) { if (wr == 0) PG8_BAR; }
    PG8_BAR;
    if constexpr (Epi::AFTER_DRAIN) { E.fused(acc, cur, wr, wc, fr, fq, lds, wid, lane); S.done(cur); }
#undef PG8_SA
#undef PG8_SB
#undef PG8_STAGE
#undef PG8_LDA
#undef PG8_LDB
#undef PG8_MMA
#undef PG8_WAIT_V
#undef PG8_WAIT_L
#undef PG8_BAR
#undef PG8_SCHED
}
}

#ifndef PG8_SP2
#define PG8_SP2 true
#endif
#ifndef PG8_ALIGN
#define PG8_ALIGN true
#endif
namespace pg8 {
template <int ACT> struct EpiSplit {
    static constexpr bool PERM = true, AFTER_DRAIN = false;
    bf16_t* O; int ldc; int split_cols; size_t split_stride; int scale_t; float scale0;
    __device__ __forceinline__ void operator()(const f32x4 (&acc)[2][2][4][2], const Unit& u, int wr, int wc, int fr, int fq) const {
        const int row0 = u.pm * BM + wr * 64 + fr; int colt = u.pn * BM; bf16_t* base = O;
        float sc = 1.f; if (split_cols) { const int t = colt / split_cols; base += (size_t)t * split_stride; colt -= t * split_cols; if (t == scale_t) sc = scale0; }
        const int col0 = colt + wc * 32 + 8 * fq;
#pragma unroll
        for (int ai = 0; ai < 2; ++ai)
#pragma unroll
            for (int m = 0; m < 4; ++m) { bf16_t* rowp = base + (size_t)(row0 + ai * HALF + m * 16) * ldc + col0;
#pragma unroll
                for (int bj = 0; bj < 2; ++bj) { f32x4 v0 = acc[ai][bj][m][0], v1 = acc[ai][bj][m][1];
                    if (ACT == 2) {
#pragma unroll
                        for (int e = 0; e < 4; ++e) { const float a = fmaxf(v0[e], 0.f), b = fmaxf(v1[e], 0.f); v0[e] = a * a; v1[e] = b * b; } }
                    v0 = v0 * sc; v1 = v1 * sc; u32x4 w; w.x = cvt_pk_bf16(v0[0], v0[1]); w.y = cvt_pk_bf16(v0[2], v0[3]); w.z = cvt_pk_bf16(v1[0], v1[1]); w.w = cvt_pk_bf16(v1[2], v1[3]);
                    *(u32x4*)(rowp + bj * HALF) = w; } }
    }
};
struct EpiOddIn {
    static constexpr bool PERM = true, AFTER_DRAIN = false;
    bf16_t *Q, *K, *V, *G;
    __device__ __forceinline__ void operator()(const f32x4 (&acc)[2][2][4][2], const Unit& u, int wr, int wc, int fr, int fq) const {
        const int row0 = u.pm * BM + wr * 64 + fr; const int pn = u.pn; bf16_t* base; int ldc, colt;
        if (pn < 4) { base = Q; ldc = 1024; colt = pn * BM; } else if (pn < 8) { base = K; ldc = 1024; colt = (pn - 4) * BM; }
        else if (pn < 16) { base = V; ldc = 2048; colt = (pn - 8) * BM; } else { base = G; ldc = 2048; colt = (pn - 16) * BM; }
        const int col0 = colt + wc * 32 + 8 * fq;
#pragma unroll
        for (int ai = 0; ai < 2; ++ai)
#pragma unroll
            for (int m = 0; m < 4; ++m) { bf16_t* rowp = base + (size_t)(row0 + ai * HALF + m * 16) * ldc + col0;
#pragma unroll
                for (int bj = 0; bj < 2; ++bj) { const f32x4 v0 = acc[ai][bj][m][0], v1 = acc[ai][bj][m][1];
                    u32x4 w; w.x = cvt_pk_bf16(v0[0], v0[1]); w.y = cvt_pk_bf16(v0[2], v0[3]); w.z = cvt_pk_bf16(v1[0], v1[1]); w.w = cvt_pk_bf16(v1[2], v1[3]);
                    *(u32x4*)(rowp + bj * HALF) = w; } }
    }
};
struct EpiRes {
    static constexpr bool PERM = false, AFTER_DRAIN = false;
    const float* base; float* out; int ldc;
    __device__ __forceinline__ void operator()(const f32x4 (&acc)[2][2][4][2], const Unit& u, int wr, int wc, int fr, int fq) const {
        const int col0 = u.pn * BM + wc * 32 + 4 * fq;
#pragma unroll
        for (int ai = 0; ai < 2; ++ai)
#pragma unroll
            for (int m = 0; m < 4; ++m) { const size_t off = (size_t)(u.pm * BM + ai * HALF + wr * 64 + m * 16 + fr) * ldc + col0;
#pragma unroll
                for (int bj = 0; bj < 2; ++bj)
#pragma unroll
                    for (int n = 0; n < 2; ++n) { const f32x4 bs = *(const f32x4*)(base + off + bj * HALF + n * 16); *(f32x4*)(out + off + bj * HALF + n * 16) = bs + acc[ai][bj][m][n]; }
                asm volatile("" ::: "memory"); }
    }
};
}
#include <hip/hip_bf16.h>
#include <cmath>
namespace attn_body {
using bf16=__hip_bfloat16;
using bf16x8=__attribute__((ext_vector_type(8)))short;
using s16x4=__attribute__((ext_vector_type(4)))short;
using f32x16=__attribute__((ext_vector_type(16)))float;
using u32x4=__attribute__((ext_vector_type(4)))unsigned;
constexpr int BATCH=16,NHEAD=8,SEQ=4096,D=64,DM=NHEAD*D,ODM=1024;
constexpr int NW=8,QBLK=32,QB=QBLK*NW,KVBLK=64,NQB=SEQ/QB;
constexpr int ATTN_PITCH=DM, ATTN_UNIT_ROWS=QB;
__device__ __forceinline__ int crow(int r,int hi){return (r&3)+8*(r>>2)+4*hi;}
#define SBAR() __builtin_amdgcn_sched_barrier(0)
__device__ __forceinline__ void cmask(f32x16&p0,f32x16&p1,int jb,int qrel,int hi){
  const float NEG=-INFINITY; int kb=64*jb+4*hi;
  #pragma unroll
  for(int r=0;r<16;++r){int kv=kb+(r&3)+8*(r>>2); if(kv>qrel)p0[r]=NEG; if(kv+32>qrel)p1[r]=NEG;}
}

constexpr int NSLOT=3, SLOTB=8192;
constexpr int LDS_K=0, LDS_V=NSLOT*SLOTB, LDS_WS=2*NSLOT*SLOTB, LDS_OST=LDS_WS+NW*64*4, LDS_CUM=LDS_OST+NW*4096,LDS_BYTES=LDS_CUM+SEQ*4;
constexpr float C2=0.125f*1.4426950408889634f;
__device__ __forceinline__ void glds16(const void*gsrc,unsigned lds_dst){unsigned keep;
  asm volatile("s_mov_b32 %0, m0\n\ts_mov_b32 m0, %2\n\ts_nop 0\n\tglobal_load_lds_dwordx4 %1, off\n\ts_mov_b32 m0, %0":"=&s"(keep):"v"(gsrc),"s"(lds_dst):"memory");}
__device__ __forceinline__ float max3f(float a,float b,float c){float r;asm("v_max3_f32 %0, %1, %2, %3":"=v"(r):"v"(a),"v"(b),"v"(c));return r;}
__device__ __forceinline__ float max2f(float a,float b){float r;asm("v_max_f32_e32 %0, %1, %2":"=v"(r):"v"(a),"v"(b));return r;}
__device__ __forceinline__ float fadd_s(float a,float b){float r;asm("v_add_f32_e32 %0, %1, %2":"=v"(r):"v"(a),"v"(b));return r;}
__device__ __forceinline__ float fsub_s(float a,float b){float r;asm("v_sub_f32_e32 %0, %1, %2":"=v"(r):"v"(a),"v"(b));return r;}
typedef float f32x2_t __attribute__((ext_vector_type(2))); typedef __bf16 bf16x2_t __attribute__((ext_vector_type(2)));
__device__ __forceinline__ unsigned cvtpk_s(float lo,float hi){f32x2_t v={lo,hi};bf16x2_t b=__builtin_convertvector(v,bf16x2_t);return __builtin_bit_cast(unsigned,b);}
#define WAIT_BAR(N) asm volatile("s_waitcnt vmcnt(" #N ") lgkmcnt(0)\n\ts_barrier":::"memory")

__device__ __forceinline__ void qkt(f32x16&p0,f32x16&p1,const char*Kslot,const bf16x8*qr,const f32x16&negm,int r32,int hi){
  const char*kb=Kslot+hi*1024+r32*16;
  #pragma unroll
  for(int d0=0;d0<4;++d0){
    const bf16x8 b0=*reinterpret_cast<const bf16x8*>(kb+d0*2048);
    const bf16x8 b1=*reinterpret_cast<const bf16x8*>(kb+d0*2048+512);
    if(d0==0){p0=__builtin_amdgcn_mfma_f32_32x32x16_bf16(b0,qr[0],negm,0,0,0);p1=__builtin_amdgcn_mfma_f32_32x32x16_bf16(b1,qr[0],negm,0,0,0);}
    else{p0=__builtin_amdgcn_mfma_f32_32x32x16_bf16(b0,qr[d0],p0,0,0,0);p1=__builtin_amdgcn_mfma_f32_32x32x16_bf16(b1,qr[d0],p1,0,0,0);}}
}
typedef __attribute__((address_space(3))) const char* lds_cptr;
typedef short v4i16_t __attribute__((ext_vector_type(4)));
__device__ __forceinline__ void kload8(bf16x8*kf,lds_cptr kp){
  kf[0]=*(const __attribute__((address_space(3))) bf16x8*)(kp);      kf[1]=*(const __attribute__((address_space(3))) bf16x8*)(kp+512);
  kf[2]=*(const __attribute__((address_space(3))) bf16x8*)(kp+2048); kf[3]=*(const __attribute__((address_space(3))) bf16x8*)(kp+2560);
  kf[4]=*(const __attribute__((address_space(3))) bf16x8*)(kp+4096); kf[5]=*(const __attribute__((address_space(3))) bf16x8*)(kp+4608);
  kf[6]=*(const __attribute__((address_space(3))) bf16x8*)(kp+6144); kf[7]=*(const __attribute__((address_space(3))) bf16x8*)(kp+6656);
}
__device__ __forceinline__ void kload2(bf16x8*kf,lds_cptr kp,int j){ kf[2*j]=*(const __attribute__((address_space(3))) bf16x8*)(kp+j*2048); kf[2*j+1]=*(const __attribute__((address_space(3))) bf16x8*)(kp+j*2048+512); }
__device__ __forceinline__ s16x4 vtr(lds_cptr p){ return __builtin_bit_cast(s16x4,__builtin_amdgcn_ds_read_tr16_b64_v4i16((__attribute__((address_space(3))) v4i16_t*)p)); }
__device__ __forceinline__ float rowmax(const f32x16&p0,const f32x16&p1){
  float a=max3f(p0[0],p0[1],p1[0]),b=max3f(p0[2],p0[3],p1[1]);a=max3f(a,p1[2],p1[3]);
  #pragma unroll
  for(int r=4;r<16;r+=4){a=max3f(a,p0[r],p0[r+1]);b=max3f(b,p0[r+2],p0[r+3]);a=max3f(a,p1[r],p1[r+1]);b=max3f(b,p1[r+2],p1[r+3]);}
  const float m=max2f(a,b);
  auto rr=__builtin_amdgcn_permlane32_swap(__float_as_uint(m),__float_as_uint(m),false,false);
  return max2f(__uint_as_float(rr[0]),__uint_as_float(rr[1]));
}
__device__ __forceinline__ void pv(f32x16*o,int vb,bf16x8 pa0,bf16x8 pa1,bf16x8 pa2,bf16x8 pa3){
  #pragma unroll
  for(int d0=0;d0<2;++d0){s16x4 lo[4],hi[4];
    #pragma unroll
    for(int ks=0;ks<4;++ks){
      asm volatile("ds_read_b64_tr_b16 %0,%1 offset:%c2":"=&v"(lo[ks]):"v"(vb),"i"(d0*4096+ks*1024):"memory");
      asm volatile("ds_read_b64_tr_b16 %0,%1 offset:%c2":"=&v"(hi[ks]):"v"(vb),"i"(d0*4096+ks*1024+512):"memory");}
    asm volatile("s_waitcnt lgkmcnt(0)":::"memory");SBAR();
    #define PK(k) (bf16x8){lo[k][0],lo[k][1],lo[k][2],lo[k][3],hi[k][0],hi[k][1],hi[k][2],hi[k][3]}
    o[d0]=__builtin_amdgcn_mfma_f32_32x32x16_bf16(pa0,PK(0),o[d0],0,0,0);
    o[d0]=__builtin_amdgcn_mfma_f32_32x32x16_bf16(pa1,PK(1),o[d0],0,0,0);
    o[d0]=__builtin_amdgcn_mfma_f32_32x32x16_bf16(pa2,PK(2),o[d0],0,0,0);
    o[d0]=__builtin_amdgcn_mfma_f32_32x32x16_bf16(pa3,PK(3),o[d0],0,0,0);
    #undef PK
  }
}

#ifndef ATTN_STORE16
#define ATTN_STORE16(p,v) (*(u32x4*)(p)=(v))
#endif
template<int THRL> __device__ __forceinline__ void attn_unit(int b,int h,int qb,const bf16*Q,const bf16*__restrict__ K,const bf16*__restrict__ V,bf16*O,const float*__restrict__ cum,char*shm){
  int tid_l=threadIdx.x; asm volatile("":"+v"(tid_l)); const int tid=tid_l,lane=tid&63,r32=lane&31,hi=lane>>5; const int wid=__builtin_amdgcn_readfirstlane(tid>>6);
  const long rowbase=(long)b*SEQ; const int q0=qb*QB;
  const bf16*Qw=Q+(rowbase+q0+wid*QBLK)*DM+h*D;
  const bf16*Kh=K+rowbase*DM+h*D,*Vh=V+rowbase*DM+h*D;
  typedef float f32x4c __attribute__((ext_vector_type(4)));
  __attribute__((address_space(3))) float* cks=(__attribute__((address_space(3))) float*)((__attribute__((address_space(3))) char*)shm+LDS_CUM);
  { const int nld=q0+QB; for(int i=tid*4;i<nld;i+=NW*64*4) *(__attribute__((address_space(3))) f32x4c*)(cks+i)=*(const f32x4c*)(cum+i); }
  #define CKSUB(P0,P1,t) do{ const __attribute__((address_space(3))) float* ckp_=cks+(t)*64+4*hi; \
    _Pragma("unroll") for(int rr_=0;rr_<4;++rr_){ const f32x4c a_=*(const __attribute__((address_space(3))) f32x4c*)(ckp_+8*rr_); const f32x4c b_=*(const __attribute__((address_space(3))) f32x4c*)(ckp_+32+8*rr_); \
      _Pragma("unroll") for(int e_=0;e_<4;++e_){ P0[4*rr_+e_]-=a_[e_]; P1[4*rr_+e_]-=b_[e_]; } __builtin_amdgcn_sched_barrier(0); } }while(0)
  const unsigned lds0=(unsigned)(uintptr_t)shm;
  float*wsf=(float*)(shm+LDS_WS)+wid*64;
  const bf16*ksrc=Kh+(long)lane*DM+wid*8;
  const bf16*vsrc=Vh+(long)(16*(wid&3)+(lane>>2))*DM+(wid>>2)*32+(lane&3)*8;
  const unsigned kdst=lds0+LDS_K+wid*1024, vdst=lds0+LDS_V+wid*1024;
  #define DMA_K(t,slot) glds16(ksrc+(long)(t)*KVBLK*DM,(unsigned)__builtin_amdgcn_readfirstlane(kdst+(slot)))
  #define DMA_V(t,slot) glds16(vsrc+(long)(t)*KVBLK*DM,(unsigned)__builtin_amdgcn_readfirstlane(vdst+(slot)))
  const int vb0=(int)(lds0+LDS_V)+((lane>>4)&1)*32+(lane&3)*8+(4*hi+((lane&15)>>2))*64;
  const char*Kbase=shm+LDS_K; bf16x8 kf[8];
  const lds_cptr shm3=(lds_cptr)shm; const lds_cptr kp0=shm3+LDS_K+hi*1024+r32*16; const lds_cptr vp0=shm3+LDS_V+((lane>>4)&1)*32+(lane&3)*8+(4*hi+((lane&15)>>2))*64;
  const int NT=(q0+QB)/KVBLK;
  DMA_K(0,0);DMA_V(0,0);DMA_K(1,SLOTB);
  bf16x8 qr[4];
  #pragma unroll
  for(int d0=0;d0<4;++d0)qr[d0]=*reinterpret_cast<const bf16x8*>(&Qw[(long)r32*DM+d0*16+hi*8]);
  float mhat=-cum[q0+wid*QBLK+r32],l_reg=0.f;f32x16 o[2];o[0]=f32x16{};o[1]=f32x16{};f32x16 negm; _Pragma("unroll") for(int r=0;r<16;++r)negm[r]=-mhat; asm volatile("":"+v"(negm));
  const int qrel=wid*QBLK+r32;
  #define CMASK(P0,P1,t) do{int jb_=(t)-(NT-4); if(jb_>=0)cmask(P0,P1,jb_,qrel,hi);}while(0)
  bool resc=false;
  #define START(P0,P1) do{ const float rm=rowmax(P0,P1); resc=false; \
    { const float dl=rm; mhat=fadd_s(mhat,dl); \
      _Pragma("unroll") for(int r=0;r<16;++r){P0[r]=fsub_s(P0[r],dl);P1[r]=fsub_s(P1[r],dl);} \
      _Pragma("unroll") for(int r=0;r<16;++r)negm[r]=-mhat; asm volatile("":"+v"(negm)); } \
    _Pragma("unroll") for(int r=0;r<16;++r)P0[r]=__builtin_amdgcn_exp2f(P0[r]); }while(0)
  #define RESC() do{ if(resc){ asm volatile("s_waitcnt lgkmcnt(0)":::"memory"); \
      _Pragma("unroll") for(int d_=0;d_<2;++d_) _Pragma("unroll") for(int r=0;r<16;++r)o[d_][r]*=wsf[crow(r,hi)]; } }while(0)
  f32x16 pA0,pA1,pB0,pB1;
  int sl_prev=0,sl_cur=0,sl_next=SLOTB;
  #define ROT() do{sl_prev=sl_cur;sl_cur=sl_next;sl_next=(sl_next==(NSLOT-1)*SLOTB)?0:sl_next+SLOTB;}while(0)
  DMA_K(2,2*SLOTB);
  WAIT_BAR(3);
  qkt(pA0,pA1,Kbase,qr,negm,r32,hi);asm volatile("s_nop 15\n\ts_nop 7":"+v"(pA0),"+v"(pA1));CKSUB(pA0,pA1,0);CMASK(pA0,pA1,0);
  START(pA0,pA1);
  _Pragma("unroll") for(int r=0;r<16;++r)pA1[r]=__builtin_amdgcn_exp2f(pA1[r]);
  WAIT_BAR(0);
  DMA_K(3,0);DMA_V(1,SLOTB);
  ROT();
  kload8(kf,kp0+sl_cur);
  WAIT_BAR(2);
  s16x4 vlo[8],vhi[8]; u32x4 pw0,pw1,pw2,pw3;
  #define PKW(P,B) cvtpk_s(P[B],P[B+1])
  #define PAF(k) __builtin_bit_cast(bf16x8,pw##k)
  #define VFR(i) (bf16x8){vlo[i][0],vlo[i][1],vlo[i][2],vlo[i][3],vhi[i][0],vhi[i][1],vhi[i][2],vhi[i][3]}
  #define PIN(x) asm volatile("":"+v"(x))
  #define MX3(a,b,c) __builtin_fmaxf(__builtin_fmaxf((a),(b)),(c))
  #define GAPA(MF,A0,A1,A2,A3,W0,W1,PW) do{ MF; sacc+=A0; sacc+=A1; sacc+=A2; sacc+=A3; PIN(sacc); W0; W1; PIN(PW); SBAR(); }while(0)
  #define EX(v) __builtin_amdgcn_exp2f(v)
  #define GAPB(MF,X,B) do{ MF; X[B]=EX(X[B]); X[B+1]=EX(X[B+1]); X[B+2]=EX(X[B+2]); X[B+3]=EX(X[B+3]); PIN(X); SBAR(); }while(0)
  #define VRD(i) do{ vlo[i]=vtr(vp_+(((i)>>2)*4096+((i)&3)*1024)); vhi[i]=vtr(vp_+(((i)>>2)*4096+((i)&3)*1024+512)); }while(0)
  #define KRD(G,j) do{ if(G){ kload2(kf,kp0+sl_next,j); SBAR(); } }while(0)
  #define STEP(C0,C1,P0,P1,t,GK,GV,GL) do{ SBAR(); \
    const lds_cptr vp_=vp0+sl_prev; \
    VRD(0); SBAR(); float sacc=(P0[0]+P0[1]); \
    GAPA(C0=__builtin_amdgcn_mfma_f32_32x32x16_bf16(kf[0],qr[0],negm,0,0,0), P0[2],P0[3],P0[4],P0[5],     pw0[0]=PKW(P0,0), pw0[1]=PKW(P0,2), pw0); \
    VRD(4); SBAR(); GAPA(C1=__builtin_amdgcn_mfma_f32_32x32x16_bf16(kf[1],qr[0],negm,0,0,0), P0[6],P0[7],P0[8],P0[9],     pw0[2]=PKW(P0,4), pw0[3]=PKW(P0,6), pw0); \
    VRD(1); SBAR(); GAPA(C0=__builtin_amdgcn_mfma_f32_32x32x16_bf16(kf[2],qr[1],C0,0,0,0),   P0[10],P0[11],P0[12],P0[13], pw1[0]=PKW(P0,8), pw1[1]=PKW(P0,10), pw1); \
    VRD(5); SBAR(); GAPA(C1=__builtin_amdgcn_mfma_f32_32x32x16_bf16(kf[3],qr[1],C1,0,0,0),   P0[14],P0[15],P1[0],P1[1],   pw1[2]=PKW(P0,12),pw1[3]=PKW(P0,14), pw1); \
    VRD(2); SBAR(); GAPA(C0=__builtin_amdgcn_mfma_f32_32x32x16_bf16(kf[4],qr[2],C0,0,0,0),   P1[2],P1[3],P1[4],P1[5],     pw2[0]=PKW(P1,0), pw2[1]=PKW(P1,2), pw2); \
    VRD(6); SBAR(); GAPA(C1=__builtin_amdgcn_mfma_f32_32x32x16_bf16(kf[5],qr[2],C1,0,0,0),   P1[6],P1[7],P1[8],P1[9],     pw2[2]=PKW(P1,4), pw2[3]=PKW(P1,6), pw2); \
    VRD(3); SBAR(); GAPA(C0=__builtin_amdgcn_mfma_f32_32x32x16_bf16(kf[6],qr[3],C0,0,0,0),   P1[10],P1[11],P1[12],P1[13], pw3[0]=PKW(P1,8), pw3[1]=PKW(P1,10), pw3); \
    VRD(7); SBAR(); GAPA(C1=__builtin_amdgcn_mfma_f32_32x32x16_bf16(kf[7],qr[3],C1,0,0,0),   P1[14],P1[15],0.f,0.f,       pw3[2]=PKW(P1,12),pw3[3]=PKW(P1,14), pw3); \
    l_reg+=sacc; \
    if(GK){DMA_K((t)+3,sl_cur);} if(GV){DMA_V((t)+1,sl_next);} \
    CKSUB(C0,C1,t); CMASK(C0,C1,t); \
    { float a=MX3(C0[0],C0[1],C1[0]),b=MX3(C0[2],C0[3],C1[1]); a=MX3(a,C1[2],C1[3]); \
      _Pragma("unroll") for(int r=4;r<16;r+=4){a=MX3(a,C0[r],C0[r+1]);b=MX3(b,C0[r+2],C0[r+3]);a=MX3(a,C1[r],C1[r+1]);b=MX3(b,C1[r+2],C1[r+3]);} \
      float rm=__builtin_fmaxf(a,b); { auto rr=__builtin_amdgcn_permlane32_swap(__float_as_uint(rm),__float_as_uint(rm),false,false); rm=__builtin_fmaxf(__uint_as_float(rr[0]),__uint_as_float(rr[1])); } \
      resc=false; \
      if(__builtin_expect(__any(rm>(float)THRL),0)){ const float dl=__builtin_fmaxf(rm,0.f); mhat+=dl; \
        _Pragma("unroll") for(int r=0;r<16;++r){C0[r]-=dl;C1[r]-=dl;} \
        _Pragma("unroll") for(int r=0;r<16;++r)negm[r]=-mhat; asm volatile("":"+v"(negm)); \
        const float f=__builtin_amdgcn_exp2f(-dl); l_reg*=f; if(hi==0)wsf[r32]=f; resc=true; } } \
    SBAR(); \
    GAPB(o[0]=__builtin_amdgcn_mfma_f32_32x32x16_bf16(PAF(0),VFR(0),o[0],0,0,0), C0,0); \
    GAPB(o[1]=__builtin_amdgcn_mfma_f32_32x32x16_bf16(PAF(0),VFR(4),o[1],0,0,0), C0,4); \
    KRD(GL,0); GAPB(o[0]=__builtin_amdgcn_mfma_f32_32x32x16_bf16(PAF(1),VFR(1),o[0],0,0,0), C0,8); \
    KRD(GL,1); GAPB(o[1]=__builtin_amdgcn_mfma_f32_32x32x16_bf16(PAF(1),VFR(5),o[1],0,0,0), C0,12); \
    KRD(GL,2); GAPB(o[0]=__builtin_amdgcn_mfma_f32_32x32x16_bf16(PAF(2),VFR(2),o[0],0,0,0), C1,0); \
    KRD(GL,3); GAPB(o[1]=__builtin_amdgcn_mfma_f32_32x32x16_bf16(PAF(2),VFR(6),o[1],0,0,0), C1,4); \
    GAPB(o[0]=__builtin_amdgcn_mfma_f32_32x32x16_bf16(PAF(3),VFR(3),o[0],0,0,0), C1,8); \
    GAPB(o[1]=__builtin_amdgcn_mfma_f32_32x32x16_bf16(PAF(3),VFR(7),o[1],0,0,0), C1,12); \
    }while(0)
  int t=1;
  #undef CMASK
  #define CMASK(P0,P1,t) do{}while(0)
  for(;t+5<NT;t+=2){
    STEP(pB0,pB1,pA0,pA1,t,true,true,true);     WAIT_BAR(2); RESC(); ROT();
    STEP(pA0,pA1,pB0,pB1,t+1,true,true,true);   WAIT_BAR(2); RESC(); ROT();
  }
  #undef CMASK
  #define CMASK(P0,P1,t) do{int jb_=(t)-(NT-4); if(jb_>=0)cmask(P0,P1,jb_,qrel,hi);}while(0)
  #define ENDW(tt) do{ if((tt)+3<NT){WAIT_BAR(2);} else if((tt)+2<NT){WAIT_BAR(1);} else {WAIT_BAR(0);} }while(0)
  for(;t+1<NT;t+=2){
    STEP(pB0,pB1,pA0,pA1,t,(t+3<NT),(t+1<NT),(t+1<NT));       ENDW(t);   RESC(); ROT();
    STEP(pA0,pA1,pB0,pB1,t+1,(t+4<NT),(t+2<NT),(t+2<NT));     ENDW(t+1); RESC(); ROT();
  }
  STEP(pB0,pB1,pA0,pA1,NT-1,false,false,false); RESC();
  { float sacc=pB0[0]+pB0[1]; _Pragma("unroll") for(int r=2;r<16;++r)sacc+=pB0[r]; _Pragma("unroll") for(int r=0;r<16;++r)sacc+=pB1[r]; l_reg+=sacc;
    pw0=(u32x4){PKW(pB0,0),PKW(pB0,2),PKW(pB0,4),PKW(pB0,6)};pw1=(u32x4){PKW(pB0,8),PKW(pB0,10),PKW(pB0,12),PKW(pB0,14)};pw2=(u32x4){PKW(pB1,0),PKW(pB1,2),PKW(pB1,4),PKW(pB1,6)};pw3=(u32x4){PKW(pB1,8),PKW(pB1,10),PKW(pB1,12),PKW(pB1,14)};
    SBAR(); pv(o,vb0+sl_cur,PAF(0),PAF(1),PAF(2),PAF(3)); }
  #undef PKW
  #undef PAF
  #undef VFR
  #undef PIN
  #undef MX3
  #undef GAPA
  #undef GAPB
  #undef EX
  #undef VRD
  #undef KRD
  #undef STEP
  #undef ENDW
  {auto rr=__builtin_amdgcn_permlane32_swap(__float_as_uint(l_reg),__float_as_uint(l_reg),false,false);l_reg=__uint_as_float(rr[0])+__uint_as_float(rr[1]);}
  if(hi==0)wsf[32+r32]=l_reg;asm volatile("s_waitcnt lgkmcnt(0)":::"memory");
  float rli[16];
  #pragma unroll
  for(int r=0;r<16;++r)rli[r]=__builtin_amdgcn_rcpf(wsf[32+crow(r,hi)]);
  bf16*Ow=O+(rowbase+q0+wid*QBLK)*ODM+h*D;
  { bf16*stg=(bf16*)(shm+LDS_OST)+wid*2048;
    #pragma unroll
    for(int r=0;r<16;++r){const int orow=crow(r,hi);
      #pragma unroll
      for(int d0=0;d0<2;++d0)stg[orow*64+d0*32+r32]=__float2bfloat16(o[d0][r]*rli[r]);}
    asm volatile("s_waitcnt lgkmcnt(0)":::"memory");
    #pragma unroll
    for(int i=0;i<4;++i){const int row=i*8+(lane>>3),ch=lane&7; const u32x4 v=*(const u32x4*)(stg+row*64+ch*8); ATTN_STORE16(Ow+(long)row*ODM+ch*8,v);} }
  asm volatile("s_waitcnt lgkmcnt(0)\n\ts_barrier":::"memory");
  #undef CKSUB
  #undef DMA_K
  #undef DMA_V
  #undef CMASK
  #undef START
  #undef RESC
  #undef ROT
}
constexpr int ATTN_LDS_BYTES=LDS_BYTES;
struct AttnTensors { const bf16* Q; const bf16* K; const bf16* V; bf16* O; const float* CUM; };
struct AttnUnit { int bh; int qb; };
struct StaticOrder {
  int vcu;
  __device__ __forceinline__ explicit StaticOrder(int grid,int block):vcu((block%8)*(grid/8)+block/8){}
  __device__ __forceinline__ bool next(int i,AttnUnit&u)const{ if(i>=8)return false; const int s=vcu&1; u.bh=vcu>>1; const int j=7-i; u.qb=4*(j>>1)+(s==0?((j&1)?3:0):((j&1)?2:1)); return true; }
  __device__ __forceinline__ void a_ready(const AttnUnit&)const{}
  __device__ __forceinline__ void done(const AttnUnit&)const{}
};
template<class Sched,int THRL=8> __device__ __forceinline__ void attn_phase(char*lds,const AttnTensors&T,const Sched&S){
  AttnUnit u;
  for(int i=0;S.next(i,u);++i){ S.a_ready(u); attn_unit<THRL>(u.bh/NHEAD,u.bh%NHEAD,u.qb,T.Q,T.K,T.V,T.O,T.CUM+(size_t)u.bh*SEQ,lds); S.done(u); }
}
#undef SBAR
#undef WAIT_BAR
}
#include <hip/hip_cooperative_groups.h>
namespace cg = cooperative_groups;
#define LAS __attribute__((address_space(3)))
typedef unsigned short bf16;
typedef unsigned v4u __attribute__((ext_vector_type(4)));
typedef unsigned v2u __attribute__((ext_vector_type(2)));
typedef float f32x4 __attribute__((ext_vector_type(4)));
typedef float f32x16 __attribute__((ext_vector_type(16)));
typedef short bf16x8 __attribute__((ext_vector_type(8)));
typedef short s16x4 __attribute__((ext_vector_type(4)));

constexpr int NWAVES = 8;
constexpr int BATCH = 16, SEQ = 4096, DM = 1024, M = BATCH * SEQ, FF = 4096, DEPTH = 4;
constexpr int EVEN_IN = 3080, EVEN_N = 3072, ODD_IN = 6144;
constexpr float RMS_EPS = 1e-6f, GN_EPS = 1e-6f, LOG2E = 1.4426950408889634f;
constexpr size_t MiB = 1u << 20;
constexpr size_t WS_EIN = 1 * MiB, WS_EOUT = WS_EIN + 12 * MiB, WS_OIN = WS_EOUT + 4 * MiB, WS_OOUT = WS_OIN + 24 * MiB, WS_F1 = WS_OOUT + 8 * MiB, WS_F2 = WS_F1 + 32 * MiB;
constexpr size_t WS_LOGF = WS_F2 + 32 * MiB, WS_CUM = WS_LOGF + 2 * MiB, WS_LSE = WS_CUM + 2 * MiB, WS_XN = 124 * MiB, WS_ACT = 252 * MiB, WS_END = 1024 * MiB;
static_assert(WS_LSE + 6 * MiB <= WS_XN, "ws map");
constexpr size_t SEG = 64 * MiB, WS_OG = WS_ACT + 6 * SEG, WS_AO = WS_OG + 3 * SEG;
static_assert(WS_AO + 128 * MiB <= WS_END, "ws map even");
constexpr size_t WS_RQ = WS_ACT, WS_RK = WS_RQ + 128 * MiB, WS_RV = WS_RK + 128 * MiB, WS_RG = WS_RV + 256 * MiB;
static_assert(WS_RG + 256 * MiB <= WS_END, "ws map odd");
constexpr size_t WS_H = WS_ACT;
constexpr int LDS_BYTES = 147456;

__device__ __forceinline__ unsigned f2bf(float f) { unsigned u = __builtin_bit_cast(unsigned, f); return (u + 0x7fffu + ((u >> 16) & 1u)) >> 16; }
__device__ __forceinline__ unsigned pk2(float lo, float hi) { return attn_body::cvtpk_s(lo, hi); }
__device__ __forceinline__ float bf2f(unsigned short b) { return __builtin_bit_cast(float, (unsigned)b << 16); }
__device__ __forceinline__ float xor32f(float v) { auto rr = __builtin_amdgcn_permlane32_swap(__float_as_uint(v), __float_as_uint(v), false, false); return __uint_as_float((threadIdx.x & 32) ? rr[0] : rr[1]); }
#define SWZ(v, x) __uint_as_float((unsigned)__builtin_amdgcn_ds_swizzle((int)__float_as_uint(v), ((x) << 10) | 0x1f))
__device__ __forceinline__ float wave_sum(float v) {
    v += SWZ(v, 1); v += SWZ(v, 2); v += SWZ(v, 4); v += SWZ(v, 8); v += SWZ(v, 16);
    auto rr = __builtin_amdgcn_permlane32_swap(__float_as_uint(v), __float_as_uint(v), false, false);
    return __uint_as_float(rr[0]) + __uint_as_float(rr[1]);
}
__device__ __forceinline__ int crow(int r, int hi) { return (r & 3) + 8 * (r >> 2) + 4 * hi; }
__device__ __forceinline__ s16x4 trrd(const LAS unsigned char* p) { typedef short v4i16_t __attribute__((ext_vector_type(4))); return __builtin_bit_cast(s16x4, __builtin_amdgcn_ds_read_tr16_b64_v4i16((LAS v4i16_t*)p)); }
#define CAT8(lo, hi) (bf16x8){lo[0], lo[1], lo[2], lo[3], hi[0], hi[1], hi[2], hi[3]}
#define MFMA32(a, b, c) __builtin_amdgcn_mfma_f32_32x32x16_bf16((a), (b), (c), 0, 0, 0)

__device__ __forceinline__ void p0_transpose_item(const float* W, int K, int N, int ldw, bf16* WT, LAS float* scr, int item, int lane) {
    const int nblk = N / 32, kb = item / nblk, nb = item % nblk, k0 = 64 * kb, n0 = 32 * nb;
#pragma unroll 8
    for (int i = 0; i < 32; ++i) { const int kk = 2 * i + (lane >> 5); scr[kk * 33 + (lane & 31)] = W[(size_t)(k0 + kk) * ldw + n0 + (lane & 31)]; }
    asm volatile("s_waitcnt lgkmcnt(0)" ::: "memory");
    const int c = lane & 7;
#pragma unroll
    for (int j = 0; j < 4; ++j) { const int n = (lane >> 3) + 8 * j; const LAS float* s = scr + (8 * c) * 33 + n;
        v4u o; o.x = pk2(s[0 * 33], s[1 * 33]); o.y = pk2(s[2 * 33], s[3 * 33]); o.z = pk2(s[4 * 33], s[5 * 33]); o.w = pk2(s[6 * 33], s[7 * 33]);
        *(v4u*)(WT + (size_t)(n0 + n) * K + k0 + 8 * c) = o; }
    asm volatile("s_waitcnt lgkmcnt(0)" ::: "memory");
}
struct Ins { const float *x, *gmix, *gffn, *ewin, *ebf, *ewout, *owin, *owout, *f1, *f2, *gfin; };
__device__ __forceinline__ void p0_prologue(const Ins& in, unsigned char* ws, LAS unsigned char* lds, int gw, int NGW, int wave, int lane) {
    LAS float* scr = (LAS float*)(lds + wave * 16384);
    constexpr int I_EIN = 16 * 96, I_EOUT = 16 * 32, I_OIN = 16 * 192, I_OOUT = 32 * 32, I_F1 = 16 * 128, I_F2 = 64 * 32;
    constexpr int NITEMS = 2 * (I_EIN + I_EOUT + I_OIN + I_OOUT) + 4 * (I_F1 + I_F2);
    for (int it = gw; it < NITEMS; it += NGW) {
        int r = it;
        if (r < 2 * I_EIN) { const int i = r / I_EIN; p0_transpose_item(in.ewin + (size_t)i * DM * EVEN_IN, DM, EVEN_N, EVEN_IN, (bf16*)(ws + WS_EIN) + (size_t)i * EVEN_N * DM, scr, r % I_EIN, lane); continue; } r -= 2 * I_EIN;
        if (r < 2 * I_EOUT) { const int i = r / I_EOUT; p0_transpose_item(in.ewout + (size_t)i * DM * DM, DM, DM, DM, (bf16*)(ws + WS_EOUT) + (size_t)i * DM * DM, scr, r % I_EOUT, lane); continue; } r -= 2 * I_EOUT;
        if (r < 2 * I_OIN) { const int i = r / I_OIN; p0_transpose_item(in.owin + (size_t)i * DM * ODD_IN, DM, ODD_IN, ODD_IN, (bf16*)(ws + WS_OIN) + (size_t)i * ODD_IN * DM, scr, r % I_OIN, lane); continue; } r -= 2 * I_OIN;
        if (r < 2 * I_OOUT) { const int i = r / I_OOUT; p0_transpose_item(in.owout + (size_t)i * 2 * DM * DM, 2 * DM, DM, DM, (bf16*)(ws + WS_OOUT) + (size_t)i * 2 * DM * DM, scr, r % I_OOUT, lane); continue; } r -= 2 * I_OOUT;
        if (r < 4 * I_F1) { const int i = r / I_F1; p0_transpose_item(in.f1 + (size_t)i * DM * FF, DM, FF, FF, (bf16*)(ws + WS_F1) + (size_t)i * FF * DM, scr, r % I_F1, lane); continue; } r -= 4 * I_F1;
        { const int i = r / I_F2; p0_transpose_item(in.f2 + (size_t)i * FF * DM, FF, DM, DM, (bf16*)(ws + WS_F2) + (size_t)i * FF * DM, scr, r % I_F2, lane); }
    }
}

__device__ __forceinline__ void rms_phase(const float* x, const float* g, bf16* XN, const float* Wf  , const float* bfp, float* LOGF,
                                          LAS unsigned char* lds, int gw, int NGW, int tid, int lane) {
    LAS float* wt = (LAS float*)lds;
    if (Wf) { for (int idx = tid; idx < 8192; idx += NWAVES * 64) { const int k = idx >> 3, j = idx & 7; wt[j * 1024 + k] = Wf[(size_t)k * EVEN_IN + j]; } }
    __syncthreads();
    f32x4 gv[4];
#pragma unroll
    for (int j = 0; j < 4; ++j) gv[j] = *((const f32x4*)g + lane + 64 * j);
    for (int m = gw; m < M; m += NGW) {
        const f32x4* xr = (const f32x4*)(x + (size_t)m * DM) + lane;
        f32x4 v[4]; float s = 0.f;
#pragma unroll
        for (int j = 0; j < 4; ++j) { v[j] = xr[64 * j]; s += (v[j].x * v[j].x + v[j].y * v[j].y) + (v[j].z * v[j].z + v[j].w * v[j].w); }
        const float rstd = 1.0f / sqrtf(wave_sum(s) * (1.f / DM) + RMS_EPS);
#pragma unroll
        for (int j = 0; j < 4; ++j) v[j] = v[j] * rstd * gv[j];
        v2u* o8 = (v2u*)(XN + (size_t)m * DM) + lane;
#pragma unroll
        for (int j = 0; j < 4; ++j) { v2u w; w.x = pk2(v[j].x, v[j].y); w.y = pk2(v[j].z, v[j].w); o8[64 * j] = w; }
        if (Wf) {
            float mine = 0.f;
#pragma unroll
            for (int jj = 0; jj < 8; ++jj) { float d = 0.f;
#pragma unroll
                for (int j = 0; j < 4; ++j) { const f32x4 w = *((const LAS f32x4*)(wt + jj * 1024) + lane + 64 * j); d += (v[j].x * w.x + v[j].y * w.y) + (v[j].z * w.z + v[j].w * w.w); }
                d = wave_sum(d); if (lane == jj) mine = d; }
            if (lane < 8) { const float u = mine + bfp[lane]; LOGF[(size_t)m * 8 + lane] = fminf(u, 0.f) - __logf(1.0f + __expf(-fabsf(u))); }
        }
    }
    __syncthreads();
}
__device__ __forceinline__ void cumsum_bh(const float* LOGF, float* CUM, int b, int h, int lane) {
    const float* src = LOGF + ((size_t)b * SEQ + 64 * lane) * 8 + h; float s = 0.f;
    for (int i = 0; i < 64; ++i) s += src[i * 8];
    float inc = s;
#pragma unroll
    for (int o = 1; o < 64; o <<= 1) { const float t = __uint_as_float((unsigned)__builtin_amdgcn_ds_bpermute(((lane - o) & 63) * 4, (int)__float_as_uint(inc))); if (lane >= o) inc += t; }
    float run = inc - s; float* dst = CUM + ((size_t)b * 8 + h) * SEQ + 64 * lane;
    for (int i = 0; i < 64; ++i) { run += src[i * 8]; dst[i] = run * LOG2E; }
}

namespace dil {
constexpr int LK = 0, LV = 384 * 128, LSCR = LV + 384 * 144, LTOT = LSCR + NWAVES * 256;
static_assert(LTOT <= 131072, "dil lds");
__device__ __forceinline__ void unit(int b, int h, int g, int sr, int np, const bf16* Q, const bf16* K, const bf16* V, bf16* OG, float* LSE, LAS unsigned char* lds, int tid, int wave, int lane) {
    const int d = (g == 0) ? 1 : (g == 1) ? 4 : 16;
    const int win0 = (2 * np - 1) * 128; const size_t rowbase = (size_t)b * SEQ; const int r32 = lane & 31, hi = lane >> 5;
#pragma unroll
    for (int i = 0; i < 6; ++i) { const int idx = tid + 512 * i, j = idx >> 3, ch = idx & 7; const bool ok = (win0 + j) >= 0;
        const size_t tok = rowbase + (size_t)((ok ? (win0 + j) : 0) * d + sr); const size_t go = tok * 512 + h * 64 + ch * 8;
        v4u kv = *(const v4u*)(K + go), vv = *(const v4u*)(V + go);
        if (!ok) { kv = (v4u){0u, 0u, 0u, 0u}; vv = kv; }
        *(LAS v4u*)(lds + LK + j * 128 + ((ch ^ ((j >> 1) & 7)) * 16)) = kv;
        *(LAS v4u*)(lds + LV + j * 144 + ch * 16) = vv; }
    const int qrow = 128 + 32 * wave + r32; const size_t tokq = rowbase + (size_t)((win0 + qrow) * d + sr);
    bf16x8 qr[4];
#pragma unroll
    for (int s = 0; s < 4; ++s) qr[s] = *(const bf16x8*)(Q + tokq * 512 + h * 64 + 16 * s + 8 * hi);
    __syncthreads();
    f32x16 sc[5];
    const float csc = 0.125f * LOG2E, al = __builtin_amdgcn_exp2f(-(float)(h + 1)) * (float)d * LOG2E;
    const int sb = 128 + r32 - 4 * hi; const int stmax = min(128, win0 + qrow);
    float mx = -INFINITY;
#pragma unroll
    for (int j = 0; j < 5; ++j) { const int row = 32 * (wave + j) + r32; f32x16 a = {};
#pragma unroll
        for (int s = 0; s < 4; ++s) { const bf16x8 kf = *(const LAS bf16x8*)(lds + LK + row * 128 + (((2 * s + hi) ^ ((row >> 1) & 7)) * 16)); a = MFMA32(kf, qr[s], a); }
        int sbj = sb; asm volatile("" : "+v"(sbj) : "v"(a[15]));
#pragma unroll
        for (int r = 0; r < 16; ++r) { const int st = sbj - (32 * j + (r & 3) + 8 * (r >> 2));
            const float x = ((unsigned)st <= (unsigned)stmax) ? (a[r] * csc - al * (float)st) : -INFINITY; a[r] = x; mx = fmaxf(mx, x); }
        sc[j] = a;  __builtin_amdgcn_sched_barrier(0); }
    { auto rr = __builtin_amdgcn_permlane32_swap(__float_as_uint(mx), __float_as_uint(mx), false, false); mx = fmaxf(__uint_as_float(rr[0]), __uint_as_float(rr[1])); }
    float l = 0.f;
#pragma unroll
    for (int j = 0; j < 5; ++j)
#pragma unroll
        for (int r = 0; r < 16; ++r) { const float p = __builtin_amdgcn_exp2f(sc[j][r] - mx); sc[j][r] = p; l += p; }
    { auto rr = __builtin_amdgcn_permlane32_swap(__float_as_uint(l), __float_as_uint(l), false, false); l = __uint_as_float(rr[0]) + __uint_as_float(rr[1]); }
    f32x16 o[2]; o[0] = f32x16{}; o[1] = f32x16{};
    const int blk = (lane >> 4) & 1, q4 = (lane & 15) >> 2, p4 = lane & 3;
#pragma unroll
    for (int j = 0; j < 5; ++j)
#pragma unroll
        for (int s = 0; s < 2; ++s) {
            v4u pw; pw.x = pk2(sc[j][8 * s + 0], sc[j][8 * s + 1]); pw.y = pk2(sc[j][8 * s + 2], sc[j][8 * s + 3]); pw.z = pk2(sc[j][8 * s + 4], sc[j][8 * s + 5]); pw.w = pk2(sc[j][8 * s + 6], sc[j][8 * s + 7]);
            const bf16x8 pa = __builtin_bit_cast(bf16x8, pw);
            const int R0 = 32 * (wave + j) + 16 * s + 4 * hi + q4;
#pragma unroll
            for (int c = 0; c < 2; ++c) { const LAS unsigned char* vp = lds + LV + R0 * 144 + (32 * c + 16 * blk) * 2 + 8 * p4;
                const s16x4 lo = trrd(vp), hh = trrd(vp + 8 * 144); o[c] = MFMA32(pa, CAT8(lo, hh), o[c]); }  __builtin_amdgcn_sched_barrier(0); }
    LAS float* scr = (LAS float*)(lds + LSCR + wave * 256);
    if (hi == 0) scr[r32] = 1.0f / l;
    asm volatile("s_waitcnt lgkmcnt(0)" ::: "memory");
    if (hi == 0) LSE[tokq * 8 + h] = mx + __builtin_amdgcn_logf(l);
#pragma unroll
    for (int r = 0; r < 16; ++r) { const int qq = crow(r, hi); const float inv = scr[qq]; const size_t tok = rowbase + (size_t)((win0 + 128 + 32 * wave + qq) * d + sr);
        bf16* op = OG + tok * 512 + h * 64 + r32; op[0] = (bf16)f2bf(o[0][r] * inv); op[32] = (bf16)f2bf(o[1][r] * inv); }
    __syncthreads();
}
}

namespace ret {
constexpr int C = 64, KR = 544, VR = 288, SR = 544, LK = 0, LV = C * KR, LST = LV + C * VR, LTOT = LST + 128 * SR;
static_assert(LTOT <= 131072, "ret lds");
__device__ __forceinline__ void unit(int b, int h, int vs, const bf16* Q, const bf16* K, bf16* V  , LAS unsigned char* lds, int tid, int wave, int lane) {
    const float gam = 1.0f - __builtin_amdgcn_exp2f(-5.0f - (float)h), lg = __builtin_amdgcn_logf(gam);
    const int r32 = lane & 31, hi = lane >> 5, wr = wave >> 2, wc = wave & 3, blk = (lane >> 4) & 1, q4 = (lane & 15) >> 2, p4 = lane & 3;
    const size_t rowbase = (size_t)b * SEQ;
    f32x16 S[4];
#pragma unroll
    for (int t = 0; t < 4; ++t) S[t] = f32x16{};
    for (int i = tid; i < 128 * SR / 16; i += NWAVES * 64) *(LAS v4u*)(lds + LST + i * 16) = (v4u){0u, 0u, 0u, 0u};
    const float c0 = __builtin_amdgcn_exp2f(-lg * (float)C), gC = __builtin_amdgcn_exp2f(lg * (float)C);
    for (int ci = 0; ci < SEQ / C; ++ci) {
        const size_t t0 = rowbase + (size_t)ci * C;
#pragma unroll
        for (int k = 0; k < 4; ++k) { const int idx = tid + 512 * k, t = idx >> 5, ch = idx & 31; *(LAS v4u*)(lds + LK + t * KR + ch * 16) = *(const v4u*)(K + (t0 + t) * 1024 + h * 256 + ch * 8); }
#pragma unroll
        for (int k = 0; k < 2; ++k) { const int idx = tid + 512 * k, t = idx >> 4, ch = idx & 15; const v4u raw = *(const v4u*)(V + (t0 + t) * 2048 + h * 512 + vs * 128 + ch * 8);
            const float kd = __builtin_amdgcn_exp2f(lg * (float)(C - 1 - t)) * 0.0625f;     v4u w;
            w.x = pk2(__builtin_bit_cast(float, raw.x << 16) * kd, __builtin_bit_cast(float, raw.x & 0xffff0000u) * kd);
            w.y = pk2(__builtin_bit_cast(float, raw.y << 16) * kd, __builtin_bit_cast(float, raw.y & 0xffff0000u) * kd);
            w.z = pk2(__builtin_bit_cast(float, raw.z << 16) * kd, __builtin_bit_cast(float, raw.z & 0xffff0000u) * kd);
            w.w = pk2(__builtin_bit_cast(float, raw.w << 16) * kd, __builtin_bit_cast(float, raw.w & 0xffff0000u) * kd);
            *(LAS v4u*)(lds + LV + t * VR + ch * 16) = w; }
        const bf16* qp = Q + (t0 + 32 * wr + r32) * 1024 + h * 256 + 8 * hi;
        bf16x8 qa[4], qb[4];
#pragma unroll
        for (int s = 0; s < 4; ++s) qa[s] = *(const bf16x8*)(qp + 16 * s);
        __syncthreads();
        f32x16 acc = f32x16{}, it0 = f32x16{}, it1 = f32x16{};
        const LAS unsigned char* sp = lds + LST + (32 * wc + r32) * SR + 16 * hi;
        const LAS unsigned char* kp = lds + LK + r32 * KR + 16 * hi;
#define RGRP(QC, QN, G) do { if ((G) < 3) { _Pragma("unroll") for (int s = 0; s < 4; ++s) QN[s] = *(const bf16x8*)(qp + 16 * (4 * ((G) + 1) + s)); } \
            _Pragma("unroll") for (int s = 0; s < 4; ++s) { const int ks = 4 * (G) + s; acc = MFMA32(QC[s], *(const LAS bf16x8*)(sp + 32 * ks), acc); \
                it0 = MFMA32(*(const LAS bf16x8*)(kp + 32 * ks), QC[s], it0); if (wr) it1 = MFMA32(*(const LAS bf16x8*)(kp + 32 * KR + 32 * ks), QC[s], it1); } \
            __builtin_amdgcn_sched_barrier(0); } while (0)
        RGRP(qa, qb, 0); RGRP(qb, qa, 1); RGRP(qa, qb, 2); RGRP(qb, qa, 3);
#undef RGRP
#pragma unroll
        for (int j = 0; j < 2; ++j) if (j <= wr) {
            f32x16 it = (j == 0) ? it0 : it1;
            int qv = 32 * wr + r32 - 4 * hi; asm volatile("" : "+v"(qv) : "v"(it[15]));
#pragma unroll
            for (int r = 0; r < 16; ++r) { it[r] = ((32 * j + (r & 3) + 8 * (r >> 2)) <= qv) ? it[r] * c0 : 0.f; }
#pragma unroll
            for (int s = 0; s < 2; ++s) {
                v4u pw; pw.x = pk2(it[8 * s + 0], it[8 * s + 1]); pw.y = pk2(it[8 * s + 2], it[8 * s + 3]); pw.z = pk2(it[8 * s + 4], it[8 * s + 5]); pw.w = pk2(it[8 * s + 6], it[8 * s + 7]);
                const LAS unsigned char* vp = lds + LV + (32 * j + 16 * s + 4 * hi + q4) * VR + (32 * wc + 16 * blk) * 2 + 8 * p4;
                const s16x4 lo = trrd(vp), hh = trrd(vp + 8 * VR); acc = MFMA32(__builtin_bit_cast(bf16x8, pw), CAT8(lo, hh), acc); } }
        { bf16* ob = V + (t0 + 32 * wr + 4 * hi) * 2048 + h * 512 + vs * 128 + 32 * wc + r32; asm volatile("" : "+v"(ob));
          float fb = lg * (float)(32 * wr + 4 * hi + 1); asm volatile("" : "+v"(fb));
#pragma unroll
          for (int r = 0; r < 16; ++r) { const int dq = (r & 3) + 8 * (r >> 2); const float f = __builtin_amdgcn_exp2f(fb + lg * (float)dq);
            ob[(size_t)dq * 2048] = (bf16)f2bf(acc[r] * f); } }
        __builtin_amdgcn_sched_barrier(0);
#pragma unroll
        for (int t = 0; t < 4; ++t) S[t] = S[t] * gC;
#pragma unroll
        for (int s = 0; s < 4; ++s) {
            const LAS unsigned char* ka = lds + LK + (16 * s + 8 * hi + q4) * KR + (32 * wave + 16 * blk) * 2 + 8 * p4;
            const s16x4 klo = trrd(ka), khi = trrd(ka + 4 * KR); const bf16x8 kf = CAT8(klo, khi);
#pragma unroll
            for (int t = 0; t < 4; ++t) { const LAS unsigned char* vb = lds + LV + (16 * s + 8 * hi + q4) * VR + (32 * t + 16 * blk) * 2 + 8 * p4;
                const s16x4 vlo = trrd(vb), vhi = trrd(vb + 4 * VR); S[t] = MFMA32(kf, CAT8(vlo, vhi), S[t]); }  __builtin_amdgcn_sched_barrier(0); }
        __syncthreads();
#pragma unroll
        for (int t = 0; t < 4; ++t)
#pragma unroll
            for (int g4 = 0; g4 < 4; ++g4) { v2u w; w.x = pk2(S[t][4 * g4 + 0], S[t][4 * g4 + 1]); w.y = pk2(S[t][4 * g4 + 2], S[t][4 * g4 + 3]);
                *(LAS v2u*)(lds + LST + (32 * t + r32) * SR + (32 * wave + 8 * g4 + 4 * hi) * 2) = w; }
    }
    __syncthreads();
}
}

struct Args { const float* in[11]; float* out; unsigned char* ws; int pad0, pad1; };
__global__ void __launch_bounds__(NWAVES * 64, 2) fwd_mk(Args args) {
    extern __shared__ __attribute__((aligned(16))) unsigned char lds_raw[];
    cg::grid_group grid = cg::this_grid();
    LAS unsigned char* lds = (LAS unsigned char*)lds_raw;
    int tid = threadIdx.x, lane = tid & 63, wave = __builtin_amdgcn_readfirstlane(tid >> 6);
#define RETID() do { tid = threadIdx.x; asm volatile("" : "+v"(tid)); lane = tid & 63; wave = __builtin_amdgcn_readfirstlane(tid >> 6); gw = vcu * NWAVES + wave; RELOAD(); } while (0)
    constexpr int G = 256; const int bx = blockIdx.x, vcu = (bx % 8) * (G / 8) + bx / 8;
    int gw = vcu * NWAVES + wave; constexpr int NGW = G * NWAVES;
    LAS unsigned long long* ptab = (LAS unsigned long long*)(lds + LDS_BYTES - 128);
    if (tid == 0) {
        ptab[0] = (unsigned long long)args.in[0]; ptab[1] = (unsigned long long)args.in[1]; ptab[2] = (unsigned long long)args.in[2]; ptab[3] = (unsigned long long)args.in[3];
        ptab[4] = (unsigned long long)args.in[4]; ptab[5] = (unsigned long long)args.in[5]; ptab[6] = (unsigned long long)args.in[6]; ptab[7] = (unsigned long long)args.in[7];
        ptab[8] = (unsigned long long)args.in[8]; ptab[9] = (unsigned long long)args.in[9]; ptab[10] = (unsigned long long)args.in[10]; ptab[11] = (unsigned long long)args.out; ptab[12] = (unsigned long long)args.ws; }
    __syncthreads();
#define LDP(i) ({ const unsigned long long v_ = ptab[(i) + pz_]; (((unsigned long long)(unsigned)__builtin_amdgcn_readfirstlane((int)(v_ >> 32))) << 32) | (unsigned long long)(unsigned)__builtin_amdgcn_readfirstlane((int)(unsigned)v_); })
#define RELOAD() do { int pz_ = 0; asm volatile("" : "+v"(pz_) :: "memory"); ws = (unsigned char*)LDP(12); out = (float*)LDP(11); in.x = (const float*)LDP(0); in.gmix = (const float*)LDP(1); in.gffn = (const float*)LDP(2); in.ewin = (const float*)LDP(3); in.ebf = (const float*)LDP(4); \
        in.ewout = (const float*)LDP(5); in.owin = (const float*)LDP(6); in.owout = (const float*)LDP(7); in.f1 = (const float*)LDP(8); in.f2 = (const float*)LDP(9); in.gfin = (const float*)LDP(10); \
        XN = (bf16*)(ws + WS_XN); LOGF = (float*)(ws + WS_LOGF); CUM = (float*)(ws + WS_CUM); LSE = (float*)(ws + WS_LSE); } while (0)
    unsigned char* ws; float* out; Ins in; bf16* XN; float* LOGF; float* CUM; float* LSE;
    RELOAD();
    p0_prologue(in, ws, lds, gw, NGW, wave, lane);
    __syncthreads();
#pragma unroll 1
    for (int layer = 0; layer < DEPTH; ++layer) {
        const int li = layer >> 1; const bool even = (layer & 1) == 0;
        RETID();
#define XIN ((layer == 0) ? in.x : out)
        rms_phase(XIN, in.gmix + layer * DM, XN, even ? in.ewin + (size_t)li * DM * EVEN_IN + EVEN_N : nullptr, in.ebf + li * 8, LOGF, lds, gw, NGW, tid, lane);
        grid.sync();
        if (even) {
            RETID();
            if (bx < BATCH) cumsum_bh(LOGF, CUM, bx, wave, lane);
            RETID();
            { pg8::Gemm g{XN, (const bf16*)(ws + WS_EIN) + (size_t)li * EVEN_N * DM, M, EVEN_N, DM}; pg8::StaticOrder S; S.init(M, EVEN_N, G, bx);
              pg8::EpiSplit<0> E{(bf16*)(ws + WS_ACT), 512, 512, SEG / 2, 3, attn_body::C2};
              pg8::gemm_phase<pg8::EpiSplit<0>, pg8::StaticOrder, PG8_ALIGN, PG8_SP2>(lds, g, S, E); }
            grid.sync();
            { const attn_body::AttnTensors AT{(const attn_body::bf16*)(ws + WS_ACT + 3 * SEG), (const attn_body::bf16*)(ws + WS_ACT + 4 * SEG), (const attn_body::bf16*)(ws + WS_ACT + 5 * SEG),
                                              (attn_body::bf16*)(ws + WS_AO) + 512, CUM};
              const attn_body::StaticOrder S(G, bx);
#ifndef NO_FOX
              attn_body::attn_phase<attn_body::StaticOrder>((char*)lds_raw, AT, S);
#endif
 }
            __syncthreads(); RETID();
            for (int u = vcu; u < BATCH * 8 * 3 * 16; u += G) {
                const int j = u & 15, g3 = (u >> 4) % 3, bh = u / 48, b = bh >> 3, h = bh & 7;
                int sr, np; if (g3 == 0) { sr = 0; np = j; } else if (g3 == 1) { sr = j >> 2; np = j & 3; } else { sr = j; np = 0; }
#ifndef NO_DIL
                dil::unit(b, h, g3, sr, np, (const bf16*)(ws + WS_ACT), (const bf16*)(ws + WS_ACT + SEG), (const bf16*)(ws + WS_ACT + 2 * SEG),
                          (bf16*)(ws + WS_OG + (size_t)g3 * SEG), LSE + (size_t)g3 * M * 8, lds, tid, wave, lane);
#endif
 }
            grid.sync();
            RETID();
            for (int m = gw; m < M; m += NGW) { const int hh = lane >> 3;
                const float l0 = LSE[(size_t)m * 8 + hh], l1 = LSE[(size_t)M * 8 + (size_t)m * 8 + hh], l2 = LSE[(size_t)2 * M * 8 + (size_t)m * 8 + hh];
                const float mx = fmaxf(l0, fmaxf(l1, l2)); float w0 = __builtin_amdgcn_exp2f(l0 - mx), w1 = __builtin_amdgcn_exp2f(l1 - mx), w2 = __builtin_amdgcn_exp2f(l2 - mx); const float inv = 1.0f / (w0 + w1 + w2); w0 *= inv; w1 *= inv; w2 *= inv;
                const v4u a = *((const v4u*)((const bf16*)(ws + WS_OG) + (size_t)m * 512) + lane), bq = *((const v4u*)((const bf16*)(ws + WS_OG + SEG) + (size_t)m * 512) + lane), c = *((const v4u*)((const bf16*)(ws + WS_OG + 2 * SEG) + (size_t)m * 512) + lane);
                v4u o;
#define CMB(f) { const float lo = w0 * __builtin_bit_cast(float, a.f << 16) + w1 * __builtin_bit_cast(float, bq.f << 16) + w2 * __builtin_bit_cast(float, c.f << 16); \
                 const float hi_ = w0 * __builtin_bit_cast(float, a.f & 0xffff0000u) + w1 * __builtin_bit_cast(float, bq.f & 0xffff0000u) + w2 * __builtin_bit_cast(float, c.f & 0xffff0000u); o.f = pk2(lo, hi_); }
                CMB(x) CMB(y) CMB(z) CMB(w)
#undef CMB
                *((v4u*)((bf16*)(ws + WS_AO) + (size_t)m * 1024) + lane) = o; }
            grid.sync();
            RETID();
            { pg8::Gemm g{(const bf16*)(ws + WS_AO), (const bf16*)(ws + WS_EOUT) + (size_t)li * DM * DM, M, DM, DM}; pg8::StaticOrder S; S.init(M, DM, G, bx);
              pg8::EpiRes E{XIN, out, DM};
              pg8::gemm_phase<pg8::EpiRes, pg8::StaticOrder, PG8_ALIGN, PG8_SP2>(lds, g, S, E); }
        } else {
            RETID();
            { pg8::Gemm g{XN, (const bf16*)(ws + WS_OIN) + (size_t)li * ODD_IN * DM, M, ODD_IN, DM}; pg8::StaticOrder S; S.init(M, ODD_IN, G, bx);
              pg8::EpiOddIn E{(bf16*)(ws + WS_RQ), (bf16*)(ws + WS_RK), (bf16*)(ws + WS_RV), (bf16*)(ws + WS_RG)};
              pg8::gemm_phase<pg8::EpiOddIn, pg8::StaticOrder, PG8_ALIGN, PG8_SP2>(lds, g, S, E); }
            grid.sync();
            RETID();
            for (int u = vcu; u < BATCH * 4 * 4; u += G) { const int vs = u & 3, bh = u >> 2;
#ifndef NO_RET
                ret::unit(bh >> 2, bh & 3, vs, (const bf16*)(ws + WS_RQ), (const bf16*)(ws + WS_RK), (bf16*)(ws + WS_RV), lds, tid, wave, lane);
#endif
 }
            grid.sync();
            RETID();
            for (int it = gw; it < M * 4; it += NGW) { const size_t off = (size_t)(it >> 2) * 2048 + (it & 3) * 512 + lane * 8;
                const v4u ov = *(const v4u*)((const bf16*)(ws + WS_RV) + off), gv = *(const v4u*)((const bf16*)(ws + WS_RG) + off);
                float o[8], gg[8];
                o[0] = __builtin_bit_cast(float, ov.x << 16); o[1] = __builtin_bit_cast(float, ov.x & 0xffff0000u); o[2] = __builtin_bit_cast(float, ov.y << 16); o[3] = __builtin_bit_cast(float, ov.y & 0xffff0000u);
                o[4] = __builtin_bit_cast(float, ov.z << 16); o[5] = __builtin_bit_cast(float, ov.z & 0xffff0000u); o[6] = __builtin_bit_cast(float, ov.w << 16); o[7] = __builtin_bit_cast(float, ov.w & 0xffff0000u);
                gg[0] = __builtin_bit_cast(float, gv.x << 16); gg[1] = __builtin_bit_cast(float, gv.x & 0xffff0000u); gg[2] = __builtin_bit_cast(float, gv.y << 16); gg[3] = __builtin_bit_cast(float, gv.y & 0xffff0000u);
                gg[4] = __builtin_bit_cast(float, gv.z << 16); gg[5] = __builtin_bit_cast(float, gv.z & 0xffff0000u); gg[6] = __builtin_bit_cast(float, gv.w << 16); gg[7] = __builtin_bit_cast(float, gv.w & 0xffff0000u);
                float s = 0.f;
#pragma unroll
                for (int e = 0; e < 8; ++e) s += o[e];
                const float mu = wave_sum(s) * (1.f / 512.f); float q = 0.f;
#pragma unroll
                for (int e = 0; e < 8; ++e) { o[e] -= mu; q += o[e] * o[e]; }
                const float rs = 1.0f / sqrtf(wave_sum(q) * (1.f / 512.f) + GN_EPS);
                float y[8];
#pragma unroll
                for (int e = 0; e < 8; ++e) y[e] = gg[e] / (1.0f + __expf(-gg[e])) * (o[e] * rs);
                v4u w; w.x = pk2(y[0], y[1]); w.y = pk2(y[2], y[3]); w.z = pk2(y[4], y[5]); w.w = pk2(y[6], y[7]);
                *(v4u*)((bf16*)(ws + WS_RG) + off) = w; }
            grid.sync();
            RETID();
            { pg8::Gemm g{(const bf16*)(ws + WS_RG), (const bf16*)(ws + WS_OOUT) + (size_t)li * 2 * DM * DM, M, DM, 2 * DM}; pg8::StaticOrder S; S.init(M, DM, G, bx);
              pg8::EpiRes E{XIN, out, DM};
              pg8::gemm_phase<pg8::EpiRes, pg8::StaticOrder, PG8_ALIGN, PG8_SP2>(lds, g, S, E); }
        }
        grid.sync();
        RETID();
        rms_phase(out, in.gffn + layer * DM, XN, nullptr, nullptr, LOGF, lds, gw, NGW, tid, lane);
        grid.sync();
        RETID();
        { pg8::Gemm g{XN, (const bf16*)(ws + WS_F1) + (size_t)layer * FF * DM, M, FF, DM}; pg8::StaticOrder S; S.init(M, FF, G, bx);
          pg8::EpiSplit<2> E{(bf16*)(ws + WS_H), FF, 0, 0, -1, 1.f};
          pg8::gemm_phase<pg8::EpiSplit<2>, pg8::StaticOrder, PG8_ALIGN, PG8_SP2>(lds, g, S, E); }
        grid.sync();
        RETID();
        { pg8::Gemm g{(const bf16*)(ws + WS_H), (const bf16*)(ws + WS_F2) + (size_t)layer * FF * DM, M, DM, FF}; pg8::StaticOrder S; S.init(M, DM, G, bx);
          pg8::EpiRes E{out, out, DM};
          pg8::gemm_phase<pg8::EpiRes, pg8::StaticOrder, PG8_ALIGN, PG8_SP2>(lds, g, S, E); }
        grid.sync();
    }
    RETID();
    { f32x4 gv[4];
#pragma unroll
      for (int j = 0; j < 4; ++j) gv[j] = *((const f32x4*)in.gfin + lane + 64 * j);
      for (int m = gw; m < M; m += NGW) { f32x4* xr = (f32x4*)(out + (size_t)m * DM) + lane; f32x4 v[4]; float s = 0.f;
#pragma unroll
          for (int j = 0; j < 4; ++j) { v[j] = xr[64 * j]; s += (v[j].x * v[j].x + v[j].y * v[j].y) + (v[j].z * v[j].z + v[j].w * v[j].w); }
          const float rstd = 1.0f / sqrtf(wave_sum(s) * (1.f / DM) + RMS_EPS);
#pragma unroll
          for (int j = 0; j < 4; ++j) xr[64 * j] = v[j] * rstd * gv[j]; } }
}

extern "C" void kernel_launch(void* const* d_in, const int* in_sizes, int n_in, void* d_out, int out_size, void* d_ws, size_t ws_size, hipStream_t stream) {
    static int grid = 0;
    if (grid == 0) {
        if (n_in != 11 || in_sizes[0] != M * DM || out_size != M * DM || ws_size < WS_END) { fprintf(stderr, "kernel_launch: unexpected shapes (n_in %d, ws %zu)\n", n_in, ws_size); grid = -1; return; }
        if (hipFuncSetAttribute((const void*)fwd_mk, hipFuncAttributeMaxDynamicSharedMemorySize, LDS_BYTES) != hipSuccess) { fprintf(stderr, "kernel_launch: hipFuncSetAttribute failed\n"); grid = -1; return; }
        int dev = 0, cus = 0, per_cu = 0;
        hipGetDevice(&dev); hipDeviceGetAttribute(&cus, hipDeviceAttributeMultiprocessorCount, dev);
        hipOccupancyMaxActiveBlocksPerMultiprocessor(&per_cu, (const void*)fwd_mk, NWAVES * 64, LDS_BYTES);
        (void)hipGetLastError();
        if (per_cu < 1) per_cu = 1;
        grid = cus;
        if (grid != 256) { fprintf(stderr, "kernel_launch: built for a 256-CU device, found %d\n", cus); grid = -1; return; }
    }
    if (grid < 0) return;
    Args a{};
    for (int i = 0; i < 11; ++i) a.in[i] = (const float*)d_in[i];
    a.out = (float*)d_out; a.ws = (unsigned char*)d_ws;
    void* kargs[] = {&a};
    hipError_t e = hipLaunchCooperativeKernel((const void*)fwd_mk, dim3(grid), dim3(NWAVES * 64), kargs, LDS_BYTES, stream);
    if (e != hipSuccess) fprintf(stderr, "cooperative launch failed: %s (grid %d)\n", hipGetErrorString(e), grid);
}
```

```cpp
#include <hip/hip_runtime.h>
#include <cstdio>
#include <cstdint>
namespace pg8 {
#define PG8_LAS __attribute__((address_space(3)))
typedef unsigned short bf16_t;
typedef short bf16x8 __attribute__((ext_vector_type(8)));
typedef float f32x4 __attribute__((ext_vector_type(4)));
typedef unsigned u32x4 __attribute__((ext_vector_type(4)));
constexpr int BM = 256, BK = 64, HALF = 128, HTB = HALF * BK * 2  , STAGE_BYTES = 8 * HTB, NXCD = 8, WGM = 8;

__host__ __device__ __forceinline__ int lds_byte(int r, int c) { const int st = (r >> 4) * 2 + (c >> 5), rr = r & 15, cc = c & 31, ob = rr * 64 + cc * 2; return st * 1024 + (ob ^ (((ob >> 9) & 1) << 5)); }
__host__ __device__ __forceinline__ void stage_rc(int b, int& R, int& C) { const int st = b / 1024, sb = b % 1024, swz = sb ^ (((sb >> 9) & 1) << 5); R = (st >> 1) * 16 + swz / 64; C = (st & 1) * 32 + (swz % 64) / 2; }
__host__ __device__ __forceinline__ int perm32(int rho) { const int n = rho >> 4, i = rho & 15; return 8 * (i >> 2) + 4 * n + (i & 3); }

struct Unit { int pm, pn; };
struct Gemm { const bf16_t* A; const bf16_t* Bt; int M, N, K; };

struct StaticOrder {
    int nM, nN, nwg, G, c;
    __host__ __device__ void init(int M, int N, int G_, int c_) { nM = M / BM; nN = N / BM; nwg = nM * nN; G = G_; c = c_; }
    __host__ __device__ bool next(int i, Unit& u) const {
        const long L = (long)i * G + c; if (L >= nwg) return false;
        int wgid = (int)L; { const int q = nwg / NXCD, r = nwg % NXCD, xcd = wgid % NXCD, off = wgid / NXCD; wgid = (xcd < r ? xcd * (q + 1) : r * (q + 1) + (xcd - r) * q) + off; }
        const int nig = WGM * nN, gid = wgid / nig, fm = gid * WGM, gsz = (nM - fm) < WGM ? (nM - fm) : WGM;
        u.pm = fm + ((wgid % nig) % gsz); u.pn = (wgid % nig) / gsz; return true;
    }
    __device__ __forceinline__ void a_ready(const Unit&) const {}
    __device__ __forceinline__ void done(const Unit&) const {}
};

__device__ __forceinline__ unsigned cvt_pk_bf16(float lo, float hi) { unsigned r; asm volatile("v_cvt_pk_bf16_f32 %0, %1, %2" : "=v"(r) : "v"(lo), "v"(hi)); return r; }
typedef float f32x2 __attribute__((ext_vector_type(2)));
__device__ __forceinline__ f32x2 gelu_pk(f32x2 v) {
    const f32x2 av = __builtin_elementwise_abs(v), d = av * 0.2316418882f + 1.0f;
    f32x2 t; t.x = __builtin_amdgcn_rcpf(d.x); t.y = __builtin_amdgcn_rcpf(d.y);
    f32x2 q = t * 0.5307027145f + (-0.7265760135f); q = q * t + 0.7107068705f; q = q * t + (-0.142248368f); q = q * t + 0.127414796f; q = q * t;
    const f32x2 s = (v * v) * (-0.72134752044f);
    f32x2 e; e.x = __builtin_amdgcn_exp2f(s.x); e.y = __builtin_amdgcn_exp2f(s.y);
    const f32x2 m = v * (q * e), r = v - m;
    f32x2 o; o.x = v.x < 0.f ? m.x : r.x; o.y = v.y < 0.f ? m.y : r.y; return o;
}

template <int ACT  > struct EpiBf16 {
    static constexpr bool PERM = true, AFTER_DRAIN = false; static_assert(ACT == 0 || ACT == 1, "EpiBf16: ACT is 0 (none) or 1 (gelu_pk)");
    bf16_t* O; int ldc; const float* bias; int split_cols; size_t split_stride; float scale0;
    __device__ __forceinline__ void operator()(const f32x4 (&acc)[2][2][4][2], const Unit& u, int wr, int wc, int fr, int fq) const {
        const int row0 = u.pm * BM + wr * 64 + fr; int colt = u.pn * BM; bf16_t* base = O;
        float sc = 1.f; if (split_cols) { const int t = colt / split_cols; base += (size_t)t * split_stride; colt -= t * split_cols; if (t == 0) sc = scale0; }
        const int col0 = colt + wc * 32 + 8 * fq, bcol0 = u.pn * BM + wc * 32 + 8 * fq;
        f32x4 bv[2][2];
#pragma unroll
        for (int bj = 0; bj < 2; ++bj)
#pragma unroll
            for (int n = 0; n < 2; ++n) bv[bj][n] = bias ? *(const f32x4*)(bias + bcol0 + bj * HALF + 4 * n) : (f32x4){0.f, 0.f, 0.f, 0.f};
#pragma unroll
        for (int ai = 0; ai < 2; ++ai)
#pragma unroll
            for (int m = 0; m < 4; ++m) { bf16_t* rowp = base + (size_t)(row0 + ai * HALF + m * 16) * ldc + col0;
#pragma unroll
                for (int bj = 0; bj < 2; ++bj) { f32x4 v0 = acc[ai][bj][m][0] + bv[bj][0], v1 = acc[ai][bj][m][1] + bv[bj][1];
                    if (ACT == 1) { f32x2 a = gelu_pk((f32x2){v0[0], v0[1]}), b = gelu_pk((f32x2){v0[2], v0[3]}), c = gelu_pk((f32x2){v1[0], v1[1]}), d = gelu_pk((f32x2){v1[2], v1[3]});
                        v0 = (f32x4){a.x, a.y, b.x, b.y}; v1 = (f32x4){c.x, c.y, d.x, d.y}; }
                    v0 = v0 * sc; v1 = v1 * sc; u32x4 w; w.x = cvt_pk_bf16(v0[0], v0[1]); w.y = cvt_pk_bf16(v0[2], v0[3]); w.z = cvt_pk_bf16(v1[0], v1[1]); w.w = cvt_pk_bf16(v1[2], v1[3]);
                    *(u32x4*)(rowp + bj * HALF) = w; } }
    }
};

struct PanelStats {
    unsigned* xbuf;
    unsigned* cnt;
    unsigned* tmo;
    int ntn; float eps;
    unsigned code;
    __device__ __forceinline__ bool run(const f32x4 (&v)[2][2][4][2], const Unit& u, int wr, int wc, int fr, int fq, PG8_LAS unsigned char* lds, int wid, int lane) const {
        typedef float f32x2v __attribute__((ext_vector_type(2)));
        PG8_LAS f32x2v* P = (PG8_LAS f32x2v*)lds;
        PG8_LAS f32x2v* S = (PG8_LAS f32x2v*)(lds + 8192);
        PG8_LAS unsigned* flag = (PG8_LAS unsigned*)(lds + 8192 + 2048);
#pragma unroll
        for (int ai = 0; ai < 2; ++ai)
#pragma unroll
            for (int m = 0; m < 4; ++m) {
                float s = 0.f;
#pragma unroll
                for (int bj = 0; bj < 2; ++bj)
#pragma unroll
                    for (int n = 0; n < 2; ++n) { const f32x4 x = v[ai][bj][m][n]; s += (x[0] + x[1]) + (x[2] + x[3]); }
                s += __shfl_xor(s, 16); s += __shfl_xor(s, 32);
                const float mw = s * (1.0f / 64.0f); float q = 0.f;
#pragma unroll
                for (int bj = 0; bj < 2; ++bj)
#pragma unroll
                    for (int n = 0; n < 2; ++n) { const f32x4 d = v[ai][bj][m][n] - mw; q += (d[0] * d[0] + d[1] * d[1]) + (d[2] * d[2] + d[3] * d[3]); }
                q += __shfl_xor(q, 16); q += __shfl_xor(q, 32);
                if (fq == 0) P[(ai * HALF + wr * 64 + m * 16 + fr) * 4 + wc] = (f32x2v){mw, q};
            }
        asm volatile("s_waitcnt lgkmcnt(0)" ::: "memory"); __builtin_amdgcn_s_barrier(); asm volatile("" ::: "memory");
#if defined(BROKEN_EXCHANGE_NO_WAIT)
#warning BROKEN CONTROL BUILD: the row-statistics exchange does not wait; results are wrong by design
        if (blockIdx.x >= 64) { const long long t0_ = clock64(); while (clock64() - t0_ < 60000) __builtin_amdgcn_s_sleep(8); }
#endif
        const int row = wid * 32 + (lane & 31);
        if (lane < 32) {
            const f32x2v a = P[row * 4 + 0], b = P[row * 4 + 1], c = P[row * 4 + 2], d = P[row * 4 + 3];
            const float mt = (a.x + b.x + c.x + d.x) * 0.25f;
            const float da = a.x - mt, db = b.x - mt, dc = c.x - mt, dd = d.x - mt;
            const float m2 = (a.y + b.y) + (c.y + d.y) + 64.0f * ((da * da + db * db) + (dc * dc + dd * dd));
            unsigned long long* slot = (unsigned long long*)xbuf + ((size_t)(u.pm * BM + row) * 4 + u.pn);
            __hip_atomic_store(slot, ((unsigned long long)__float_as_uint(m2) << 32) | __float_as_uint(mt), __ATOMIC_RELAXED, __HIP_MEMORY_SCOPE_AGENT);
        }
        asm volatile("s_waitcnt vmcnt(0)" ::: "memory");
        if (lane == 0) __hip_atomic_fetch_add(cnt + 64 * u.pm, 1u, __ATOMIC_RELAXED, __HIP_MEMORY_SCOPE_AGENT);
        if (wid == 0) {
            bool dead = false; const unsigned long long t0 = __builtin_amdgcn_s_memrealtime(); const unsigned want = 8u * (unsigned)ntn;
            for (;;) {
#if defined(BROKEN_EXCHANGE_NO_WAIT)
                break;
#endif
                if ((unsigned)__builtin_amdgcn_readfirstlane(__hip_atomic_load(cnt + 64 * u.pm, __ATOMIC_RELAXED, __HIP_MEMORY_SCOPE_AGENT)) >= want) break;
                if (__builtin_amdgcn_s_memrealtime() - t0 > 2000000ull) {
                    if (lane == 0) { unsigned expect = 0u; __hip_atomic_compare_exchange_strong(tmo + 1, &expect, code | (unsigned)(u.pm & 0xff), __ATOMIC_RELAXED, __ATOMIC_RELAXED, __HIP_MEMORY_SCOPE_AGENT);
                                     __hip_atomic_store(tmo, 1u, __ATOMIC_RELAXED, __HIP_MEMORY_SCOPE_AGENT); }
                    dead = true; break; }
                __builtin_amdgcn_s_sleep(2);
            }
            __builtin_amdgcn_fence(__ATOMIC_ACQUIRE, "agent");
            if (lane == 0) flag[0] = dead ? 1u : 0u;
        }
        asm volatile("s_waitcnt vmcnt(0) lgkmcnt(0)" ::: "memory"); __builtin_amdgcn_s_barrier(); asm volatile("" ::: "memory");
        const bool bad = flag[0] != 0u;
        if (lane < 32) {
            const unsigned long long* slot = (const unsigned long long*)xbuf + (size_t)(u.pm * BM + row) * 4; float mt[4], m2[4]; float ms = 0.f;
#pragma unroll
            for (int t = 0; t < 4; ++t) { if (t < ntn) { const unsigned long long w = __hip_atomic_load(slot + t, __ATOMIC_RELAXED, __HIP_MEMORY_SCOPE_AGENT); mt[t] = __uint_as_float((unsigned)w); m2[t] = __uint_as_float((unsigned)(w >> 32)); } else { mt[t] = 0.f; m2[t] = 0.f; } ms += mt[t]; }
            const float mean = ms / (float)ntn; float q = 0.f;
#pragma unroll
            for (int t = 0; t < 4; ++t) if (t < ntn) { const float dm = mt[t] - mean; q += m2[t] + 256.0f * dm * dm; }
            S[row] = (f32x2v){mean, 1.0f / sqrtf(q / (256.0f * (float)ntn) + eps)};
        }
        asm volatile("s_waitcnt lgkmcnt(0)" ::: "memory"); __builtin_amdgcn_s_barrier(); asm volatile("" ::: "memory");
        return bad;
    }
};
struct EpiLnRes {
    static constexpr bool PERM = false, AFTER_DRAIN = true;
    const float* base; float* out; int ldc; const float* bias; PanelStats st; unsigned poison;
    __device__ __forceinline__ void fused(f32x4 (&acc)[2][2][4][2], const Unit& u, int wr, int wc, int fr, int fq, PG8_LAS unsigned char* lds, int wid, int lane) const {
        typedef float f32x2v __attribute__((ext_vector_type(2)));
        const PG8_LAS f32x2v* S = (const PG8_LAS f32x2v*)(lds + 8192);
        const int col0 = u.pn * BM + wc * 32 + 4 * fq;
#pragma unroll
        for (int bj = 0; bj < 2; ++bj)
#pragma unroll
            for (int n = 0; n < 2; ++n) { const f32x4 bv = bias ? *(const f32x4*)(bias + col0 + bj * HALF + n * 16) : (f32x4){0.f, 0.f, 0.f, 0.f};
#pragma unroll
                for (int ai = 0; ai < 2; ++ai)
#pragma unroll
                    for (int m = 0; m < 4; ++m) acc[ai][bj][m][n] += bv; }
        f32x4 pre[4][2][2];
#pragma unroll
        for (int m = 0; m < 4; ++m) { const size_t off = (size_t)(u.pm * BM + wr * 64 + m * 16 + fr) * ldc + col0;
#pragma unroll
            for (int bj = 0; bj < 2; ++bj)
#pragma unroll
                for (int n = 0; n < 2; ++n) pre[m][bj][n] = *(const f32x4*)(base + off + bj * HALF + n * 16); }
        const bool bad = st.run(acc, u, wr, wc, fr, fq, lds, wid, lane) || poison != 0u;
        const float qnan = __builtin_nanf("");
#pragma unroll
        for (int ai = 0; ai < 2; ++ai)
#pragma unroll
            for (int m = 0; m < 4; ++m) { const int r = ai * HALF + wr * 64 + m * 16 + fr; const f32x2v sr = S[r]; const size_t off = (size_t)(u.pm * BM + r) * ldc + col0;
#pragma unroll
                for (int bj = 0; bj < 2; ++bj)
#pragma unroll
                    for (int n = 0; n < 2; ++n) { const f32x4 bs = ai == 0 ? pre[m][bj][n] : *(const f32x4*)(base + off + bj * HALF + n * 16); f32x4 o = bs + (acc[ai][bj][m][n] - sr.x) * sr.y;
                        if (bad) o = (f32x4){qnan, qnan, qnan, qnan}; *(f32x4*)(out + off + bj * HALF + n * 16) = o; }
                if (m & 1) asm volatile("" ::: "memory"); }
    }
};
struct EpiLnResLn {
    static constexpr bool PERM = false, AFTER_DRAIN = true;
    const float* base; float* out; bf16_t* xn; int ldc; const float* bias; PanelStats st1, st2; unsigned poison;
    __device__ __forceinline__ void fused(f32x4 (&acc)[2][2][4][2], const Unit& u, int wr, int wc, int fr, int fq, PG8_LAS unsigned char* lds, int wid, int lane) const {
        typedef float f32x2v __attribute__((ext_vector_type(2))); typedef unsigned u32x2v __attribute__((ext_vector_type(2)));
        const PG8_LAS f32x2v* S = (const PG8_LAS f32x2v*)(lds + 8192);
        const int col0 = u.pn * BM + wc * 32 + 4 * fq;
#pragma unroll
        for (int bj = 0; bj < 2; ++bj)
#pragma unroll
            for (int n = 0; n < 2; ++n) { const f32x4 bv = bias ? *(const f32x4*)(bias + col0 + bj * HALF + n * 16) : (f32x4){0.f, 0.f, 0.f, 0.f};
#pragma unroll
                for (int ai = 0; ai < 2; ++ai)
#pragma unroll
                    for (int m = 0; m < 4; ++m) acc[ai][bj][m][n] += bv; }
        bool bad = st1.run(acc, u, wr, wc, fr, fq, lds, wid, lane) || poison != 0u;
        const float qnan = __builtin_nanf("");
#pragma unroll
        for (int ai = 0; ai < 2; ++ai)
#pragma unroll
            for (int m = 0; m < 4; ++m) { const int r = ai * HALF + wr * 64 + m * 16 + fr; const f32x2v sr = S[r]; const size_t off = (size_t)(u.pm * BM + r) * ldc + col0;
#pragma unroll
                for (int bj = 0; bj < 2; ++bj)
#pragma unroll
                    for (int n = 0; n < 2; ++n) { const f32x4 bs = *(const f32x4*)(base + off + bj * HALF + n * 16); acc[ai][bj][m][n] = bs + (acc[ai][bj][m][n] - sr.x) * sr.y; }
                asm volatile("" : "+v"(acc[ai][0][m][0]), "+v"(acc[ai][0][m][1]), "+v"(acc[ai][1][m][0]), "+v"(acc[ai][1][m][1]));
                if (m & 1) asm volatile("" ::: "memory"); }
        const bool bad1 = bad;
        bad = st2.run(acc, u, wr, wc, fr, fq, lds, wid, lane) || bad;
#pragma unroll
        for (int ai = 0; ai < 2; ++ai)
#pragma unroll
            for (int m = 0; m < 4; ++m) { const int r = ai * HALF + wr * 64 + m * 16 + fr; const f32x2v sr = S[r]; const size_t off = (size_t)(u.pm * BM + r) * ldc + col0;
#pragma unroll
                for (int bj = 0; bj < 2; ++bj)
#pragma unroll
                    for (int n = 0; n < 2; ++n) { const f32x4 x1 = acc[ai][bj][m][n]; *(f32x4*)(out + off + bj * HALF + n * 16) = bad1 ? (f32x4){qnan, qnan, qnan, qnan} : x1;
                        const f32x4 o = (x1 - sr.x) * sr.y; u32x2v w; w.x = cvt_pk_bf16(o[0], o[1]); w.y = cvt_pk_bf16(o[2], o[3]);
                        if (bad) { w.x = 0x7fc07fc0u; w.y = 0x7fc07fc0u; } *(u32x2v*)(xn + off + bj * HALF + n * 16) = w; }
                asm volatile("" ::: "memory"); }
    }
};

template <bool F16> __device__ __forceinline__ f32x4 mma16(bf16x8 b, bf16x8 a, f32x4 c) {
    if constexpr (F16) { typedef _Float16 h8_t __attribute__((ext_vector_type(8))); return __builtin_amdgcn_mfma_f32_16x16x32_f16(__builtin_bit_cast(h8_t, b), __builtin_bit_cast(h8_t, a), c, 0, 0, 0); }
    else return __builtin_amdgcn_mfma_f32_16x16x32_bf16(b, a, c, 0, 0, 0);
}
template <class Epi, class Sched, bool ALIGN_EPI = false, bool SP2 = false, bool F16 = false>
__device__ __forceinline__ void gemm_phase(PG8_LAS unsigned char* lds, const Gemm g, const Sched& S, const Epi& E) {
#ifdef NO_GEMM
    return;
#endif
    int tid_l = threadIdx.x; asm volatile("" : "+v"(tid_l));
    const int tid = tid_l, wid = __builtin_amdgcn_readfirstlane(tid >> 6), lane = tid & 63, wr = wid >> 2, wc = wid & 3, fr = lane & 15, fq = lane >> 4;
    const int K = g.K, nt = K / BK;
    unsigned voffA[2], voffB[2];
#pragma unroll
    for (int i = 0; i < 2; ++i) { int R, C; stage_rc(tid * 16 + i * 8192, R, C); const int Rb = Epi::PERM ? ((R & ~31) + perm32(R & 31)) : R;
        voffA[i] = (unsigned)(R * K + C) * 2u; voffB[i] = (unsigned)(Rb * K + C) * 2u; }
    const size_t kstep = (size_t)(BK * 2);
    const size_t hstep = (size_t)HALF * K * 2;
    const size_t tstep = 2 * hstep;
    const unsigned ldsw = (unsigned)wid * 1024u;
    const int aoff = lds_byte(wr * 64 + fr, fq * 8), boff = lds_byte(wc * 32 + fr, fq * 8);
#define PG8_SA(b, h) (((b) * 2 + (h)) * HTB)
#define PG8_SB(b, h) ((4 + (b) * 2 + (h)) * HTB)
#define PG8_STAGE(bufoff, gbase, voff) do { _Pragma("unroll") for (int _i = 0; _i < 2; ++_i) \
        __builtin_amdgcn_global_load_lds((const unsigned*)((const char*)(gbase) + (voff)[_i]), (PG8_LAS unsigned*)(lds + (bufoff) + ldsw + _i * 8192), 16, 0, 0); } while (0)
#define PG8_LDA(dst, b, h) do { _Pragma("unroll") for (int m = 0; m < 4; ++m) _Pragma("unroll") for (int k = 0; k < 2; ++k) dst[m][k] = *(const PG8_LAS bf16x8*)(lds + PG8_SA(b, h) + aoff + m * 2048 + k * 1024); } while (0)
#define PG8_LDB(dst, b, h) do { _Pragma("unroll") for (int n = 0; n < 2; ++n) _Pragma("unroll") for (int k = 0; k < 2; ++k) dst[n][k] = *(const PG8_LAS bf16x8*)(lds + PG8_SB(b, h) + boff + n * 2048 + k * 1024); } while (0)
#define PG8_MMA(ai, bj, At, Bt) do { __builtin_amdgcn_s_setprio(1); _Pragma("unroll") for (int m = 0; m < 4; ++m) _Pragma("unroll") for (int n = 0; n < 2; ++n) _Pragma("unroll") for (int k = 0; k < 2; ++k) \
        acc[ai][bj][m][n] = mma16<F16>(Bt[n][k], At[m][k], acc[ai][bj][m][n]); __builtin_amdgcn_s_setprio(0); } while (0)
#define PG8_WAIT_V(n) asm volatile("s_waitcnt vmcnt(" #n ")" ::: "memory")
#define PG8_WAIT_L(n) asm volatile("s_waitcnt lgkmcnt(" #n ")" ::: "memory")
#define PG8_BAR __builtin_amdgcn_s_barrier()
#define PG8_SCHED __builtin_amdgcn_sched_barrier(0)
    Unit cur, nxt; int ui = 0;
    if (!S.next(0, cur)) return;
    f32x4 acc[2][2][4][2];
#pragma unroll
    for (int a = 0; a < 2; ++a)
#pragma unroll
        for (int b = 0; b < 2; ++b)
#pragma unroll
            for (int m = 0; m < 4; ++m)
#pragma unroll
                for (int n = 0; n < 2; ++n) acc[a][b][m][n] = (f32x4){0.f, 0.f, 0.f, 0.f};
    bf16x8 At[4][2], B0[2][2], B1[2][2];
    const char* cA = (const char*)g.A + (size_t)cur.pm * tstep; const char* cB = (const char*)g.Bt + (size_t)cur.pn * tstep;
    S.a_ready(cur);
    if constexpr (SP2) {
        PG8_STAGE(PG8_SB(0, 0), cB, voffB); PG8_STAGE(PG8_SB(0, 1), cB + hstep, voffB); PG8_STAGE(PG8_SA(0, 0), cA, voffA); PG8_STAGE(PG8_SA(0, 1), cA + hstep, voffA);
        if (wr == 1) PG8_BAR;
        PG8_WAIT_V(2); PG8_BAR;
        PG8_STAGE(PG8_SB(1, 0), cB + kstep, voffB); PG8_STAGE(PG8_SA(1, 0), cA + kstep, voffA); PG8_STAGE(PG8_SB(1, 1), cB + hstep + kstep, voffB);
        PG8_WAIT_V(6); PG8_BAR;
    } else {
        PG8_STAGE(PG8_SB(0, 0), cB, voffB); PG8_STAGE(PG8_SA(0, 0), cA, voffA); PG8_STAGE(PG8_SB(0, 1), cB + hstep, voffB); PG8_STAGE(PG8_SA(0, 1), cA + hstep, voffA);
        if (wr == 1) PG8_BAR;
        PG8_WAIT_V(4); PG8_BAR;
        PG8_STAGE(PG8_SB(1, 0), cB + kstep, voffB); PG8_STAGE(PG8_SA(1, 0), cA + kstep, voffA); PG8_STAGE(PG8_SB(1, 1), cB + hstep + kstep, voffB);
        PG8_WAIT_V(6); PG8_BAR;
    }
    for (;;) {
        const bool has_next = S.next(ui + 1, nxt);
        const char* nA = has_next ? (const char*)g.A + (size_t)nxt.pm * tstep : cA; const char* nB = has_next ? (const char*)g.Bt + (size_t)nxt.pn * tstep : cB;
        for (int t = 0; t < nt; t += 2) {
            const bool last = (t == nt - 2);
            const char* a1 = cA + (size_t)(t + 1) * kstep;
            const char* a2 = last ? nA : cA + (size_t)(t + 2) * kstep; const char* b2 = last ? nB : cB + (size_t)(t + 2) * kstep;
            const char* a3 = a2 + kstep; const char* b3 = b2 + kstep;
            if (last && has_next) S.a_ready(nxt);
            if constexpr (SP2) {
            PG8_LDB(B0, 0, 0); PG8_LDB(B1, 0, 1); PG8_SCHED; PG8_LDA(At, 0, 0); PG8_STAGE(PG8_SA(1, 1), a1 + hstep, voffA);
            PG8_WAIT_V(8); PG8_WAIT_L(0); PG8_BAR; PG8_MMA(0, 0, At, B0); PG8_MMA(0, 1, At, B1); PG8_BAR; PG8_SCHED;
            PG8_LDA(At, 0, 1); PG8_STAGE(PG8_SB(0, 0), b2, voffB); PG8_STAGE(PG8_SB(0, 1), b2 + hstep, voffB); PG8_STAGE(PG8_SA(0, 0), a2, voffA);
            PG8_WAIT_V(8); PG8_WAIT_L(0); PG8_BAR; PG8_MMA(1, 0, At, B0); PG8_MMA(1, 1, At, B1); PG8_BAR; PG8_SCHED;
            PG8_LDB(B0, 1, 0); PG8_LDB(B1, 1, 1); PG8_SCHED; PG8_LDA(At, 1, 0); PG8_STAGE(PG8_SA(0, 1), a2 + hstep, voffA);
            PG8_WAIT_V(8); PG8_WAIT_L(0); PG8_BAR; PG8_MMA(0, 0, At, B0); PG8_MMA(0, 1, At, B1); PG8_BAR; PG8_SCHED;
            PG8_LDA(At, 1, 1); PG8_STAGE(PG8_SB(1, 0), b3, voffB); PG8_STAGE(PG8_SB(1, 1), b3 + hstep, voffB); PG8_STAGE(PG8_SA(1, 0), a3, voffA);
            PG8_WAIT_V(8); PG8_WAIT_L(0); PG8_BAR; PG8_MMA(1, 0, At, B0); PG8_MMA(1, 1, At, B1); PG8_BAR; PG8_SCHED;
            } else {
            PG8_LDB(B0, 0, 0); PG8_SCHED; PG8_LDA(At, 0, 0); PG8_STAGE(PG8_SA(1, 1), a1 + hstep, voffA);
            PG8_WAIT_L(8); PG8_BAR; PG8_WAIT_L(0); PG8_MMA(0, 0, At, B0); PG8_BAR; PG8_SCHED;
            PG8_LDB(B1, 0, 1); PG8_STAGE(PG8_SB(0, 0), b2, voffB);
            PG8_BAR; PG8_WAIT_L(0); PG8_MMA(0, 1, At, B1); PG8_BAR;
            PG8_LDA(At, 0, 1); PG8_STAGE(PG8_SA(0, 0), a2, voffA);
            PG8_BAR; PG8_WAIT_L(0); PG8_MMA(1, 0, At, B0); PG8_BAR; PG8_SCHED;
            PG8_STAGE(PG8_SB(0, 1), b2 + hstep, voffB);
            PG8_WAIT_V(6); PG8_BAR; PG8_MMA(1, 1, At, B1); PG8_BAR;
            PG8_LDB(B0, 1, 0); PG8_SCHED; PG8_LDA(At, 1, 0); PG8_STAGE(PG8_SA(0, 1), a2 + hstep, voffA);
            PG8_WAIT_L(8); PG8_BAR; PG8_WAIT_L(0); PG8_MMA(0, 0, At, B0); PG8_BAR; PG8_SCHED;
            PG8_LDB(B1, 1, 1); PG8_STAGE(PG8_SB(1, 0), b3, voffB);
            PG8_BAR; PG8_WAIT_L(0); PG8_MMA(0, 1, At, B1); PG8_BAR;
            PG8_LDA(At, 1, 1); PG8_STAGE(PG8_SA(1, 0), a3, voffA);
            PG8_BAR; PG8_WAIT_L(0); PG8_MMA(1, 0, At, B0); PG8_BAR; PG8_SCHED;
            PG8_STAGE(PG8_SB(1, 1), b3 + hstep, voffB);
            PG8_WAIT_V(6); PG8_BAR; PG8_MMA(1, 1, At, B1); PG8_BAR;
            }
        }
        if constexpr (ALIGN_EPI) { if (wr == 0) PG8_BAR; }
        if constexpr (!Epi::AFTER_DRAIN) { E(acc, cur, wr, wc, fr, fq); S.done(cur); }
        if (!has_next) break;
#pragma unroll
        for (int a = 0; a < 2; ++a)
#pragma unroll
            for (int b = 0; b < 2; ++b)
#pragma unroll
                for (int m = 0; m < 4; ++m)
#pragma unroll
                    for (int n = 0; n < 2; ++n) acc[a][b][m][n] = (f32x4){0.f, 0.f, 0.f, 0.f};
        cur = nxt; cA = nA; cB = nB; ++ui;
        if constexpr (ALIGN_EPI) { if (wr == 1) PG8_BAR; }
    }
    PG8_WAIT_V(0);
    if constexpr (!ALIGN_EPI) { if (wr == 0) PG8_BAR; }
    PG8_BAR;
    if constexpr (Epi::AFTER_DRAIN) { E.fused(acc, cur, wr, wc, fr, fq, lds, wid, lane); S.done(cur); }
#undef PG8_SA
#undef PG8_SB
#undef PG8_STAGE
#undef PG8_LDA
#undef PG8_LDB
#undef PG8_MMA
#undef PG8_WAIT_V
#undef PG8_WAIT_L
#undef PG8_BAR
#undef PG8_SCHED
}
}

#ifndef PG8_SP2
#define PG8_SP2 true
#endif
#ifndef PG8_ALIGN
#define PG8_ALIGN true
#endif
namespace pg8 {
template <int ACT> struct EpiSplit {
    static constexpr bool PERM = true, AFTER_DRAIN = false;
    bf16_t* O; int ldc; int split_cols; size_t split_stride; int scale_t; float scale0; const float* ss;
    __device__ __forceinline__ void operator()(const f32x4 (&acc)[2][2][4][2], const Unit& u, int wr, int wc, int fr, int fq) const {
        const int row0 = u.pm * BM + wr * 64 + fr; int colt = u.pn * BM; bf16_t* base = O;
        float sc = 1.f; if (split_cols) { const int t = colt / split_cols; base += (size_t)t * split_stride; colt -= t * split_cols; if (t == scale_t) sc = scale0; }
        const int col0 = colt + wc * 32 + 8 * fq;
        float rs[2][4];
        if (ACT != 2) { f32x4 pp[2][4];
#pragma unroll
        for (int ai = 0; ai < 2; ++ai)
#pragma unroll
            for (int m = 0; m < 4; ++m) pp[ai][m] = *(const f32x4*)(ss + (size_t)(row0 + ai * HALF + m * 16) * 16 + 4 * fq);
        asm volatile("" ::: "memory");
#pragma unroll
        for (int ai = 0; ai < 2; ++ai)
#pragma unroll
            for (int m = 0; m < 4; ++m) { const f32x4 p = pp[ai][m]; float sq = (p[0] + p[1]) + (p[2] + p[3]);
                sq += __uint_as_float((unsigned)__builtin_amdgcn_ds_swizzle((int)__float_as_uint(sq), (16 << 10) | 0x1f));
                { auto rr = __builtin_amdgcn_permlane32_swap(__float_as_uint(sq), __float_as_uint(sq), false, false); sq = __uint_as_float(rr[0]) + __uint_as_float(rr[1]); }
                rs[ai][m] = __builtin_amdgcn_rsqf(sq * (1.0f / 1024.0f) + 1e-6f); } }
        else {
#pragma unroll
            for (int ai = 0; ai < 2; ++ai)
#pragma unroll
                for (int m = 0; m < 4; ++m) rs[ai][m] = 1.0f; }
#pragma unroll
        for (int ai = 0; ai < 2; ++ai)
#pragma unroll
            for (int m = 0; m < 4; ++m) { bf16_t* rowp = base + (size_t)(row0 + ai * HALF + m * 16) * ldc + col0;
#pragma unroll
                for (int bj = 0; bj < 2; ++bj) { f32x4 v0 = acc[ai][bj][m][0] * rs[ai][m], v1 = acc[ai][bj][m][1] * rs[ai][m];
                    if (ACT == 2) {
#pragma unroll
                        for (int e = 0; e < 4; ++e) { const float a = fmaxf(v0[e], 0.f), b = fmaxf(v1[e], 0.f); v0[e] = a * a; v1[e] = b * b; } }
                    v0 = v0 * sc; v1 = v1 * sc; u32x4 w; w.x = cvt_pk_bf16(v0[0], v0[1]); w.y = cvt_pk_bf16(v0[2], v0[3]); w.z = cvt_pk_bf16(v1[0], v1[1]); w.w = cvt_pk_bf16(v1[2], v1[3]);
                    *(u32x4*)(rowp + bj * HALF) = w; } }
    }
};
struct EpiOddIn {
    static constexpr bool PERM = true, AFTER_DRAIN = false;
    bf16_t *Q, *K, *V, *G; const float* ss;
    __device__ __forceinline__ void operator()(const f32x4 (&acc)[2][2][4][2], const Unit& u, int wr, int wc, int fr, int fq) const {
        const int row0 = u.pm * BM + wr * 64 + fr; const int pn = u.pn; bf16_t* base; int ldc, colt;
        if (pn < 4) { base = Q; ldc = 1024; colt = pn * BM; } else if (pn < 8) { base = K; ldc = 1024; colt = (pn - 4) * BM; }
        else if (pn < 16) { base = V; ldc = 2048; colt = (pn - 8) * BM; } else { base = G; ldc = 2048; colt = (pn - 16) * BM; }
        const int col0 = colt + wc * 32 + 8 * fq;
        float rs[2][4]; f32x4 pp[2][4];
#pragma unroll
        for (int ai = 0; ai < 2; ++ai)
#pragma unroll
            for (int m = 0; m < 4; ++m) pp[ai][m] = *(const f32x4*)(ss + (size_t)(row0 + ai * HALF + m * 16) * 16 + 4 * fq);
        asm volatile("" ::: "memory");
#pragma unroll
        for (int ai = 0; ai < 2; ++ai)
#pragma unroll
            for (int m = 0; m < 4; ++m) { const f32x4 p = pp[ai][m]; float sq = (p[0] + p[1]) + (p[2] + p[3]);
                sq += __uint_as_float((unsigned)__builtin_amdgcn_ds_swizzle((int)__float_as_uint(sq), (16 << 10) | 0x1f));
                { auto rr = __builtin_amdgcn_permlane32_swap(__float_as_uint(sq), __float_as_uint(sq), false, false); sq = __uint_as_float(rr[0]) + __uint_as_float(rr[1]); }
                rs[ai][m] = __builtin_amdgcn_rsqf(sq * (1.0f / 1024.0f) + 1e-6f); }
#pragma unroll
        for (int ai = 0; ai < 2; ++ai)
#pragma unroll
            for (int m = 0; m < 4; ++m) { bf16_t* rowp = base + (size_t)(row0 + ai * HALF + m * 16) * ldc + col0;
#pragma unroll
                for (int bj = 0; bj < 2; ++bj) { const f32x4 v0 = acc[ai][bj][m][0] * rs[ai][m], v1 = acc[ai][bj][m][1] * rs[ai][m];
                    u32x4 w; w.x = cvt_pk_bf16(v0[0], v0[1]); w.y = cvt_pk_bf16(v0[2], v0[3]); w.z = cvt_pk_bf16(v1[0], v1[1]); w.w = cvt_pk_bf16(v1[2], v1[3]);
                    *(u32x4*)(rowp + bj * HALF) = w; } }
    }
};
__device__ __forceinline__ unsigned cvt_pk_f16(float lo, float hi) { typedef _Float16 h2_t __attribute__((ext_vector_type(2))); const h2_t v = {(_Float16)lo, (_Float16)hi}; return __builtin_bit_cast(unsigned, v); }
__device__ __forceinline__ float f16lo(unsigned w) { typedef _Float16 h2_t __attribute__((ext_vector_type(2))); return (float)__builtin_bit_cast(h2_t, w)[0]; }
__device__ __forceinline__ float f16hi(unsigned w) { typedef _Float16 h2_t __attribute__((ext_vector_type(2))); return (float)__builtin_bit_cast(h2_t, w)[1]; }
#ifndef STREAM_F16
#define STREAM_F16 1
#endif
__device__ __forceinline__ unsigned st_pk(float lo, float hi) { return STREAM_F16 ? cvt_pk_f16(lo, hi) : cvt_pk_bf16(lo, hi); }
__device__ __forceinline__ float st_lo(unsigned w) { return STREAM_F16 ? f16lo(w) : __uint_as_float(w << 16); }
__device__ __forceinline__ float st_hi(unsigned w) { return STREAM_F16 ? f16hi(w) : __uint_as_float(w & 0xffff0000u); }
template <bool BASEF32> struct EpiRes {
    static constexpr bool PERM = false, AFTER_DRAIN = false;
    const float* basef; bf16_t* xb; int ldc; float* ss; const float* ss2;
    __device__ __forceinline__ void operator()(const f32x4 (&acc)[2][2][4][2], const Unit& u, int wr, int wc, int fr, int fq) const {
        typedef unsigned u32x2e __attribute__((ext_vector_type(2)));
        const int col0 = u.pn * BM + wc * 32 + 4 * fq;
#pragma unroll
        for (int ai = 0; ai < 2; ++ai)
#pragma unroll
        for (int mh = 0; mh < 2; ++mh) {
            f32x4 bs[2][2][2], pq[2]; float r2[2];
#pragma unroll
            for (int mm = 0; mm < 2; ++mm) { const int m = 2 * mh + mm; const size_t row = (size_t)(u.pm * BM + ai * HALF + wr * 64 + m * 16 + fr), off = row * ldc + col0;
                if (ss2) pq[mm] = *(const f32x4*)(ss2 + row * 16 + 4 * fq);
#pragma unroll
                for (int bj = 0; bj < 2; ++bj)
#pragma unroll
                    for (int n = 0; n < 2; ++n) {
                        if (BASEF32) bs[mm][bj][n] = *(const f32x4*)(basef + off + bj * HALF + n * 16);
                        else { const u32x2e w = *(const u32x2e*)(xb + off + bj * HALF + n * 16);
                            bs[mm][bj][n] = (f32x4){st_lo(w.x), st_hi(w.x), st_lo(w.y), st_hi(w.y)}; } } }
            asm volatile("" ::: "memory");
#pragma unroll
            for (int mm = 0; mm < 2; ++mm) { r2[mm] = 1.0f;
                if (ss2) { const f32x4 p = pq[mm]; float t = (p[0] + p[1]) + (p[2] + p[3]);
                    t += __uint_as_float((unsigned)__builtin_amdgcn_ds_swizzle((int)__float_as_uint(t), (16 << 10) | 0x1f));
                    { auto rr = __builtin_amdgcn_permlane32_swap(__float_as_uint(t), __float_as_uint(t), false, false); t = __uint_as_float(rr[0]) + __uint_as_float(rr[1]); }
                    r2[mm] = __builtin_amdgcn_rcpf(t * (1.0f / 1024.0f) + 1e-6f); } }
#pragma unroll
            for (int mm = 0; mm < 2; ++mm) { const int m = 2 * mh + mm; const size_t row = (size_t)(u.pm * BM + ai * HALF + wr * 64 + m * 16 + fr), off = row * ldc + col0;
                float sq = 0.f;
#pragma unroll
                for (int bj = 0; bj < 2; ++bj)
#pragma unroll
                    for (int n = 0; n < 2; ++n) { const f32x4 xn = bs[mm][bj][n] + acc[ai][bj][m][n] * r2[mm];
                        u32x2e w; w.x = st_pk(xn[0], xn[1]); w.y = st_pk(xn[2], xn[3]); *(u32x2e*)(xb + off + bj * HALF + n * 16) = w;
                        sq += (xn[0] * xn[0] + xn[1] * xn[1]) + (xn[2] * xn[2] + xn[3] * xn[3]); }
                sq += __uint_as_float((unsigned)__builtin_amdgcn_ds_swizzle((int)__float_as_uint(sq), (16 << 10) | 0x1f));
                { auto rr = __builtin_amdgcn_permlane32_swap(__float_as_uint(sq), __float_as_uint(sq), false, false); sq = __uint_as_float(rr[0]) + __uint_as_float(rr[1]); }
                if (fq == 0) ss[row * 16 + u.pn * 4 + wc] = sq; }
            asm volatile("" ::: "memory");
        }
    }
};
}
#include <hip/hip_bf16.h>
#include <cmath>
namespace attn_body {
using bf16=__hip_bfloat16;
using bf16x8=__attribute__((ext_vector_type(8)))short;
using s16x4=__attribute__((ext_vector_type(4)))short;
using f32x16=__attribute__((ext_vector_type(16)))float;
using u32x4=__attribute__((ext_vector_type(4)))unsigned;
constexpr int BATCH=16,NHEAD=8,SEQ=4096,D=64,DM=NHEAD*D,ODM=1024;
constexpr int NW=8,QBLK=32,QB=QBLK*NW,KVBLK=64,NQB=SEQ/QB;
constexpr int ATTN_PITCH=DM, ATTN_UNIT_ROWS=QB;
__device__ __forceinline__ int crow(int r,int hi){return (r&3)+8*(r>>2)+4*hi;}
#define SBAR() __builtin_amdgcn_sched_barrier(0)
__device__ __forceinline__ void cmask(f32x16&p0,f32x16&p1,int jb,int qrel,int hi){
  const float NEG=-INFINITY; int kb=64*jb+4*hi;
  #pragma unroll
  for(int r=0;r<16;++r){int kv=kb+(r&3)+8*(r>>2); if(kv>qrel)p0[r]=NEG; if(kv+32>qrel)p1[r]=NEG;}
}

constexpr int NSLOT=3, SLOTB=8192;
constexpr int LDS_K=0, LDS_V=NSLOT*SLOTB, LDS_WS=2*NSLOT*SLOTB, LDS_OST=LDS_WS+NW*64*4, LDS_CUM=LDS_OST+NW*4096,LDS_KN=LDS_CUM+SEQ*4,LDS_BYTES=LDS_KN+256;
constexpr float C2=0.125f*1.4426950408889634f;
__device__ __forceinline__ void glds16(const void*gsrc,unsigned lds_dst){unsigned keep;
  asm volatile("s_mov_b32 %0, m0\n\ts_mov_b32 m0, %2\n\ts_nop 0\n\tglobal_load_lds_dwordx4 %1, off\n\ts_mov_b32 m0, %0":"=&s"(keep):"v"(gsrc),"s"(lds_dst):"memory");}
__device__ __forceinline__ float max3f(float a,float b,float c){float r;asm("v_max3_f32 %0, %1, %2, %3":"=v"(r):"v"(a),"v"(b),"v"(c));return r;}
__device__ __forceinline__ float max2f(float a,float b){float r;asm("v_max_f32_e32 %0, %1, %2":"=v"(r):"v"(a),"v"(b));return r;}
__device__ __forceinline__ float fadd_s(float a,float b){float r;asm("v_add_f32_e32 %0, %1, %2":"=v"(r):"v"(a),"v"(b));return r;}
__device__ __forceinline__ float fsub_s(float a,float b){float r;asm("v_sub_f32_e32 %0, %1, %2":"=v"(r):"v"(a),"v"(b));return r;}
typedef float f32x2_t __attribute__((ext_vector_type(2))); typedef __bf16 bf16x2_t __attribute__((ext_vector_type(2)));
__device__ __forceinline__ unsigned cvtpk_s(float lo,float hi){f32x2_t v={lo,hi};bf16x2_t b=__builtin_convertvector(v,bf16x2_t);return __builtin_bit_cast(unsigned,b);}
#define WAIT_BAR(N) asm volatile("s_waitcnt vmcnt(" #N ") lgkmcnt(0)\n\ts_barrier":::"memory")

__device__ __forceinline__ void qkt(f32x16&p0,f32x16&p1,const char*Kslot,const bf16x8*qr,const f32x16&negm,int r32,int hi){
  const char*kb=Kslot+hi*1024+r32*16;
  #pragma unroll
  for(int d0=0;d0<4;++d0){
    const bf16x8 b0=*reinterpret_cast<const bf16x8*>(kb+d0*2048);
    const bf16x8 b1=*reinterpret_cast<const bf16x8*>(kb+d0*2048+512);
    if(d0==0){p0=__builtin_amdgcn_mfma_f32_32x32x16_bf16(b0,qr[0],negm,0,0,0);p1=__builtin_amdgcn_mfma_f32_32x32x16_bf16(b1,qr[0],negm,0,0,0);}
    else{p0=__builtin_amdgcn_mfma_f32_32x32x16_bf16(b0,qr[d0],p0,0,0,0);p1=__builtin_amdgcn_mfma_f32_32x32x16_bf16(b1,qr[d0],p1,0,0,0);}}
}
typedef __attribute__((address_space(3))) const char* lds_cptr;
typedef short v4i16_t __attribute__((ext_vector_type(4)));
__device__ __forceinline__ void kload8(bf16x8*kf,lds_cptr kp){
  kf[0]=*(const __attribute__((address_space(3))) bf16x8*)(kp);      kf[1]=*(const __attribute__((address_space(3))) bf16x8*)(kp+512);
  kf[2]=*(const __attribute__((address_space(3))) bf16x8*)(kp+2048); kf[3]=*(const __attribute__((address_space(3))) bf16x8*)(kp+2560);
  kf[4]=*(const __attribute__((address_space(3))) bf16x8*)(kp+4096); kf[5]=*(const __attribute__((address_space(3))) bf16x8*)(kp+4608);
  kf[6]=*(const __attribute__((address_space(3))) bf16x8*)(kp+6144); kf[7]=*(const __attribute__((address_space(3))) bf16x8*)(kp+6656);
}
__device__ __forceinline__ void kload2(bf16x8*kf,lds_cptr kp,int j){ kf[2*j]=*(const __attribute__((address_space(3))) bf16x8*)(kp+j*2048); kf[2*j+1]=*(const __attribute__((address_space(3))) bf16x8*)(kp+j*2048+512); }
__device__ __forceinline__ s16x4 vtr(lds_cptr p){ return __builtin_bit_cast(s16x4,__builtin_amdgcn_ds_read_tr16_b64_v4i16((__attribute__((address_space(3))) v4i16_t*)p)); }
__device__ __forceinline__ float rowmax(const f32x16&p0,const f32x16&p1){
  float a=max3f(p0[0],p0[1],p1[0]),b=max3f(p0[2],p0[3],p1[1]);a=max3f(a,p1[2],p1[3]);
  #pragma unroll
  for(int r=4;r<16;r+=4){a=max3f(a,p0[r],p0[r+1]);b=max3f(b,p0[r+2],p0[r+3]);a=max3f(a,p1[r],p1[r+1]);b=max3f(b,p1[r+2],p1[r+3]);}
  const float m=max2f(a,b);
  auto rr=__builtin_amdgcn_permlane32_swap(__float_as_uint(m),__float_as_uint(m),false,false);
  return max2f(__uint_as_float(rr[0]),__uint_as_float(rr[1]));
}
__device__ __forceinline__ void pv(f32x16*o,int vb,bf16x8 pa0,bf16x8 pa1,bf16x8 pa2,bf16x8 pa3){
  #pragma unroll
  for(int d0=0;d0<2;++d0){s16x4 lo[4],hi[4];
    #pragma unroll
    for(int ks=0;ks<4;++ks){
      asm volatile("ds_read_b64_tr_b16 %0,%1 offset:%c2":"=&v"(lo[ks]):"v"(vb),"i"(d0*4096+ks*1024):"memory");
      asm volatile("ds_read_b64_tr_b16 %0,%1 offset:%c2":"=&v"(hi[ks]):"v"(vb),"i"(d0*4096+ks*1024+512):"memory");}
    asm volatile("s_waitcnt lgkmcnt(0)":::"memory");SBAR();
    #define PK(k) (bf16x8){lo[k][0],lo[k][1],lo[k][2],lo[k][3],hi[k][0],hi[k][1],hi[k][2],hi[k][3]}
    o[d0]=__builtin_amdgcn_mfma_f32_32x32x16_bf16(pa0,PK(0),o[d0],0,0,0);
    o[d0]=__builtin_amdgcn_mfma_f32_32x32x16_bf16(pa1,PK(1),o[d0],0,0,0);
    o[d0]=__builtin_amdgcn_mfma_f32_32x32x16_bf16(pa2,PK(2),o[d0],0,0,0);
    o[d0]=__builtin_amdgcn_mfma_f32_32x32x16_bf16(pa3,PK(3),o[d0],0,0,0);
    #undef PK
  }
}

#ifndef ATTN_STORE16
#define ATTN_STORE16(p,v) (*(u32x4*)(p)=(v))
#endif
template<int THRL> __device__ __forceinline__ void attn_unit(int b,int h,int qb,const bf16*Q,const bf16*__restrict__ K,const bf16*__restrict__ V,bf16*O,const float*__restrict__ cum,char*shm){
  int tid_l=threadIdx.x; asm volatile("":"+v"(tid_l)); const int tid=tid_l,lane=tid&63,r32=lane&31,hi=lane>>5; const int wid=__builtin_amdgcn_readfirstlane(tid>>6);
  const long rowbase=(long)b*SEQ; const int q0=qb*QB;
  const bf16*Qw=Q+(rowbase+q0+wid*QBLK)*DM+h*D;
  const bf16*Kh=K+rowbase*DM+h*D,*Vh=V+rowbase*DM+h*D;
  bf16x8 qr[4];
  _Pragma("unroll") for(int d0=0;d0<4;++d0)qr[d0]=*reinterpret_cast<const bf16x8*>(&Qw[(long)r32*DM+d0*16+hi*8]);
  typedef float f32x4c __attribute__((ext_vector_type(4)));
  __attribute__((address_space(3))) float* cks=(__attribute__((address_space(3))) float*)((__attribute__((address_space(3))) char*)shm+LDS_CUM);
  { const int nld=q0+QB, base=tid*8; f32x4c a=(f32x4c){0.f,0.f,0.f,0.f}, b4=a; if(base<nld){ a=*(const f32x4c*)(cum+base); b4=*(const f32x4c*)(cum+base+4); }
    a[1]+=a[0]; a[2]+=a[1]; a[3]+=a[2]; b4[0]+=a[3]; b4[1]+=b4[0]; b4[2]+=b4[1]; b4[3]+=b4[2];
    float inc=b4[3];
    _Pragma("unroll") for(int o_=1;o_<64;o_<<=1){ const float t_=__uint_as_float((unsigned)__builtin_amdgcn_ds_bpermute(((lane-o_)&63)*4,(int)__float_as_uint(inc))); if(lane>=o_)inc+=t_; }
    __attribute__((address_space(3))) float* wsum=(__attribute__((address_space(3))) float*)((__attribute__((address_space(3))) char*)shm+LDS_WS);
    if(lane==63)wsum[wid]=inc;
    { float ssq=0.f; _Pragma("unroll") for(int d0=0;d0<4;++d0) _Pragma("unroll") for(int e_=0;e_<8;++e_){ const float v_=__uint_as_float(((unsigned)(unsigned short)qr[d0][e_])<<16); ssq+=v_*v_; }
      { auto rr=__builtin_amdgcn_permlane32_swap(__float_as_uint(ssq),__float_as_uint(ssq),false,false); ssq=__uint_as_float(rr[0])+__uint_as_float(rr[1]); }
      #define SWMAX_(v,x) v=__builtin_fmaxf(v,__uint_as_float((unsigned)__builtin_amdgcn_ds_swizzle((int)__float_as_uint(v),((x)<<10)|0x1f)))
      SWMAX_(ssq,1); SWMAX_(ssq,2); SWMAX_(ssq,4); SWMAX_(ssq,8); SWMAX_(ssq,16);
      if(lane==0)wsum[8+wid]=ssq; }
    asm volatile("s_waitcnt lgkmcnt(0)\n\ts_barrier":::"memory");
    float off_=inc-b4[3]; _Pragma("unroll") for(int w_=0;w_<NW;++w_){ const float t_=wsum[w_]; if(w_<wid)off_+=t_; }
    if(base<nld){ const float L2E=1.4426950408889634f; *(__attribute__((address_space(3))) f32x4c*)(cks+base)=(a+off_)*L2E; *(__attribute__((address_space(3))) f32x4c*)(cks+base+4)=(b4+off_)*L2E; }
    asm volatile("s_waitcnt lgkmcnt(0)\n\ts_barrier":::"memory"); }
  int tstart=0;
  { const __attribute__((address_space(3))) float* wq=(const __attribute__((address_space(3))) float*)((__attribute__((address_space(3))) char*)shm+LDS_WS)+8;
    const __attribute__((address_space(3))) float* KN=(const __attribute__((address_space(3))) float*)((__attribute__((address_space(3))) char*)shm+LDS_KN);
    float qm=wq[0]; _Pragma("unroll") for(int w_=1;w_<NW;++w_)qm=__builtin_fmaxf(qm,wq[w_]);
    const int NT0=(q0+QB)/KVBLK, nb=NT0-4; const float kb=__builtin_fmaxf(__builtin_fmaxf(KN[NT0-4],KN[NT0-3]),__builtin_fmaxf(KN[NT0-2],KN[NT0-1]));
    const float floor_=-__builtin_sqrtf(qm*kb)-44.f, cq0=cks[q0]; bool skip=false;
    if(lane<nb){ const float ub=__builtin_sqrtf(qm*KN[lane])+cq0-cks[64*lane+63]; skip=ub<floor_; }
    const unsigned long long m_=__ballot(skip); int pre=(int)__builtin_ctzll(~m_); pre=pre<nb?pre:nb; tstart=__builtin_amdgcn_readfirstlane(pre&~1); }
  Kh+=(long)tstart*KVBLK*DM; Vh+=(long)tstart*KVBLK*DM;
  const __attribute__((address_space(3))) float* ckt=cks+tstart*KVBLK;
  #define CKSUB(P0,P1,t) do{ const __attribute__((address_space(3))) float* ckp_=ckt+(t)*64+4*hi; \
    _Pragma("unroll") for(int rr_=0;rr_<4;++rr_){ const f32x4c a_=*(const __attribute__((address_space(3))) f32x4c*)(ckp_+8*rr_); const f32x4c b_=*(const __attribute__((address_space(3))) f32x4c*)(ckp_+32+8*rr_); \
      _Pragma("unroll") for(int e_=0;e_<4;++e_){ P0[4*rr_+e_]-=a_[e_]; P1[4*rr_+e_]-=b_[e_]; } if(rr_==1)__builtin_amdgcn_sched_barrier(0); } }while(0)
  const unsigned lds0=(unsigned)(uintptr_t)shm;
  float*wsf=(float*)(shm+LDS_WS)+wid*64;
  const bf16*ksrc=Kh+(long)lane*DM+wid*8;
  const bf16*vsrc=Vh+(long)(16*(wid&3)+(lane>>2))*DM+(wid>>2)*32+(lane&3)*8;
  const unsigned kdst=lds0+LDS_K+wid*1024, vdst=lds0+LDS_V+wid*1024;
  #define DMA_K(t,slot) glds16(ksrc+(long)(t)*KVBLK*DM,(unsigned)__builtin_amdgcn_readfirstlane(kdst+(slot)))
  #define DMA_V(t,slot) glds16(vsrc+(long)(t)*KVBLK*DM,(unsigned)__builtin_amdgcn_readfirstlane(vdst+(slot)))
  const int vb0=(int)(lds0+LDS_V)+((lane>>4)&1)*32+(lane&3)*8+(4*hi+((lane&15)>>2))*64;
  const char*Kbase=shm+LDS_K; bf16x8 kf[8];
  const lds_cptr shm3=(lds_cptr)shm; const lds_cptr kp0=shm3+LDS_K+hi*1024+r32*16; const lds_cptr vp0=shm3+LDS_V+((lane>>4)&1)*32+(lane&3)*8+(4*hi+((lane&15)>>2))*64;
  const int NT=(q0+QB)/KVBLK-tstart;
  DMA_K(0,0);DMA_V(0,0);DMA_K(1,SLOTB);
  float mhat=-cks[q0+wid*QBLK+r32],l_reg=0.f;f32x16 o[2];o[0]=f32x16{};o[1]=f32x16{};f32x16 negm; _Pragma("unroll") for(int r=0;r<16;++r)negm[r]=-mhat; asm volatile("":"+v"(negm));
  const int qrel=wid*QBLK+r32;
  #define CMASK(P0,P1,t) do{int jb_=(t)-(NT-4); if(jb_>=0)cmask(P0,P1,jb_,qrel,hi);}while(0)
  bool resc=false;
  #define START(P0,P1) do{ const float rm=rowmax(P0,P1); resc=false; \
    { const float dl=rm; mhat=fadd_s(mhat,dl); \
      _Pragma("unroll") for(int r=0;r<16;++r){P0[r]=fsub_s(P0[r],dl);P1[r]=fsub_s(P1[r],dl);} \
      _Pragma("unroll") for(int r=0;r<16;++r)negm[r]=-mhat; asm volatile("":"+v"(negm)); } \
    _Pragma("unroll") for(int r=0;r<16;++r)P0[r]=__builtin_amdgcn_exp2f(P0[r]); }while(0)
  #define RESC() do{ if(resc){ asm volatile("s_waitcnt lgkmcnt(0)":::"memory"); \
      _Pragma("unroll") for(int d_=0;d_<2;++d_) _Pragma("unroll") for(int r=0;r<16;++r)o[d_][r]*=wsf[crow(r,hi)]; } }while(0)
  f32x16 pA0,pA1,pB0,pB1;
  int sl_prev=0,sl_cur=0,sl_next=SLOTB;
  #define ROT() do{sl_prev=sl_cur;sl_cur=sl_next;sl_next=(sl_next==(NSLOT-1)*SLOTB)?0:sl_next+SLOTB;}while(0)
  DMA_K(2,2*SLOTB);
  WAIT_BAR(3);
  qkt(pA0,pA1,Kbase,qr,negm,r32,hi);asm volatile("s_nop 15\n\ts_nop 7":"+v"(pA0),"+v"(pA1));CKSUB(pA0,pA1,0);CMASK(pA0,pA1,0);
  START(pA0,pA1);
  _Pragma("unroll") for(int r=0;r<16;++r)pA1[r]=__builtin_amdgcn_exp2f(pA1[r]);
  WAIT_BAR(0);
  DMA_K(3,0);DMA_V(1,SLOTB);
  ROT();
  kload8(kf,kp0+sl_cur);
  WAIT_BAR(2);
  s16x4 vlo[8],vhi[8]; u32x4 pw0,pw1,pw2,pw3;
  #define PKW(P,B) cvtpk_s(P[B],P[B+1])
  #define PAF(k) __builtin_bit_cast(bf16x8,pw##k)
  #define VFR(i) (bf16x8){vlo[i][0],vlo[i][1],vlo[i][2],vlo[i][3],vhi[i][0],vhi[i][1],vhi[i][2],vhi[i][3]}
  #define PIN(x) asm volatile("":"+v"(x))
  #define MX3(a,b,c) __builtin_fmaxf(__builtin_fmaxf((a),(b)),(c))
  #define GAPA(MF,A0,A1,A2,A3,W0,W1,PW) do{ MF; sacc+=A0; sacc+=A1; sacc+=A2; sacc+=A3; PIN(sacc); W0; W1; PIN(PW); SBAR(); }while(0)
  #define EX(v) __builtin_amdgcn_exp2f(v)
  #define GAPB(MF,X,B) do{ MF; X[B]=EX(X[B]); X[B+1]=EX(X[B+1]); X[B+2]=EX(X[B+2]); X[B+3]=EX(X[B+3]); PIN(X); SBAR(); }while(0)
  #define VRD(i) do{ vlo[i]=vtr(vp_+(((i)>>2)*4096+((i)&3)*1024)); vhi[i]=vtr(vp_+(((i)>>2)*4096+((i)&3)*1024+512)); }while(0)
  #define KRD(G,j) do{ if(G){ kload2(kf,kp0+sl_next,j); SBAR(); } }while(0)
  #define STEP(C0,C1,P0,P1,t,GK,GV,GL) do{ SBAR(); \
    const lds_cptr vp_=vp0+sl_prev; \
    VRD(0); SBAR(); float sacc=(P0[0]+P0[1]); \
    GAPA(C0=__builtin_amdgcn_mfma_f32_32x32x16_bf16(kf[0],qr[0],negm,0,0,0), P0[2],P0[3],P0[4],P0[5],     pw0[0]=PKW(P0,0), pw0[1]=PKW(P0,2), pw0); \
    VRD(4); SBAR(); GAPA(C1=__builtin_amdgcn_mfma_f32_32x32x16_bf16(kf[1],qr[0],negm,0,0,0), P0[6],P0[7],P0[8],P0[9],     pw0[2]=PKW(P0,4), pw0[3]=PKW(P0,6), pw0); \
    VRD(1); SBAR(); GAPA(C0=__builtin_amdgcn_mfma_f32_32x32x16_bf16(kf[2],qr[1],C0,0,0,0),   P0[10],P0[11],P0[12],P0[13], pw1[0]=PKW(P0,8), pw1[1]=PKW(P0,10), pw1); \
    VRD(5); SBAR(); GAPA(C1=__builtin_amdgcn_mfma_f32_32x32x16_bf16(kf[3],qr[1],C1,0,0,0),   P0[14],P0[15],P1[0],P1[1],   pw1[2]=PKW(P0,12),pw1[3]=PKW(P0,14), pw1); \
    VRD(2); SBAR(); GAPA(C0=__builtin_amdgcn_mfma_f32_32x32x16_bf16(kf[4],qr[2],C0,0,0,0),   P1[2],P1[3],P1[4],P1[5],     pw2[0]=PKW(P1,0), pw2[1]=PKW(P1,2), pw2); \
    VRD(6); SBAR(); GAPA(C1=__builtin_amdgcn_mfma_f32_32x32x16_bf16(kf[5],qr[2],C1,0,0,0),   P1[6],P1[7],P1[8],P1[9],     pw2[2]=PKW(P1,4), pw2[3]=PKW(P1,6), pw2); \
    VRD(3); SBAR(); GAPA(C0=__builtin_amdgcn_mfma_f32_32x32x16_bf16(kf[6],qr[3],C0,0,0,0),   P1[10],P1[11],P1[12],P1[13], pw3[0]=PKW(P1,8), pw3[1]=PKW(P1,10), pw3); \
    VRD(7); SBAR(); GAPA(C1=__builtin_amdgcn_mfma_f32_32x32x16_bf16(kf[7],qr[3],C1,0,0,0),   P1[14],P1[15],0.f,0.f,       pw3[2]=PKW(P1,12),pw3[3]=PKW(P1,14), pw3); \
    l_reg+=sacc; \
    if(GK){DMA_K((t)+3,sl_cur);} if(GV){DMA_V((t)+1,sl_next);} \
    CKSUB(C0,C1,t); CMASK(C0,C1,t); \
    { float a=MX3(C0[0],C0[1],C1[0]),b=MX3(C0[2],C0[3],C1[1]); a=MX3(a,C1[2],C1[3]); \
      _Pragma("unroll") for(int r=4;r<16;r+=4){a=MX3(a,C0[r],C0[r+1]);b=MX3(b,C0[r+2],C0[r+3]);a=MX3(a,C1[r],C1[r+1]);b=MX3(b,C1[r+2],C1[r+3]);} \
      float rm=__builtin_fmaxf(a,b); { auto rr=__builtin_amdgcn_permlane32_swap(__float_as_uint(rm),__float_as_uint(rm),false,false); rm=__builtin_fmaxf(__uint_as_float(rr[0]),__uint_as_float(rr[1])); } \
      resc=false; \
      if(__builtin_expect(__any(rm>(float)THRL),0)){ const float dl=__builtin_fmaxf(rm,0.f); mhat+=dl; \
        _Pragma("unroll") for(int r=0;r<16;++r){C0[r]-=dl;C1[r]-=dl;} \
        _Pragma("unroll") for(int r=0;r<16;++r)negm[r]=-mhat; asm volatile("":"+v"(negm)); \
        const float f=__builtin_amdgcn_exp2f(-dl); l_reg*=f; if(hi==0)wsf[r32]=f; resc=true; } } \
    SBAR(); \
    GAPB(o[0]=__builtin_amdgcn_mfma_f32_32x32x16_bf16(PAF(0),VFR(0),o[0],0,0,0), C0,0); \
    GAPB(o[1]=__builtin_amdgcn_mfma_f32_32x32x16_bf16(PAF(0),VFR(4),o[1],0,0,0), C0,4); \
    KRD(GL,0); GAPB(o[0]=__builtin_amdgcn_mfma_f32_32x32x16_bf16(PAF(1),VFR(1),o[0],0,0,0), C0,8); \
    KRD(GL,1); GAPB(o[1]=__builtin_amdgcn_mfma_f32_32x32x16_bf16(PAF(1),VFR(5),o[1],0,0,0), C0,12); \
    KRD(GL,2); GAPB(o[0]=__builtin_amdgcn_mfma_f32_32x32x16_bf16(PAF(2),VFR(2),o[0],0,0,0), C1,0); \
    KRD(GL,3); GAPB(o[1]=__builtin_amdgcn_mfma_f32_32x32x16_bf16(PAF(2),VFR(6),o[1],0,0,0), C1,4); \
    GAPB(o[0]=__builtin_amdgcn_mfma_f32_32x32x16_bf16(PAF(3),VFR(3),o[0],0,0,0), C1,8); \
    GAPB(o[1]=__builtin_amdgcn_mfma_f32_32x32x16_bf16(PAF(3),VFR(7),o[1],0,0,0), C1,12); \
    }while(0)
  int t=1;
  #undef CMASK
  #define CMASK(P0,P1,t) do{}while(0)
  for(;t+5<NT;t+=2){
    STEP(pB0,pB1,pA0,pA1,t,true,true,true);     WAIT_BAR(2); RESC(); ROT();
    STEP(pA0,pA1,pB0,pB1,t+1,true,true,true);   WAIT_BAR(2); RESC(); ROT();
  }
  #undef CMASK
  #define CMASK(P0,P1,t) do{int jb_=(t)-(NT-4); if(jb_>=0)cmask(P0,P1,jb_,qrel,hi);}while(0)
  #define ENDW(tt) do{ if((tt)+3<NT){WAIT_BAR(2);} else if((tt)+2<NT){WAIT_BAR(1);} else {WAIT_BAR(0);} }while(0)
  for(;t+1<NT;t+=2){
    STEP(pB0,pB1,pA0,pA1,t,(t+3<NT),(t+1<NT),(t+1<NT));       ENDW(t);   RESC(); ROT();
    STEP(pA0,pA1,pB0,pB1,t+1,(t+4<NT),(t+2<NT),(t+2<NT));     ENDW(t+1); RESC(); ROT();
  }
  STEP(pB0,pB1,pA0,pA1,NT-1,false,false,false); RESC();
  { float sacc=pB0[0]+pB0[1]; _Pragma("unroll") for(int r=2;r<16;++r)sacc+=pB0[r]; _Pragma("unroll") for(int r=0;r<16;++r)sacc+=pB1[r]; l_reg+=sacc;
    pw0=(u32x4){PKW(pB0,0),PKW(pB0,2),PKW(pB0,4),PKW(pB0,6)};pw1=(u32x4){PKW(pB0,8),PKW(pB0,10),PKW(pB0,12),PKW(pB0,14)};pw2=(u32x4){PKW(pB1,0),PKW(pB1,2),PKW(pB1,4),PKW(pB1,6)};pw3=(u32x4){PKW(pB1,8),PKW(pB1,10),PKW(pB1,12),PKW(pB1,14)};
    SBAR(); pv(o,vb0+sl_cur,PAF(0),PAF(1),PAF(2),PAF(3)); }
  #undef PKW
  #undef PAF
  #undef VFR
  #undef PIN
  #undef MX3
  #undef GAPA
  #undef GAPB
  #undef EX
  #undef VRD
  #undef KRD
  #undef STEP
  #undef ENDW
  {auto rr=__builtin_amdgcn_permlane32_swap(__float_as_uint(l_reg),__float_as_uint(l_reg),false,false);l_reg=__uint_as_float(rr[0])+__uint_as_float(rr[1]);}
  if(hi==0)wsf[32+r32]=l_reg;asm volatile("s_waitcnt lgkmcnt(0)":::"memory");
  float rli[16];
  #pragma unroll
  for(int r=0;r<16;++r)rli[r]=__builtin_amdgcn_rcpf(wsf[32+crow(r,hi)]);
  bf16*Ow=O+(rowbase+q0+wid*QBLK)*ODM+h*D;
  { bf16*stg=(bf16*)(shm+LDS_OST)+wid*2048;
    #pragma unroll
    for(int r=0;r<16;++r){const int orow=crow(r,hi);
      #pragma unroll
      for(int d0=0;d0<2;++d0)stg[orow*64+d0*32+r32]=__float2bfloat16(o[d0][r]*rli[r]);}
    asm volatile("s_waitcnt lgkmcnt(0)":::"memory");
    #pragma unroll
    for(int i=0;i<4;++i){const int row=i*8+(lane>>3),ch=lane&7; const u32x4 v=*(const u32x4*)(stg+row*64+ch*8); ATTN_STORE16(Ow+(long)row*ODM+ch*8,v);} }
  asm volatile("s_waitcnt lgkmcnt(0)\n\ts_barrier":::"memory");
  #undef CKSUB
  #undef DMA_K
  #undef DMA_V
  #undef CMASK
  #undef START
  #undef RESC
  #undef ROT
}
constexpr int ATTN_LDS_BYTES=LDS_BYTES;
struct AttnTensors { const bf16* Q; const bf16* K; const bf16* V; bf16* O; const float* CUM; };
struct AttnUnit { int bh; int qb; };
struct StaticOrder {
  int vcu;
  __device__ __forceinline__ explicit StaticOrder(int grid,int block):vcu((block%8)*(grid/8)+block/8){}
  __device__ __forceinline__ bool next(int i,AttnUnit&u)const{ if(i>=8)return false; const int s=vcu&1; u.bh=vcu>>1; const int j=7-i; u.qb=4*(j>>1)+(s==0?((j&1)?3:0):((j&1)?2:1)); return true; }
  __device__ __forceinline__ void a_ready(const AttnUnit&)const{}
  __device__ __forceinline__ void done(const AttnUnit&)const{}
};
__device__ __forceinline__ void kn_table(const bf16*K,int bh,char*shm){
  int tid_l=threadIdx.x; asm volatile("":"+v"(tid_l)); const int tid=tid_l,lane=tid&63; const bf16*kp=K+((long)(bh/NHEAD)*SEQ+8*tid)*DM+(bh%NHEAD)*D; float mx=0.f;
  _Pragma("unroll 2") for(int r=0;r<8;++r){ float ssq=0.f;
    _Pragma("unroll") for(int c=0;c<8;++c){ const u32x4 w=*reinterpret_cast<const u32x4*>(kp+(long)r*DM+c*8);
      _Pragma("unroll") for(int e_=0;e_<4;++e_){ const float lo_=__uint_as_float(w[e_]<<16), hi_=__uint_as_float(w[e_]&0xffff0000u); ssq+=lo_*lo_+hi_*hi_; } }
    mx=__builtin_fmaxf(mx,ssq); }
  #define SWMAXK_(v,x) v=__builtin_fmaxf(v,__uint_as_float((unsigned)__builtin_amdgcn_ds_swizzle((int)__float_as_uint(v),((x)<<10)|0x1f)))
  SWMAXK_(mx,1); SWMAXK_(mx,2); SWMAXK_(mx,4);
  if((lane&7)==0) ((__attribute__((address_space(3))) float*)((__attribute__((address_space(3))) char*)shm+LDS_KN))[tid>>3]=mx;
  asm volatile("s_waitcnt lgkmcnt(0)\n\ts_barrier":::"memory");
}
template<class Sched,int THRL=8> __device__ __forceinline__ void attn_phase(char*lds,const AttnTensors&T,const Sched&S){
  AttnUnit u;
  if(S.next(0,u)) kn_table(T.K,u.bh,lds);
  for(int i=0;S.next(i,u);++i){ S.a_ready(u); attn_unit<THRL>(u.bh/NHEAD,u.bh%NHEAD,u.qb,T.Q,T.K,T.V,T.O,T.CUM+(size_t)u.bh*SEQ,lds); S.done(u); }
}
#undef SBAR
#undef WAIT_BAR
}
#include <hip/hip_cooperative_groups.h>
namespace cg = cooperative_groups;
#define LAS __attribute__((address_space(3)))
typedef unsigned short bf16;
typedef unsigned v4u __attribute__((ext_vector_type(4)));
typedef unsigned v2u __attribute__((ext_vector_type(2)));
typedef float f32x4 __attribute__((ext_vector_type(4)));
typedef float f32x16 __attribute__((ext_vector_type(16)));
typedef short bf16x8 __attribute__((ext_vector_type(8)));
typedef short s16x4 __attribute__((ext_vector_type(4)));

constexpr int NWAVES = 8;
#ifndef PROBE_DOUBLE
#define PROBE_DOUBLE 0
#endif
constexpr int BATCH = 16, SEQ = 4096, DM = 1024, M = BATCH * SEQ, FF = 4096, DEPTH = 4;
constexpr int EVEN_IN = 3080, EVEN_N = 3072, ODD_IN = 6144;
constexpr float RMS_EPS = 1e-6f, GN_EPS = 1e-6f, LOG2E = 1.4426950408889634f;
constexpr size_t MiB = 1u << 20;
constexpr size_t WS_EIN = 1 * MiB, WS_EOUT = WS_EIN + 12 * MiB, WS_OIN = WS_EOUT + 4 * MiB, WS_OOUT = WS_OIN + 24 * MiB, WS_F1 = WS_OOUT + 8 * MiB, WS_F2 = WS_F1 + 32 * MiB;
constexpr size_t WS_LOGF = WS_F2 + 32 * MiB, WS_CUM = WS_LOGF + 2 * MiB, WS_LSE = WS_CUM + 2 * MiB, WS_XN = 124 * MiB, WS_ACT = 252 * MiB, WS_END = 1024 * MiB;
static_assert(WS_LSE + 6 * MiB <= WS_XN, "ws map");
constexpr size_t SEG = 64 * MiB, WS_OG = WS_ACT + 6 * SEG, WS_AO = WS_OG + 3 * SEG;
static_assert(WS_AO + 128 * MiB <= WS_END, "ws map even");
constexpr size_t WS_RQ = WS_ACT, WS_RK = WS_RQ + 128 * MiB, WS_RV = WS_RK + 128 * MiB, WS_RG = WS_RV + 256 * MiB;
static_assert(WS_RG + 256 * MiB <= WS_END, "ws map odd");
constexpr size_t WS_H = WS_ACT;
constexpr int LDS_BYTES = 147456;

__device__ __forceinline__ unsigned f2bf(float f) { unsigned u = __builtin_bit_cast(unsigned, f); return (u + 0x7fffu + ((u >> 16) & 1u)) >> 16; }
__device__ __forceinline__ unsigned pk2(float lo, float hi) { return attn_body::cvtpk_s(lo, hi); }
__device__ __forceinline__ unsigned pkh2(float lo, float hi) { return pg8::st_pk(lo, hi); }
__device__ __forceinline__ float bf2f(unsigned short b) { return __builtin_bit_cast(float, (unsigned)b << 16); }
__device__ __forceinline__ float xor32f(float v) { auto rr = __builtin_amdgcn_permlane32_swap(__float_as_uint(v), __float_as_uint(v), false, false); return __uint_as_float((threadIdx.x & 32) ? rr[0] : rr[1]); }
#define SWZ(v, x) __uint_as_float((unsigned)__builtin_amdgcn_ds_swizzle((int)__float_as_uint(v), ((x) << 10) | 0x1f))
__device__ __forceinline__ float wave_sum(float v) {
    v += SWZ(v, 1); v += SWZ(v, 2); v += SWZ(v, 4); v += SWZ(v, 8); v += SWZ(v, 16);
    auto rr = __builtin_amdgcn_permlane32_swap(__float_as_uint(v), __float_as_uint(v), false, false);
    return __uint_as_float(rr[0]) + __uint_as_float(rr[1]);
}
__device__ __forceinline__ int crow(int r, int hi) { return (r & 3) + 8 * (r >> 2) + 4 * hi; }
__device__ __forceinline__ s16x4 trrd(const LAS unsigned char* p) { typedef short v4i16_t __attribute__((ext_vector_type(4))); return __builtin_bit_cast(s16x4, __builtin_amdgcn_ds_read_tr16_b64_v4i16((LAS v4i16_t*)p)); }
#define CAT8(lo, hi) (bf16x8){lo[0], lo[1], lo[2], lo[3], hi[0], hi[1], hi[2], hi[3]}
#define LBAR() asm volatile("s_waitcnt lgkmcnt(0)\n\ts_barrier" ::: "memory")
#define MFMA32(a, b, c) __builtin_amdgcn_mfma_f32_32x32x16_bf16((a), (b), (c), 0, 0, 0)

__device__ __forceinline__ void p0_transpose_item(const float* W, int K, int N, int ldw, bf16* WT, LAS float* scr, int item, int lane, const float* gk = nullptr, bool f16 = false) {
    const int nblk = N / 32, kb = item / nblk, nb = item % nblk, k0 = 64 * kb, n0 = 32 * nb;
#pragma unroll 8
    for (int i = 0; i < 32; ++i) { const int kk = 2 * i + (lane >> 5); scr[kk * 33 + (lane & 31)] = W[(size_t)(k0 + kk) * ldw + n0 + (lane & 31)] * (gk ? gk[k0 + kk] : 1.0f); }
    asm volatile("s_waitcnt lgkmcnt(0)" ::: "memory");
    const int c = lane & 7;
#pragma unroll
    for (int j = 0; j < 4; ++j) { const int n = (lane >> 3) + 8 * j; const LAS float* s = scr + (8 * c) * 33 + n;
        v4u o; if (f16) { o.x = pkh2(s[0 * 33], s[1 * 33]); o.y = pkh2(s[2 * 33], s[3 * 33]); o.z = pkh2(s[4 * 33], s[5 * 33]); o.w = pkh2(s[6 * 33], s[7 * 33]); }
        else { o.x = pk2(s[0 * 33], s[1 * 33]); o.y = pk2(s[2 * 33], s[3 * 33]); o.z = pk2(s[4 * 33], s[5 * 33]); o.w = pk2(s[6 * 33], s[7 * 33]); }
        *(v4u*)(WT + (size_t)(n0 + n) * K + k0 + 8 * c) = o; }
    asm volatile("s_waitcnt lgkmcnt(0)" ::: "memory");
}
struct Ins { const float *x, *gmix, *gffn, *ewin, *ebf, *ewout, *owin, *owout, *f1, *f2, *gfin; };
__device__ __forceinline__ void p0_prologue(const Ins& in, unsigned char* ws, LAS unsigned char* lds, int gw, int NGW, int wave, int lane) {
    LAS float* scr = (LAS float*)(lds + wave * 16384);
    constexpr int I_EIN = 16 * 96, I_EOUT = 16 * 32, I_OIN = 16 * 192, I_OOUT = 32 * 32, I_F1 = 16 * 128, I_F2 = 64 * 32;
    constexpr int NITEMS = 2 * (I_EIN + I_EOUT + I_OIN + I_OOUT) + 4 * (I_F1 + I_F2);
    for (int it = gw; it < NITEMS; it += NGW) {
        int r = it;
        if (r < 2 * I_EIN) { const int i = r / I_EIN; p0_transpose_item(in.ewin + (size_t)i * DM * EVEN_IN, DM, EVEN_N, EVEN_IN, (bf16*)(ws + WS_EIN) + (size_t)i * EVEN_N * DM, scr, r % I_EIN, lane, in.gmix + (2 * i) * DM, STREAM_F16 != 0); continue; } r -= 2 * I_EIN;
        if (r < 2 * I_EOUT) { const int i = r / I_EOUT; p0_transpose_item(in.ewout + (size_t)i * DM * DM, DM, DM, DM, (bf16*)(ws + WS_EOUT) + (size_t)i * DM * DM, scr, r % I_EOUT, lane); continue; } r -= 2 * I_EOUT;
        if (r < 2 * I_OIN) { const int i = r / I_OIN; p0_transpose_item(in.owin + (size_t)i * DM * ODD_IN, DM, ODD_IN, ODD_IN, (bf16*)(ws + WS_OIN) + (size_t)i * ODD_IN * DM, scr, r % I_OIN, lane, in.gmix + (2 * i + 1) * DM, STREAM_F16 != 0); continue; } r -= 2 * I_OIN;
        if (r < 2 * I_OOUT) { const int i = r / I_OOUT; p0_transpose_item(in.owout + (size_t)i * 2 * DM * DM, 2 * DM, DM, DM, (bf16*)(ws + WS_OOUT) + (size_t)i * 2 * DM * DM, scr, r % I_OOUT, lane); continue; } r -= 2 * I_OOUT;
        if (r < 4 * I_F1) { const int i = r / I_F1; p0_transpose_item(in.f1 + (size_t)i * DM * FF, DM, FF, FF, (bf16*)(ws + WS_F1) + (size_t)i * FF * DM, scr, r % I_F1, lane, in.gffn + i * DM, STREAM_F16 != 0); continue; } r -= 4 * I_F1;
        { const int i = r / I_F2; p0_transpose_item(in.f2 + (size_t)i * FF * DM, FF, DM, DM, (bf16*)(ws + WS_F2) + (size_t)i * FF * DM, scr, r % I_F2, lane); }
    }
}

template <bool FIRST> __device__ __forceinline__ void gate_pass(const float* x, bf16* XB, float* SS, const float* g, const float* Wf  , const float* bfp, float* LOGF,
                                                               LAS unsigned char* lds, int gw, int NGW, int tid, int lane) {
    LAS float* wt = (LAS float*)lds;
    for (int idx = tid; idx < 8192; idx += NWAVES * 64) { const int k = idx >> 3, j = idx & 7; wt[j * 1024 + k] = Wf[(size_t)k * EVEN_IN + j] * g[k]; }
    __syncthreads();
    for (int m = gw; m < M; m += NGW) {
        f32x4 v[4]; float rstd;
        if (FIRST) { const f32x4* xr = (const f32x4*)(x + (size_t)m * DM) + lane; float s = 0.f;
#pragma unroll
            for (int j = 0; j < 4; ++j) { v[j] = xr[64 * j]; s += (v[j].x * v[j].x + v[j].y * v[j].y) + (v[j].z * v[j].z + v[j].w * v[j].w); }
            s = wave_sum(s); rstd = __builtin_amdgcn_rsqf(s * (1.f / DM) + RMS_EPS); if (lane < 16) SS[(size_t)m * 16 + lane] = (lane == 0) ? s : 0.f;
            v2u* o8 = (v2u*)(XB + (size_t)m * DM) + lane;
#pragma unroll
            for (int j = 0; j < 4; ++j) { v2u w; w.x = pkh2(v[j].x, v[j].y); w.y = pkh2(v[j].z, v[j].w); o8[64 * j] = w; }
        } else { const v2u* xr = (const v2u*)(XB + (size_t)m * DM) + lane;
#pragma unroll
            for (int j = 0; j < 4; ++j) { const v2u w = xr[64 * j]; v[j].x = pg8::st_lo(w.x); v[j].y = pg8::st_hi(w.x); v[j].z = pg8::st_lo(w.y); v[j].w = pg8::st_hi(w.y); }
            rstd = __builtin_amdgcn_rsqf(wave_sum((lane < 16) ? SS[(size_t)m * 16 + lane] : 0.f) * (1.f / DM) + RMS_EPS); }
        float mine = 0.f;
#pragma unroll
        for (int jj = 0; jj < 8; ++jj) { float d = 0.f;
#pragma unroll
            for (int j = 0; j < 4; ++j) { const f32x4 w = *((const LAS f32x4*)(wt + jj * 1024) + lane + 64 * j); d += (v[j].x * w.x + v[j].y * w.y) + (v[j].z * w.z + v[j].w * w.w); }
            d = wave_sum(d); if (lane == jj) mine = d; }
        if (lane < 8) { const float u = mine * rstd + bfp[lane]; LOGF[((size_t)(m >> 12) * 8 + lane) * SEQ + (m & (SEQ - 1))] = fminf(u, 0.f) - __logf(1.0f + __expf(-fabsf(u))); }
    }
    __syncthreads();
}

#define XB_TMO      128
#define XB_XCNT(j)  (256  + 64 * (j))
#define XB_XSUB(j)  (1280 + 64 * (j))
#define XB_XGEN(j)  (2304 + 64 * (j))
#define XB_TOP      3328
#define XB_TOPGEN   3392
#define XCD_BAR_WORDS 3456
#define XB_SPIN_CAP (1u << 18)

__device__ __forceinline__ unsigned xb_ld(unsigned* p)              { return __hip_atomic_load(p, __ATOMIC_RELAXED, __HIP_MEMORY_SCOPE_AGENT); }
__device__ __forceinline__ unsigned xb_add(unsigned* p, unsigned v) { return __hip_atomic_fetch_add(p, v, __ATOMIC_RELAXED, __HIP_MEMORY_SCOPE_AGENT); }
__device__ __forceinline__ unsigned xb_xcc_id() { return (unsigned)__builtin_amdgcn_s_getreg((3 << 11) | 20) & 0xFu; }
#define XB_SPIN(cond, bar) do { unsigned _sp = 0; while (cond) { __builtin_amdgcn_s_sleep(1); \
    if ((++_sp & 255u) == 0u) { if (xb_ld(&(bar)[XB_TMO])) break; if (_sp > XB_SPIN_CAP) { atomicAdd(&(bar)[XB_TMO], 1u); break; } } } } while (0)

struct XcdBarrier {
    unsigned* bar; unsigned x;
    volatile LAS unsigned* st;
};

__device__ __forceinline__ XcdBarrier xcd_barrier_post(unsigned* bar, volatile LAS unsigned* st) {
    XcdBarrier b; b.bar = bar; b.x = xb_xcc_id(); b.st = st;
    if (threadIdx.x == 0) (void)xb_add(&bar[XB_XCNT(b.x)], 1u);
    return b;
}
__device__ __forceinline__ void xcd_barrier_complete(unsigned* bar, unsigned x, unsigned& nloc, unsigned& nx) {
    const unsigned G = gridDim.x * gridDim.y * gridDim.z;
    unsigned sum, cnt, mine, sp = 0u;
    for (;;) {
        sum = 0u; cnt = 0u; mine = 0u;
#pragma unroll
        for (unsigned j = 0; j < 16; ++j) { const unsigned c = xb_ld(&bar[XB_XCNT(j)]); sum += c; cnt += (c > 0u) ? 1u : 0u; mine = (j == x) ? c : mine; }
        if (sum == G) break;
        __builtin_amdgcn_s_sleep(1);
        if ((++sp & 255u) == 0u) { if (xb_ld(&bar[XB_TMO])) break; if (sp > XB_SPIN_CAP) { atomicAdd(&bar[XB_TMO], 1u); break; } }
    }
    nloc = mine > 0u ? mine : 1u; nx = cnt > 0u ? cnt : 1u;
}

__device__ __forceinline__ void xcd_barrier(const XcdBarrier& b) {
    asm volatile("s_waitcnt vmcnt(0)" ::: "memory");
    __syncthreads();
    if (threadIdx.x == 0) {
        unsigned* bar = b.bar;
        __builtin_amdgcn_s_waitcnt(0);
        unsigned nloc = b.st[0], nx = b.st[1];
        unsigned bxx = b.x; asm volatile("" : "+s"(bxx));
        if (nloc == 0u) { xcd_barrier_complete(bar, bxx, nloc, nx); b.st[0] = nloc; b.st[1] = nx; }
        const unsigned old = xb_add(&bar[XB_XSUB(bxx)], 1u);
        const unsigned gen = old / nloc;
        if (old + 1u == (gen + 1u) * nloc) {
            __builtin_amdgcn_fence(__ATOMIC_RELEASE, "agent");
            asm volatile("s_waitcnt vmcnt(0)" ::: "memory");
            const unsigned og = xb_add(&bar[XB_TOP], 1u);
            const unsigned tg = og / nx;
            if (og + 1u == (tg + 1u) * nx) xb_add(&bar[XB_TOPGEN], 1u);
            else XB_SPIN(xb_ld(&bar[XB_TOPGEN]) == tg, bar);
            __builtin_amdgcn_fence(__ATOMIC_ACQUIRE, "agent");
            xb_add(&bar[XB_XGEN(bxx)], 1u);
            asm volatile("s_waitcnt vmcnt(0)" ::: "memory");
        } else {
            XB_SPIN(xb_ld(&bar[XB_XGEN(bxx)]) == gen, bar);
            __builtin_amdgcn_fence(__ATOMIC_ACQUIRE, "agent");
            asm volatile("s_waitcnt vmcnt(0)" ::: "memory");
        }
    }
    __syncthreads();
}

namespace dil {
constexpr int LK = 0, LV = 384 * 128, LSCR = LV + 384 * 144, LTOT = LSCR + NWAVES * 256;
static_assert(LTOT <= 131072, "dil lds");
struct U { int b, h, d, sr, win0; };
__device__ __forceinline__ U decode(int u) {
    U r; const int j = u & 15, g3 = (u >> 4) % 3, bh = u / 48; r.b = bh >> 3; r.h = bh & 7; int np;
    if (g3 == 0) { r.d = 1; r.sr = 0; np = j; } else if (g3 == 1) { r.d = 4; r.sr = j >> 2; np = j & 3; } else { r.d = 16; r.sr = j; np = 0; }
    r.win0 = (2 * np - 1) * 128; return r;
}
__device__ __forceinline__ void issue(const U& w, const bf16* Q, const bf16* K, const bf16* V, int tid, int wave, int lane, v4u (&kreg)[6], v4u (&vreg)[6], bf16x8 (&qr)[4]) {
    const unsigned rowbase = (unsigned)w.b * SEQ; const int r32 = lane & 31, hi = lane >> 5;
#pragma unroll
    for (int i = 0; i < 6; ++i) { const int idx = tid + 512 * i, j = idx >> 3, ch = idx & 7; const int sp = max(w.win0 + j, 0);
        const unsigned go = (rowbase + (unsigned)(sp * w.d + w.sr)) * 512u + w.h * 64 + ch * 8; kreg[i] = *(const v4u*)(K + go); vreg[i] = *(const v4u*)(V + go); }
    const unsigned tokq = rowbase + (unsigned)((w.win0 + 128 + 32 * wave + r32) * w.d + w.sr);
#pragma unroll
    for (int s = 0; s < 4; ++s) qr[s] = *(const bf16x8*)(Q + (tokq * 512u + w.h * 64 + 16 * s + 8 * hi));
}
__device__ __forceinline__ void stage(const U& w, LAS unsigned char* lds, int tid, const v4u (&kreg)[6], const v4u (&vreg)[6]) {
    unsigned zz_ = 0u; asm volatile("" : "+v"(zz_));
#pragma unroll
    for (int i = 0; i < 6; ++i) { const int idx = tid + 512 * i, j = idx >> 3, ch = idx & 7; const bool ok = (w.win0 + j) >= 0;
        v4u kv = kreg[i], vv = vreg[i]; if (!ok) { kv = (v4u){zz_, zz_, zz_, zz_}; vv = kv; }
        *(LAS v4u*)(lds + LK + j * 128 + ((ch ^ ((j >> 1) & 7)) * 16)) = kv;
        *(LAS v4u*)(lds + LV + j * 144 + ch * 16) = vv; }
}
__device__ __forceinline__ void compute(const U& w, int g3, const bf16x8 (&qr)[4], bf16* OG, float* LSE, LAS unsigned char* lds, int wave, int lane) {
    const int d = w.d, h = w.h, win0 = w.win0, sr = w.sr; const size_t rowbase = (size_t)w.b * SEQ; const int r32 = lane & 31, hi = lane >> 5;
    const int qrow = 128 + 32 * wave + r32; const size_t tokq = rowbase + (size_t)((win0 + qrow) * d + sr);
    f32x16 sc[5];
    const float csc = 0.125f * LOG2E, al = __builtin_amdgcn_exp2f(-(float)(h + 1)) * (float)d * LOG2E;
    const int sb = 128 + r32 - 4 * hi; const int stmax = min(128, win0 + qrow);
    const bool full = (win0 + 128 + 32 * wave) >= 128;
    float mx = -INFINITY;
#pragma unroll
    for (int j = 0; j < 5; ++j) { const int row = 32 * (wave + j) + r32; f32x16 a = {};
#pragma unroll
        for (int s = 0; s < 4; ++s) { const bf16x8 kf = *(const LAS bf16x8*)(lds + LK + row * 128 + (((2 * s + hi) ^ ((row >> 1) & 7)) * 16)); a = MFMA32(kf, qr[s], a); }
        int sbj = sb; asm volatile("" : "+v"(sbj) : "v"(a[15]));
        if (j >= 1 && j <= 3 && full) {
#pragma unroll
            for (int r = 0; r < 16; ++r) { const int st = sbj - (32 * j + (r & 3) + 8 * (r >> 2)); const float x = a[r] * csc - al * (float)st; a[r] = x; mx = fmaxf(mx, x); }
        } else {
#pragma unroll
        for (int r = 0; r < 16; ++r) { const int st = sbj - (32 * j + (r & 3) + 8 * (r >> 2));
            const float x = ((unsigned)st <= (unsigned)stmax) ? (a[r] * csc - al * (float)st) : -INFINITY; a[r] = x; mx = fmaxf(mx, x); } }
        sc[j] = a; __builtin_amdgcn_sched_barrier(0); }
    { auto rr = __builtin_amdgcn_permlane32_swap(__float_as_uint(mx), __float_as_uint(mx), false, false); mx = fmaxf(__uint_as_float(rr[0]), __uint_as_float(rr[1])); }
    float l = 0.f;
#pragma unroll
    for (int j = 0; j < 5; ++j)
#pragma unroll
        for (int r = 0; r < 16; ++r) { const float p = __builtin_amdgcn_exp2f(sc[j][r] - mx); sc[j][r] = p; l += p; }
    { auto rr = __builtin_amdgcn_permlane32_swap(__float_as_uint(l), __float_as_uint(l), false, false); l = __uint_as_float(rr[0]) + __uint_as_float(rr[1]); }
    f32x16 o[2]; o[0] = f32x16{}; o[1] = f32x16{};
    const int blk = (lane >> 4) & 1, q4 = (lane & 15) >> 2, p4 = lane & 3;
#pragma unroll
    for (int j = 0; j < 5; ++j)
#pragma unroll
        for (int s = 0; s < 2; ++s) {
            v4u pw; pw.x = pk2(sc[j][8 * s + 0], sc[j][8 * s + 1]); pw.y = pk2(sc[j][8 * s + 2], sc[j][8 * s + 3]); pw.z = pk2(sc[j][8 * s + 4], sc[j][8 * s + 5]); pw.w = pk2(sc[j][8 * s + 6], sc[j][8 * s + 7]);
            const bf16x8 pa = __builtin_bit_cast(bf16x8, pw);
            const int R0 = 32 * (wave + j) + 16 * s + 4 * hi + q4;
#pragma unroll
            for (int c = 0; c < 2; ++c) { const LAS unsigned char* vp = lds + LV + R0 * 144 + (32 * c + 16 * blk) * 2 + 8 * p4;
                const s16x4 lo = trrd(vp), hh = trrd(vp + 8 * 144); o[c] = MFMA32(pa, CAT8(lo, hh), o[c]); } __builtin_amdgcn_sched_barrier(0); }
    LAS float* scr = (LAS float*)(lds + LSCR + wave * 256);
    if (hi == 0) scr[r32] = 1.0f / l;
    asm volatile("s_waitcnt lgkmcnt(0)" ::: "memory");
    if (hi == 0) LSE[tokq * 8 + h] = mx + __builtin_amdgcn_logf(l);
#pragma unroll
    for (int r = 0; r < 16; ++r) { const int qq = crow(r, hi); const float inv = scr[qq]; const size_t tok = rowbase + (size_t)((win0 + 128 + 32 * wave + qq) * d + sr);
        bf16* op = OG + tok * 512 + h * 64 + r32; op[0] = (bf16)f2bf(o[0][r] * inv); op[32] = (bf16)f2bf(o[1][r] * inv); }
}
}

namespace ret {
constexpr int C = 64, KR = 528, VR = 288, SR = 528, LK = 0, LV = C * KR, LST = LV + C * VR, LTOT = LST + 128 * SR, NCH = SEQ / C;
static_assert(LTOT <= 131072, "ret lds");
__device__ __forceinline__ void unit(int b, int h, int vs, const bf16* Q, const bf16* K, bf16* V  , LAS unsigned char* lds, int tid_, int wave, int lane_, bf16* Vst, unsigned stmask) {
    const float gam = 1.0f - __builtin_amdgcn_exp2f(-5.0f - (float)h), lg = __builtin_amdgcn_logf(gam);
    const int wr = wave >> 2, wc = wave & 3;
    asm volatile("" : "+v"(tid_));
    { unsigned zz_ = 0u; asm volatile("" : "+v"(zz_)); for (int i = tid_; i < 128 * SR / 16; i += NWAVES * 64) *(LAS v4u*)(lds + LST + i * 16) = (v4u){zz_, zz_, zz_, zz_}; }
    __builtin_amdgcn_sched_barrier(0);
    const size_t rowbase = (size_t)b * SEQ;
    f32x16 S[4];
#pragma unroll
    for (int t = 0; t < 4; ++t) S[t] = f32x16{};
    const float c0 = __builtin_amdgcn_exp2f(-lg * (float)C), gC = __builtin_amdgcn_exp2f(lg * (float)C);
    v4u kreg[4], vreg[2]; bf16x8 qr[16];
    { int tp_ = tid_; asm volatile("" : "+v"(tp_)); const int tid = tp_, r32 = tp_ & 31, hi = (tp_ >> 5) & 1;
    const unsigned kg = ((unsigned)rowbase + (unsigned)(tid >> 5)) * 1024u + h * 256 + (tid & 31) * 8;
    const unsigned vg = ((unsigned)rowbase + (unsigned)(tid >> 4)) * 2048u + h * 512 + vs * 128 + (tid & 15) * 8;
    const unsigned qg = ((unsigned)rowbase + (unsigned)(32 * wr + r32)) * 1024u + h * 256 + 8 * hi;
#pragma unroll
    for (int k = 0; k < 4; ++k) kreg[k] = *(const v4u*)(K + (kg + (unsigned)(16 * k) * 1024u));
#pragma unroll
    for (int k = 0; k < 2; ++k) vreg[k] = *(const v4u*)(V + (vg + (unsigned)(32 * k) * 2048u));
#pragma unroll
    for (int s = 0; s < 16; ++s) qr[s] = *(const bf16x8*)(Q + (qg + 16u * s)); }
    for (int ci = 0; ci < NCH; ++ci) {
        const size_t t0 = rowbase + (size_t)ci * C; const bool more = (ci + 1 < NCH);
        int tl = tid_; asm volatile("" : "+v"(tl));
        const int tid = tl, lane = tl & 63, r32 = lane & 31, hi = lane >> 5, blk = (lane >> 4) & 1, q4 = (lane & 15) >> 2, p4 = lane & 3;
        const unsigned kg = ((unsigned)rowbase + (unsigned)(tid >> 5)) * 1024u + h * 256 + (tid & 31) * 8;
        const unsigned vg = ((unsigned)rowbase + (unsigned)(tid >> 4)) * 2048u + h * 512 + vs * 128 + (tid & 15) * 8;
        const unsigned qg = ((unsigned)rowbase + (unsigned)(32 * wr + r32)) * 1024u + h * 256 + 8 * hi;
#pragma unroll
        for (int k = 0; k < 4; ++k) *(LAS v4u*)(lds + LK + ((tid >> 5) + 16 * k) * KR + (tid & 31) * 16) = kreg[k];
#pragma unroll
        for (int k = 0; k < 2; ++k) { const int t = (tid >> 4) + 32 * k; const v4u raw = vreg[k];
            const float kd = __builtin_amdgcn_exp2f(lg * (float)(C - 1 - t)) * 0.0625f; v4u w;
            w.x = pk2(__builtin_bit_cast(float, raw.x << 16) * kd, __builtin_bit_cast(float, raw.x & 0xffff0000u) * kd);
            w.y = pk2(__builtin_bit_cast(float, raw.y << 16) * kd, __builtin_bit_cast(float, raw.y & 0xffff0000u) * kd);
            w.z = pk2(__builtin_bit_cast(float, raw.z << 16) * kd, __builtin_bit_cast(float, raw.z & 0xffff0000u) * kd);
            w.w = pk2(__builtin_bit_cast(float, raw.w << 16) * kd, __builtin_bit_cast(float, raw.w & 0xffff0000u) * kd);
            *(LAS v4u*)(lds + LV + t * VR + (tid & 15) * 16) = w; }
        LBAR();
        f32x16 acc = f32x16{}, it0 = f32x16{}, it1 = f32x16{};
        const LAS unsigned char* sp = lds + LST + (32 * wc + r32) * SR + 16 * hi;
        const LAS unsigned char* kp = lds + LK + r32 * KR + 16 * hi;
        const unsigned qn = qg + (unsigned)(ci + 1) * C * 1024u;
#pragma unroll
        for (int g = 0; g < 4; ++g) {
#pragma unroll
            for (int s = 0; s < 4; ++s) { const int ks = 4 * g + s; acc = MFMA32(qr[ks], *(const LAS bf16x8*)(sp + 32 * ks), acc);
                it0 = MFMA32(*(const LAS bf16x8*)(kp + 32 * ks), qr[ks], it0); if (wr) it1 = MFMA32(*(const LAS bf16x8*)(kp + 32 * KR + 32 * ks), qr[ks], it1); }
            __builtin_amdgcn_sched_barrier(0);
            if (more) {
#pragma unroll
                for (int s = 0; s < 4; ++s) qr[4 * g + s] = *(const bf16x8*)(Q + (qn + 16u * (4 * g + s))); }
            __builtin_amdgcn_sched_barrier(0);
        }
#define PVSTEP(IT, J) do { int qv = 32 * wr + r32 - 4 * hi; asm volatile("" : "+v"(qv) : "v"(IT[15])); \
            _Pragma("unroll") for (int r = 0; r < 16; ++r) { IT[r] = ((32 * (J) + (r & 3) + 8 * (r >> 2)) <= qv) ? IT[r] * c0 : 0.f; } \
            _Pragma("unroll") for (int s = 0; s < 2; ++s) { \
                v4u pw; pw.x = pk2(IT[8 * s + 0], IT[8 * s + 1]); pw.y = pk2(IT[8 * s + 2], IT[8 * s + 3]); pw.z = pk2(IT[8 * s + 4], IT[8 * s + 5]); pw.w = pk2(IT[8 * s + 6], IT[8 * s + 7]); \
                const LAS unsigned char* vp = lds + LV + (32 * (J) + 16 * s + 4 * hi + q4) * VR + (32 * wc + 16 * blk) * 2 + 8 * p4; \
                const s16x4 lo = trrd(vp), hh = trrd(vp + 8 * VR); acc = MFMA32(__builtin_bit_cast(bf16x8, pw), CAT8(lo, hh), acc); } } while (0)
        PVSTEP(it0, 0);
        if (wr) PVSTEP(it1, 1);
#undef PVSTEP
        __builtin_amdgcn_sched_barrier(0);
        if (more) { const unsigned nr = (unsigned)(ci + 1) * C;
#pragma unroll
            for (int k = 0; k < 4; ++k) kreg[k] = *(const v4u*)(K + (kg + (nr + 16 * k) * 1024u));
#pragma unroll
            for (int k = 0; k < 2; ++k) vreg[k] = *(const v4u*)(V + (vg + (nr + 32 * k) * 2048u)); }
        __builtin_amdgcn_sched_barrier(0);
        { unsigned ob = ((unsigned)t0 + 32 * wr + 4 * hi) * 2048u + h * 512 + vs * 128 + 32 * wc + r32; asm volatile("" : "+v"(ob));
          float fb = lg * (float)(32 * wr + 4 * hi + 1); asm volatile("" : "+v"(fb));
#pragma unroll
          for (int r = 0; r < 16; ++r) { const int dq = (r & 3) + 8 * (r >> 2); const float f = __builtin_amdgcn_exp2f(fb + lg * (float)dq);
            Vst[(ob + (unsigned)dq * 2048u) & stmask] = (bf16)f2bf(acc[r] * f); } }
        __builtin_amdgcn_sched_barrier(0);
#pragma unroll
        for (int t = 0; t < 4; ++t) S[t] = S[t] * gC;
#pragma unroll
        for (int s = 0; s < 4; ++s) {
            const LAS unsigned char* ka = lds + LK + (16 * s + 8 * hi + q4) * KR + (32 * wave + 16 * blk) * 2 + 8 * p4;
            const s16x4 klo = trrd(ka), khi = trrd(ka + 4 * KR); const bf16x8 kf = CAT8(klo, khi);
#pragma unroll
            for (int t = 0; t < 4; ++t) { const LAS unsigned char* vb = lds + LV + (16 * s + 8 * hi + q4) * VR + (32 * t + 16 * blk) * 2 + 8 * p4;
                const s16x4 vlo = trrd(vb), vhi = trrd(vb + 4 * VR); S[t] = MFMA32(kf, CAT8(vlo, vhi), S[t]); } __builtin_amdgcn_sched_barrier(0); }
        LBAR();
#pragma unroll
        for (int t = 0; t < 4; ++t)
#pragma unroll
            for (int g4 = 0; g4 < 4; ++g4) { v2u w; w.x = pk2(S[t][4 * g4 + 0], S[t][4 * g4 + 1]); w.y = pk2(S[t][4 * g4 + 2], S[t][4 * g4 + 3]);
                *(LAS v2u*)(lds + LST + (32 * t + r32) * SR + (32 * wave + 8 * g4 + 4 * hi) * 2) = w; }
    }
    __syncthreads();
}
}

struct Args { const float* in[11]; float* out; unsigned char* ws; int pad0, pad1; };
__global__ void __launch_bounds__(NWAVES * 64, 2) fwd_mk(Args args) {
    extern __shared__ __attribute__((aligned(16))) unsigned char lds_raw[];
    cg::grid_group grid = cg::this_grid();
#define GSYNC() do { xcd_barrier(xbar); if (PROBE_DOUBLE == 11) xcd_barrier(xbar); } while (0)
#ifndef PROBE_T
#define PROBE_T 0
#endif
#define GSYNCN(id) do { GSYNC(); if (PROBE_T && bx == 0 && threadIdx.x == 0) { const unsigned long long t_ = __builtin_amdgcn_s_memrealtime(); if (PROBE_T == (id) + 1) tacc[0] += t_ - tacc[1]; tacc[1] = t_; } } while (0)
    LAS unsigned char* lds = (LAS unsigned char*)lds_raw;
    int tid = threadIdx.x, lane = tid & 63, wave = __builtin_amdgcn_readfirstlane(tid >> 6);
#define RETID() do { tid = threadIdx.x; asm volatile("" : "+v"(tid)); lane = tid & 63; wave = __builtin_amdgcn_readfirstlane(tid >> 6); bx = blockIdx.x; asm volatile("" : "+s"(bx)); vcu = (bx % 8) * (G / 8) + bx / 8; gw = vcu * NWAVES + wave; RELOAD(); } while (0)
    constexpr int G = 256; int bx = blockIdx.x, vcu = (bx % 8) * (G / 8) + bx / 8;
    int gw = vcu * NWAVES + wave; constexpr int NGW = G * NWAVES;
    LAS unsigned long long* ptab = (LAS unsigned long long*)(lds + LDS_BYTES - 128);
    LAS unsigned long long* tacc = (LAS unsigned long long*)(lds + LDS_BYTES - 160);
    if (PROBE_T && threadIdx.x == 0) { tacc[0] = 0; tacc[1] = __builtin_amdgcn_s_memrealtime(); }
    if (tid == 0) {
        ptab[0] = (unsigned long long)args.in[0]; ptab[1] = (unsigned long long)args.in[1]; ptab[2] = (unsigned long long)args.in[2]; ptab[3] = (unsigned long long)args.in[3];
        ptab[4] = (unsigned long long)args.in[4]; ptab[5] = (unsigned long long)args.in[5]; ptab[6] = (unsigned long long)args.in[6]; ptab[7] = (unsigned long long)args.in[7];
        ptab[8] = (unsigned long long)args.in[8]; ptab[9] = (unsigned long long)args.in[9]; ptab[10] = (unsigned long long)args.in[10]; ptab[11] = (unsigned long long)args.out; ptab[12] = (unsigned long long)args.ws; }
    __syncthreads();
#define GASP(T, i) ((T*)(__attribute__((address_space(1))) T*)LDP(i))
#define LDP(i) ({ const unsigned long long v_ = ptab[(i) + pz_]; (((unsigned long long)(unsigned)__builtin_amdgcn_readfirstlane((int)(v_ >> 32))) << 32) | (unsigned long long)(unsigned)__builtin_amdgcn_readfirstlane((int)(unsigned)v_); })
#define RELOAD() do { int pz_ = 0; asm volatile("" : "+v"(pz_) :: "memory"); ws = GASP(unsigned char, 12); out = GASP(float, 11); in.x = GASP(const float, 0); in.gmix = GASP(const float, 1); in.gffn = GASP(const float, 2); in.ewin = GASP(const float, 3); in.ebf = GASP(const float, 4); \
        in.ewout = GASP(const float, 5); in.owin = GASP(const float, 6); in.owout = GASP(const float, 7); in.f1 = GASP(const float, 8); in.f2 = GASP(const float, 9); in.gfin = GASP(const float, 10); \
        XN = (bf16*)(ws + WS_XN); LOGF = (float*)(ws + WS_LOGF); SSM = (float*)(ws + 1020 * MiB); SSF = (float*)(ws + WS_LSE);     LSE = (float*)(ws + WS_LSE); } while (0)
    unsigned char* ws; float* out; Ins in; bf16* XN; float* LOGF; float* SSM; float* SSF; float* LSE;
    RELOAD();
    volatile LAS unsigned* xst = (volatile LAS unsigned*)(lds + LDS_BYTES - 192);
    if (threadIdx.x == 0) { xst[0] = 0u; xst[1] = 0u; }
    __syncthreads();
    XcdBarrier xbar = xcd_barrier_post((unsigned*)ws, xst);
    p0_prologue(in, ws, lds, gw, NGW, wave, lane);
    if (PROBE_DOUBLE == 10) p0_prologue(in, ws, lds, gw, NGW, wave, lane);
    __syncthreads();
#pragma unroll 1
    for (int layer = 0; layer < DEPTH; ++layer) {
        const int li = layer >> 1; const bool even = (layer & 1) == 0;
        RETID();
#define XIN ((layer == 0) ? in.x : out)
        if (layer == 0) {
            gate_pass<true>(in.x, XN, SSM, in.gmix, in.ewin + EVEN_N, in.ebf, LOGF, lds, gw, NGW, tid, lane);
            grid.sync();
            if (PROBE_T && bx == 0 && threadIdx.x == 0) { const unsigned long long t_ = __builtin_amdgcn_s_memrealtime(); if (PROBE_T == 1) tacc[0] += t_ - tacc[1]; tacc[1] = t_; }
            RETID();
        }
#define ZERO_SS(P) do { for (int i_ = vcu * (NWAVES * 64) + tid; i_ < M; i_ += G * NWAVES * 64) (P)[i_] = 0.f; } while (0)
        if (even) {
            if (layer != 0) { gate_pass<false>(nullptr, XN, SSM, in.gmix + layer * DM, in.ewin + (size_t)li * DM * EVEN_IN + EVEN_N, in.ebf + li * 8, LOGF, lds, gw, NGW, tid, lane); RETID(); }
            { pg8::Gemm g{XN, (const bf16*)(ws + WS_EIN) + (size_t)li * EVEN_N * DM, M, EVEN_N, DM}; pg8::StaticOrder S; S.init(M, EVEN_N, G, bx);
              pg8::EpiSplit<0> E{(bf16*)(ws + WS_ACT), 512, 512, SEG / 2, 3, attn_body::C2, SSM};
              for (int rp = 0; rp < (PROBE_DOUBLE == 9 ? 2 : 1); ++rp) pg8::gemm_phase<pg8::EpiSplit<0>, pg8::StaticOrder, PG8_ALIGN, PG8_SP2, STREAM_F16 != 0>(lds, g, S, E); }
            GSYNCN(1);
            { const attn_body::AttnTensors AT{(const attn_body::bf16*)(ws + WS_ACT + 3 * SEG), (const attn_body::bf16*)(ws + WS_ACT + 4 * SEG), (const attn_body::bf16*)(ws + WS_ACT + 5 * SEG),
                                              (attn_body::bf16*)(ws + WS_AO) + 512, LOGF};
              const attn_body::StaticOrder S(G, bx);
              for (int rp = 0; rp < (PROBE_DOUBLE == 2 ? 2 : 1); ++rp) attn_body::attn_phase<attn_body::StaticOrder>((char*)lds_raw, AT, S);
 }
            __syncthreads(); RETID();
            for (int rp = 0; rp < (PROBE_DOUBLE == 1 ? 2 : 1); ++rp) {
                constexpr int NU = BATCH * 8 * 3 * 16; const bf16* QA = (const bf16*)(ws + WS_ACT); const bf16* KA = (const bf16*)(ws + WS_ACT + SEG); const bf16* VA = (const bf16*)(ws + WS_ACT + 2 * SEG);
                v4u kreg[6], vreg[6]; bf16x8 qn[4];
                dil::U cur = dil::decode(vcu); dil::issue(cur, QA, KA, VA, tid, wave, lane, kreg, vreg, qn);
                for (int u = vcu; u < NU; u += G) {
                    dil::stage(cur, lds, tid, kreg, vreg);
                    bf16x8 qc[4];
#pragma unroll
                    for (int s_ = 0; s_ < 4; ++s_) qc[s_] = qn[s_];
                    LBAR();
                    const int g3 = (u >> 4) % 3; const dil::U me = cur;
                    if (u + G < NU) { cur = dil::decode(u + G); dil::issue(cur, QA, KA, VA, tid, wave, lane, kreg, vreg, qn); }
                    dil::compute(me, g3, qc, (bf16*)(ws + WS_OG + (size_t)g3 * SEG), LSE + (size_t)g3 * M * 8, lds, wave, lane);
                    LBAR();
                }
            }
            GSYNCN(2);
            RETID();
            for (int rp = 0; rp < (PROBE_DOUBLE == 5 ? 2 : 1); ++rp)
            for (int m = gw; m < M; m += NGW) { const int hh = lane >> 3;
                const float l0 = LSE[(size_t)m * 8 + hh], l1 = LSE[(size_t)M * 8 + (size_t)m * 8 + hh], l2 = LSE[(size_t)2 * M * 8 + (size_t)m * 8 + hh];
                const float mx = fmaxf(l0, fmaxf(l1, l2)); float w0 = __builtin_amdgcn_exp2f(l0 - mx), w1 = __builtin_amdgcn_exp2f(l1 - mx), w2 = __builtin_amdgcn_exp2f(l2 - mx); const float inv = 1.0f / (w0 + w1 + w2); w0 *= inv; w1 *= inv; w2 *= inv;
                const v4u a = *((const v4u*)((const bf16*)(ws + WS_OG) + (size_t)m * 512) + lane), bq = *((const v4u*)((const bf16*)(ws + WS_OG + SEG) + (size_t)m * 512) + lane), c = *((const v4u*)((const bf16*)(ws + WS_OG + 2 * SEG) + (size_t)m * 512) + lane);
                v4u o;
#define CMB(f) { const float lo = w0 * __builtin_bit_cast(float, a.f << 16) + w1 * __builtin_bit_cast(float, bq.f << 16) + w2 * __builtin_bit_cast(float, c.f << 16); \
                 const float hi_ = w0 * __builtin_bit_cast(float, a.f & 0xffff0000u) + w1 * __builtin_bit_cast(float, bq.f & 0xffff0000u) + w2 * __builtin_bit_cast(float, c.f & 0xffff0000u); o.f = pk2(lo, hi_); }
                CMB(x) CMB(y) CMB(z) CMB(w)
#undef CMB
                *((v4u*)((bf16*)(ws + WS_AO) + (size_t)m * 1024) + lane) = o; }
            GSYNCN(3);
            RETID();
            { pg8::Gemm g{(const bf16*)(ws + WS_AO), (const bf16*)(ws + WS_EOUT) + (size_t)li * DM * DM, M, DM, DM}; pg8::StaticOrder S; S.init(M, DM, G, bx);
              if (layer == 0) { pg8::EpiRes<true> E{in.x, XN, DM, SSF, nullptr}; pg8::gemm_phase<pg8::EpiRes<true>, pg8::StaticOrder, PG8_ALIGN, PG8_SP2>(lds, g, S, E); }
              else { pg8::EpiRes<false> E{nullptr, XN, DM, SSF, nullptr}; pg8::gemm_phase<pg8::EpiRes<false>, pg8::StaticOrder, PG8_ALIGN, PG8_SP2>(lds, g, S, E); } }
        } else {
            RETID();
            { pg8::Gemm g{XN, (const bf16*)(ws + WS_OIN) + (size_t)li * ODD_IN * DM, M, ODD_IN, DM}; pg8::StaticOrder S; S.init(M, ODD_IN, G, bx);
              pg8::EpiOddIn E{(bf16*)(ws + WS_RQ), (bf16*)(ws + WS_RK), (bf16*)(ws + WS_RV), (bf16*)(ws + WS_RG), SSM};
              for (int rp = 0; rp < (PROBE_DOUBLE == 13 ? 2 : 1); ++rp) pg8::gemm_phase<pg8::EpiOddIn, pg8::StaticOrder, PG8_ALIGN, PG8_SP2, STREAM_F16 != 0>(lds, g, S, E); }
            GSYNCN(4);
            RETID();
            for (int u = vcu; u < BATCH * 4 * 4; u += G) { const int vs = u & 3, bh = u >> 2;
                for (int rp = (PROBE_DOUBLE == 3 ? 0 : 1); rp < 2; ++rp) ret::unit(bh >> 2, bh & 3, vs, (const bf16*)(ws + WS_RQ), (const bf16*)(ws + WS_RK), (bf16*)(ws + WS_RV), lds, tid, wave, lane, (rp == 0) ? (bf16*)ws : (bf16*)(ws + WS_RV), (rp == 0) ? 0x7ffffu : 0xffffffffu); }
            GSYNCN(5);
            RETID();
            for (int it = gw; it < M * 4; it += NGW) { const size_t off = (size_t)(it >> 2) * 2048 + (it & 3) * 512 + lane * 8;
                const v4u ov = *(const v4u*)((const bf16*)(ws + WS_RV) + off), gv = *(const v4u*)((const bf16*)(ws + WS_RG) + off);
                float o[8], gg[8];
                o[0] = __builtin_bit_cast(float, ov.x << 16); o[1] = __builtin_bit_cast(float, ov.x & 0xffff0000u); o[2] = __builtin_bit_cast(float, ov.y << 16); o[3] = __builtin_bit_cast(float, ov.y & 0xffff0000u);
                o[4] = __builtin_bit_cast(float, ov.z << 16); o[5] = __builtin_bit_cast(float, ov.z & 0xffff0000u); o[6] = __builtin_bit_cast(float, ov.w << 16); o[7] = __builtin_bit_cast(float, ov.w & 0xffff0000u);
                gg[0] = __builtin_bit_cast(float, gv.x << 16); gg[1] = __builtin_bit_cast(float, gv.x & 0xffff0000u); gg[2] = __builtin_bit_cast(float, gv.y << 16); gg[3] = __builtin_bit_cast(float, gv.y & 0xffff0000u);
                gg[4] = __builtin_bit_cast(float, gv.z << 16); gg[5] = __builtin_bit_cast(float, gv.z & 0xffff0000u); gg[6] = __builtin_bit_cast(float, gv.w << 16); gg[7] = __builtin_bit_cast(float, gv.w & 0xffff0000u);
                float s = 0.f;
#pragma unroll
                for (int e = 0; e < 8; ++e) s += o[e];
                const float mu = wave_sum(s) * (1.f / 512.f); float q = 0.f;
#pragma unroll
                for (int e = 0; e < 8; ++e) { o[e] -= mu; q += o[e] * o[e]; }
                const float rs = 1.0f / sqrtf(wave_sum(q) * (1.f / 512.f) + GN_EPS);
                float y[8];
#pragma unroll
                for (int e = 0; e < 8; ++e) y[e] = gg[e] / (1.0f + __expf(-gg[e])) * (o[e] * rs);
                v4u w; w.x = pk2(y[0], y[1]); w.y = pk2(y[2], y[3]); w.z = pk2(y[4], y[5]); w.w = pk2(y[6], y[7]);
                *(v4u*)((bf16*)(ws + WS_RG) + off) = w; }
            GSYNCN(6);
            RETID();
            { pg8::Gemm g{(const bf16*)(ws + WS_RG), (const bf16*)(ws + WS_OOUT) + (size_t)li * 2 * DM * DM, M, DM, 2 * DM}; pg8::StaticOrder S; S.init(M, DM, G, bx);
              pg8::EpiRes<false> E{nullptr, XN, DM, SSF, nullptr}; pg8::gemm_phase<pg8::EpiRes<false>, pg8::StaticOrder, PG8_ALIGN, PG8_SP2>(lds, g, S, E); }
        }
        GSYNCN(7);
        RETID();
        if (PROBE_DOUBLE == 20) { const unsigned long long t0_ = __builtin_amdgcn_s_memrealtime(); while (__builtin_amdgcn_s_memrealtime() - t0_ < 25000ull) __builtin_amdgcn_s_sleep(16); }
        { pg8::Gemm g{XN, (const bf16*)(ws + WS_F1) + (size_t)layer * FF * DM, M, FF, DM}; pg8::StaticOrder S; S.init(M, FF, G, bx);
          pg8::EpiSplit<2> E{(bf16*)(ws + WS_H), FF, 0, 0, -1, 1.f, SSF};
          for (int rp = 0; rp < (PROBE_DOUBLE == 7 ? 2 : 1); ++rp) pg8::gemm_phase<pg8::EpiSplit<2>, pg8::StaticOrder, PG8_ALIGN, PG8_SP2, STREAM_F16 != 0>(lds, g, S, E); }
        GSYNCN(9);
        RETID();
        { pg8::Gemm g{(const bf16*)(ws + WS_H), (const bf16*)(ws + WS_F2) + (size_t)layer * FF * DM, M, DM, FF}; pg8::StaticOrder S; S.init(M, DM, G, bx);
          pg8::EpiRes<false> E{nullptr, XN, DM, SSM, SSF}; pg8::gemm_phase<pg8::EpiRes<false>, pg8::StaticOrder, PG8_ALIGN, PG8_SP2>(lds, g, S, E); }
        GSYNCN(10);
    }
    RETID();
    { f32x4 gv[4];
#pragma unroll
      for (int j = 0; j < 4; ++j) gv[j] = *((const f32x4*)in.gfin + lane + 64 * j);
      for (int m = gw; m < M; m += NGW) { const v2u* xr = (const v2u*)(XN + (size_t)m * DM) + lane; f32x4 v[4]; float s = 0.f;
#pragma unroll
          for (int j = 0; j < 4; ++j) { const v2u w = xr[64 * j]; v[j].x = pg8::st_lo(w.x); v[j].y = pg8::st_hi(w.x); v[j].z = pg8::st_lo(w.y); v[j].w = pg8::st_hi(w.y);
              s += (v[j].x * v[j].x + v[j].y * v[j].y) + (v[j].z * v[j].z + v[j].w * v[j].w); }
          const float rstd = 1.0f / sqrtf(wave_sum(s) * (1.f / DM) + RMS_EPS); f32x4* orow = (f32x4*)(out + (size_t)m * DM) + lane;
#pragma unroll
          for (int j = 0; j < 4; ++j) orow[64 * j] = v[j] * rstd * gv[j]; } }
    if (PROBE_T && bx == 0 && threadIdx.x == 0) { const unsigned long long t0_ = __builtin_amdgcn_s_memrealtime(), w_ = 10ull * tacc[0]; while (__builtin_amdgcn_s_memrealtime() - t0_ < w_) __builtin_amdgcn_s_sleep(8); }
}

extern "C" void kernel_launch(void* const* d_in, const int* in_sizes, int n_in, void* d_out, int out_size, void* d_ws, size_t ws_size, hipStream_t stream) {
    static int grid = 0;
    if (grid == 0) {
        if (n_in != 11 || in_sizes[0] != M * DM || out_size != M * DM || ws_size < WS_END) { fprintf(stderr, "kernel_launch: unexpected shapes (n_in %d, ws %zu)\n", n_in, ws_size); grid = -1; return; }
        if (hipFuncSetAttribute((const void*)fwd_mk, hipFuncAttributeMaxDynamicSharedMemorySize, LDS_BYTES) != hipSuccess) { fprintf(stderr, "kernel_launch: hipFuncSetAttribute failed\n"); grid = -1; return; }
        int dev = 0, cus = 0, per_cu = 0;
        hipGetDevice(&dev); hipDeviceGetAttribute(&cus, hipDeviceAttributeMultiprocessorCount, dev);
        hipOccupancyMaxActiveBlocksPerMultiprocessor(&per_cu, (const void*)fwd_mk, NWAVES * 64, LDS_BYTES);
        (void)hipGetLastError();
        if (per_cu < 1) per_cu = 1;
        grid = cus;
        if (grid != 256) { fprintf(stderr, "kernel_launch: built for a 256-CU device, found %d\n", cus); grid = -1; return; }
    }
    if (grid < 0) return;
    if (hipMemsetAsync(d_ws, 0, 16384, stream) != hipSuccess) { fprintf(stderr, "kernel_launch: memset failed\n"); return; }
    Args a{};
    for (int i = 0; i < 11; ++i) a.in[i] = (const float*)d_in[i];
    a.out = (float*)d_out; a.ws = (unsigned char*)d_ws;
    void* kargs[] = {&a};
    hipError_t e = hipLaunchCooperativeKernel((const void*)fwd_mk, dim3(grid), dim3(NWAVES * 64), kargs, LDS_BYTES, stream);
    if (e != hipSuccess) fprintf(stderr, "cooperative launch failed: %s (grid %d)\n", hipGetErrorString(e), grid);
}
```

```cpp
#include <hip/hip_runtime.h>
#include <cstdio>
#include <cstdint>
namespace pg8 {
#define PG8_LAS __attribute__((address_space(3)))
typedef unsigned short bf16_t;
typedef short bf16x8 __attribute__((ext_vector_type(8)));
typedef float f32x4 __attribute__((ext_vector_type(4)));
typedef unsigned u32x4 __attribute__((ext_vector_type(4)));
constexpr int BM = 256, BK = 64, HALF = 128, HTB = HALF * BK * 2  , STAGE_BYTES = 8 * HTB, NXCD = 8, WGM = 8;

__host__ __device__ __forceinline__ int lds_byte(int r, int c) { const int st = (r >> 4) * 2 + (c >> 5), rr = r & 15, cc = c & 31, ob = rr * 64 + cc * 2; return st * 1024 + (ob ^ (((ob >> 9) & 1) << 5)); }
__host__ __device__ __forceinline__ void stage_rc(int b, int& R, int& C) { const int st = b / 1024, sb = b % 1024, swz = sb ^ (((sb >> 9) & 1) << 5); R = (st >> 1) * 16 + swz / 64; C = (st & 1) * 32 + (swz % 64) / 2; }
__host__ __device__ __forceinline__ int perm32(int rho) { const int n = rho >> 4, i = rho & 15; return 8 * (i >> 2) + 4 * n + (i & 3); }

struct Unit { int pm, pn; };
struct Gemm { const bf16_t* A; const bf16_t* Bt; int M, N, K; };

struct StaticOrder {
    int nM, nN, nwg, G, c;
    __host__ __device__ void init(int M, int N, int G_, int c_) { nM = M / BM; nN = N / BM; nwg = nM * nN; G = G_; c = c_; }
    __host__ __device__ bool next(int i, Unit& u) const {
        const long L = (long)i * G + c; if (L >= nwg) return false;
        int wgid = (int)L; { const int q = nwg / NXCD, r = nwg % NXCD, xcd = wgid % NXCD, off = wgid / NXCD; wgid = (xcd < r ? xcd * (q + 1) : r * (q + 1) + (xcd - r) * q) + off; }
        const int nig = WGM * nN, gid = wgid / nig, fm = gid * WGM, gsz = (nM - fm) < WGM ? (nM - fm) : WGM;
        u.pm = fm + ((wgid % nig) % gsz); u.pn = (wgid % nig) / gsz; return true;
    }
    __device__ __forceinline__ void a_ready(const Unit&) const {}
    __device__ __forceinline__ void done(const Unit&) const {}
};

__device__ __forceinline__ unsigned cvt_pk_bf16(float lo, float hi) { unsigned r; asm volatile("v_cvt_pk_bf16_f32 %0, %1, %2" : "=v"(r) : "v"(lo), "v"(hi)); return r; }
typedef float f32x2 __attribute__((ext_vector_type(2)));
__device__ __forceinline__ f32x2 gelu_pk(f32x2 v) {
    const f32x2 av = __builtin_elementwise_abs(v), d = av * 0.2316418882f + 1.0f;
    f32x2 t; t.x = __builtin_amdgcn_rcpf(d.x); t.y = __builtin_amdgcn_rcpf(d.y);
    f32x2 q = t * 0.5307027145f + (-0.7265760135f); q = q * t + 0.7107068705f; q = q * t + (-0.142248368f); q = q * t + 0.127414796f; q = q * t;
    const f32x2 s = (v * v) * (-0.72134752044f);
    f32x2 e; e.x = __builtin_amdgcn_exp2f(s.x); e.y = __builtin_amdgcn_exp2f(s.y);
    const f32x2 m = v * (q * e), r = v - m;
    f32x2 o; o.x = v.x < 0.f ? m.x : r.x; o.y = v.y < 0.f ? m.y : r.y; return o;
}

template <int ACT  > struct EpiBf16 {
    static constexpr bool PERM = true, AFTER_DRAIN = false; static_assert(ACT == 0 || ACT == 1, "EpiBf16: ACT is 0 (none) or 1 (gelu_pk)");
    bf16_t* O; int ldc; const float* bias; int split_cols; size_t split_stride; float scale0;
    __device__ __forceinline__ void operator()(const f32x4 (&acc)[2][2][4][2], const Unit& u, int wr, int wc, int fr, int fq) const {
        const int row0 = u.pm * BM + wr * 64 + fr; int colt = u.pn * BM; bf16_t* base = O;
        float sc = 1.f; if (split_cols) { const int t = colt / split_cols; base += (size_t)t * split_stride; colt -= t * split_cols; if (t == 0) sc = scale0; }
        const int col0 = colt + wc * 32 + 8 * fq, bcol0 = u.pn * BM + wc * 32 + 8 * fq;
        f32x4 bv[2][2];
#pragma unroll
        for (int bj = 0; bj < 2; ++bj)
#pragma unroll
            for (int n = 0; n < 2; ++n) bv[bj][n] = bias ? *(const f32x4*)(bias + bcol0 + bj * HALF + 4 * n) : (f32x4){0.f, 0.f, 0.f, 0.f};
#pragma unroll
        for (int ai = 0; ai < 2; ++ai)
#pragma unroll
            for (int m = 0; m < 4; ++m) { bf16_t* rowp = base + (size_t)(row0 + ai * HALF + m * 16) * ldc + col0;
#pragma unroll
                for (int bj = 0; bj < 2; ++bj) { f32x4 v0 = acc[ai][bj][m][0] + bv[bj][0], v1 = acc[ai][bj][m][1] + bv[bj][1];
                    if (ACT == 1) { f32x2 a = gelu_pk((f32x2){v0[0], v0[1]}), b = gelu_pk((f32x2){v0[2], v0[3]}), c = gelu_pk((f32x2){v1[0], v1[1]}), d = gelu_pk((f32x2){v1[2], v1[3]});
                        v0 = (f32x4){a.x, a.y, b.x, b.y}; v1 = (f32x4){c.x, c.y, d.x, d.y}; }
                    v0 = v0 * sc; v1 = v1 * sc; u32x4 w; w.x = cvt_pk_bf16(v0[0], v0[1]); w.y = cvt_pk_bf16(v0[2], v0[3]); w.z = cvt_pk_bf16(v1[0], v1[1]); w.w = cvt_pk_bf16(v1[2], v1[3]);
                    *(u32x4*)(rowp + bj * HALF) = w; } }
    }
};

struct PanelStats {
    unsigned* xbuf;
    unsigned* cnt;
    unsigned* tmo;
    int ntn; float eps;
    unsigned code;
    __device__ __forceinline__ bool run(const f32x4 (&v)[2][2][4][2], const Unit& u, int wr, int wc, int fr, int fq, PG8_LAS unsigned char* lds, int wid, int lane) const {
        typedef float f32x2v __attribute__((ext_vector_type(2)));
        PG8_LAS f32x2v* P = (PG8_LAS f32x2v*)lds;
        PG8_LAS f32x2v* S = (PG8_LAS f32x2v*)(lds + 8192);
        PG8_LAS unsigned* flag = (PG8_LAS unsigned*)(lds + 8192 + 2048);
#pragma unroll
        for (int ai = 0; ai < 2; ++ai)
#pragma unroll
            for (int m = 0; m < 4; ++m) {
                float s = 0.f;
#pragma unroll
                for (int bj = 0; bj < 2; ++bj)
#pragma unroll
                    for (int n = 0; n < 2; ++n) { const f32x4 x = v[ai][bj][m][n]; s += (x[0] + x[1]) + (x[2] + x[3]); }
                s += __shfl_xor(s, 16); s += __shfl_xor(s, 32);
                const float mw = s * (1.0f / 64.0f); float q = 0.f;
#pragma unroll
                for (int bj = 0; bj < 2; ++bj)
#pragma unroll
                    for (int n = 0; n < 2; ++n) { const f32x4 d = v[ai][bj][m][n] - mw; q += (d[0] * d[0] + d[1] * d[1]) + (d[2] * d[2] + d[3] * d[3]); }
                q += __shfl_xor(q, 16); q += __shfl_xor(q, 32);
                if (fq == 0) P[(ai * HALF + wr * 64 + m * 16 + fr) * 4 + wc] = (f32x2v){mw, q};
            }
        asm volatile("s_waitcnt lgkmcnt(0)" ::: "memory"); __builtin_amdgcn_s_barrier(); asm volatile("" ::: "memory");
#if defined(BROKEN_EXCHANGE_NO_WAIT)
#warning BROKEN CONTROL BUILD: the row-statistics exchange does not wait; results are wrong by design
        if (blockIdx.x >= 64) { const long long t0_ = clock64(); while (clock64() - t0_ < 60000) __builtin_amdgcn_s_sleep(8); }
#endif
        const int row = wid * 32 + (lane & 31);
        if (lane < 32) {
            const f32x2v a = P[row * 4 + 0], b = P[row * 4 + 1], c = P[row * 4 + 2], d = P[row * 4 + 3];
            const float mt = (a.x + b.x + c.x + d.x) * 0.25f;
            const float da = a.x - mt, db = b.x - mt, dc = c.x - mt, dd = d.x - mt;
            const float m2 = (a.y + b.y) + (c.y + d.y) + 64.0f * ((da * da + db * db) + (dc * dc + dd * dd));
            unsigned long long* slot = (unsigned long long*)xbuf + ((size_t)(u.pm * BM + row) * 4 + u.pn);
            __hip_atomic_store(slot, ((unsigned long long)__float_as_uint(m2) << 32) | __float_as_uint(mt), __ATOMIC_RELAXED, __HIP_MEMORY_SCOPE_AGENT);
        }
        asm volatile("s_waitcnt vmcnt(0)" ::: "memory");
        if (lane == 0) __hip_atomic_fetch_add(cnt + 64 * u.pm, 1u, __ATOMIC_RELAXED, __HIP_MEMORY_SCOPE_AGENT);
        if (wid == 0) {
            bool dead = false; const unsigned long long t0 = __builtin_amdgcn_s_memrealtime(); const unsigned want = 8u * (unsigned)ntn;
            for (;;) {
#if defined(BROKEN_EXCHANGE_NO_WAIT)
                break;
#endif
                if ((unsigned)__builtin_amdgcn_readfirstlane(__hip_atomic_load(cnt + 64 * u.pm, __ATOMIC_RELAXED, __HIP_MEMORY_SCOPE_AGENT)) >= want) break;
                if (__builtin_amdgcn_s_memrealtime() - t0 > 2000000ull) {
                    if (lane == 0) { unsigned expect = 0u; __hip_atomic_compare_exchange_strong(tmo + 1, &expect, code | (unsigned)(u.pm & 0xff), __ATOMIC_RELAXED, __ATOMIC_RELAXED, __HIP_MEMORY_SCOPE_AGENT);
                                     __hip_atomic_store(tmo, 1u, __ATOMIC_RELAXED, __HIP_MEMORY_SCOPE_AGENT); }
                    dead = true; break; }
                __builtin_amdgcn_s_sleep(2);
            }
            __builtin_amdgcn_fence(__ATOMIC_ACQUIRE, "agent");
            if (lane == 0) flag[0] = dead ? 1u : 0u;
        }
        asm volatile("s_waitcnt vmcnt(0) lgkmcnt(0)" ::: "memory"); __builtin_amdgcn_s_barrier(); asm volatile("" ::: "memory");
        const bool bad = flag[0] != 0u;
        if (lane < 32) {
            const unsigned long long* slot = (const unsigned long long*)xbuf + (size_t)(u.pm * BM + row) * 4; float mt[4], m2[4]; float ms = 0.f;
#pragma unroll
            for (int t = 0; t < 4; ++t) { if (t < ntn) { const unsigned long long w = __hip_atomic_load(slot + t, __ATOMIC_RELAXED, __HIP_MEMORY_SCOPE_AGENT); mt[t] = __uint_as_float((unsigned)w); m2[t] = __uint_as_float((unsigned)(w >> 32)); } else { mt[t] = 0.f; m2[t] = 0.f; } ms += mt[t]; }
            const float mean = ms / (float)ntn; float q = 0.f;
#pragma unroll
            for (int t = 0; t < 4; ++t) if (t < ntn) { const float dm = mt[t] - mean; q += m2[t] + 256.0f * dm * dm; }
            S[row] = (f32x2v){mean, 1.0f / sqrtf(q / (256.0f * (float)ntn) + eps)};
        }
        asm volatile("s_waitcnt lgkmcnt(0)" ::: "memory"); __builtin_amdgcn_s_barrier(); asm volatile("" ::: "memory");
        return bad;
    }
};
struct EpiLnRes {
    static constexpr bool PERM = false, AFTER_DRAIN = true;
    const float* base; float* out; int ldc; const float* bias; PanelStats st; unsigned poison;
    __device__ __forceinline__ void fused(f32x4 (&acc)[2][2][4][2], const Unit& u, int wr, int wc, int fr, int fq, PG8_LAS unsigned char* lds, int wid, int lane) const {
        typedef float f32x2v __attribute__((ext_vector_type(2)));
        const PG8_LAS f32x2v* S = (const PG8_LAS f32x2v*)(lds + 8192);
        const int col0 = u.pn * BM + wc * 32 + 4 * fq;
#pragma unroll
        for (int bj = 0; bj < 2; ++bj)
#pragma unroll
            for (int n = 0; n < 2; ++n) { const f32x4 bv = bias ? *(const f32x4*)(bias + col0 + bj * HALF + n * 16) : (f32x4){0.f, 0.f, 0.f, 0.f};
#pragma unroll
                for (int ai = 0; ai < 2; ++ai)
#pragma unroll
                    for (int m = 0; m < 4; ++m) acc[ai][bj][m][n] += bv; }
        f32x4 pre[4][2][2];
#pragma unroll
        for (int m = 0; m < 4; ++m) { const size_t off = (size_t)(u.pm * BM + wr * 64 + m * 16 + fr) * ldc + col0;
#pragma unroll
            for (int bj = 0; bj < 2; ++bj)
#pragma unroll
                for (int n = 0; n < 2; ++n) pre[m][bj][n] = *(const f32x4*)(base + off + bj * HALF + n * 16); }
        const bool bad = st.run(acc, u, wr, wc, fr, fq, lds, wid, lane) || poison != 0u;
        const float qnan = __builtin_nanf("");
#pragma unroll
        for (int ai = 0; ai < 2; ++ai)
#pragma unroll
            for (int m = 0; m < 4; ++m) { const int r = ai * HALF + wr * 64 + m * 16 + fr; const f32x2v sr = S[r]; const size_t off = (size_t)(u.pm * BM + r) * ldc + col0;
#pragma unroll
                for (int bj = 0; bj < 2; ++bj)
#pragma unroll
                    for (int n = 0; n < 2; ++n) { const f32x4 bs = ai == 0 ? pre[m][bj][n] : *(const f32x4*)(base + off + bj * HALF + n * 16); f32x4 o = bs + (acc[ai][bj][m][n] - sr.x) * sr.y;
                        if (bad) o = (f32x4){qnan, qnan, qnan, qnan}; *(f32x4*)(out + off + bj * HALF + n * 16) = o; }
                if (m & 1) asm volatile("" ::: "memory"); }
    }
};
struct EpiLnResLn {
    static constexpr bool PERM = false, AFTER_DRAIN = true;
    const float* base; float* out; bf16_t* xn; int ldc; const float* bias; PanelStats st1, st2; unsigned poison;
    __device__ __forceinline__ void fused(f32x4 (&acc)[2][2][4][2], const Unit& u, int wr, int wc, int fr, int fq, PG8_LAS unsigned char* lds, int wid, int lane) const {
        typedef float f32x2v __attribute__((ext_vector_type(2))); typedef unsigned u32x2v __attribute__((ext_vector_type(2)));
        const PG8_LAS f32x2v* S = (const PG8_LAS f32x2v*)(lds + 8192);
        const int col0 = u.pn * BM + wc * 32 + 4 * fq;
#pragma unroll
        for (int bj = 0; bj < 2; ++bj)
#pragma unroll
            for (int n = 0; n < 2; ++n) { const f32x4 bv = bias ? *(const f32x4*)(bias + col0 + bj * HALF + n * 16) : (f32x4){0.f, 0.f, 0.f, 0.f};
#pragma unroll
                for (int ai = 0; ai < 2; ++ai)
#pragma unroll
                    for (int m = 0; m < 4; ++m) acc[ai][bj][m][n] += bv; }
        bool bad = st1.run(acc, u, wr, wc, fr, fq, lds, wid, lane) || poison != 0u;
        const float qnan = __builtin_nanf("");
#pragma unroll
        for (int ai = 0; ai < 2; ++ai)
#pragma unroll
            for (int m = 0; m < 4; ++m) { const int r = ai * HALF + wr * 64 + m * 16 + fr; const f32x2v sr = S[r]; const size_t off = (size_t)(u.pm * BM + r) * ldc + col0;
#pragma unroll
                for (int bj = 0; bj < 2; ++bj)
#pragma unroll
                    for (int n = 0; n < 2; ++n) { const f32x4 bs = *(const f32x4*)(base + off + bj * HALF + n * 16); acc[ai][bj][m][n] = bs + (acc[ai][bj][m][n] - sr.x) * sr.y; }
                asm volatile("" : "+v"(acc[ai][0][m][0]), "+v"(acc[ai][0][m][1]), "+v"(acc[ai][1][m][0]), "+v"(acc[ai][1][m][1]));
                if (m & 1) asm volatile("" ::: "memory"); }
        const bool bad1 = bad;
        bad = st2.run(acc, u, wr, wc, fr, fq, lds, wid, lane) || bad;
#pragma unroll
        for (int ai = 0; ai < 2; ++ai)
#pragma unroll
            for (int m = 0; m < 4; ++m) { const int r = ai * HALF + wr * 64 + m * 16 + fr; const f32x2v sr = S[r]; const size_t off = (size_t)(u.pm * BM + r) * ldc + col0;
#pragma unroll
                for (int bj = 0; bj < 2; ++bj)
#pragma unroll
                    for (int n = 0; n < 2; ++n) { const f32x4 x1 = acc[ai][bj][m][n]; *(f32x4*)(out + off + bj * HALF + n * 16) = bad1 ? (f32x4){qnan, qnan, qnan, qnan} : x1;
                        const f32x4 o = (x1 - sr.x) * sr.y; u32x2v w; w.x = cvt_pk_bf16(o[0], o[1]); w.y = cvt_pk_bf16(o[2], o[3]);
                        if (bad) { w.x = 0x7fc07fc0u; w.y = 0x7fc07fc0u; } *(u32x2v*)(xn + off + bj * HALF + n * 16) = w; }
                asm volatile("" ::: "memory"); }
    }
};

template <bool F16> __device__ __forceinline__ f32x4 mma16(bf16x8 b, bf16x8 a, f32x4 c) {
    if constexpr (F16) { typedef _Float16 h8_t __attribute__((ext_vector_type(8))); return __builtin_amdgcn_mfma_f32_16x16x32_f16(__builtin_bit_cast(h8_t, b), __builtin_bit_cast(h8_t, a), c, 0, 0, 0); }
    else return __builtin_amdgcn_mfma_f32_16x16x32_bf16(b, a, c, 0, 0, 0);
}
template <class Epi, class Sched, bool ALIGN_EPI = false, bool SP2 = false, bool F16 = false>
__device__ __forceinline__ void gemm_phase(PG8_LAS unsigned char* lds, const Gemm g, const Sched& S, const Epi& E) {
#ifdef NO_GEMM
    return;
#endif
    int tid_l = threadIdx.x; asm volatile("" : "+v"(tid_l));
    const int tid = tid_l, wid = __builtin_amdgcn_readfirstlane(tid >> 6), lane = tid & 63, wr = wid >> 2, wc = wid & 3, fr = lane & 15, fq = lane >> 4;
    const int K = g.K, nt = K / BK;
    unsigned voffA[2], voffB[2];
#pragma unroll
    for (int i = 0; i < 2; ++i) { int R, C; stage_rc(tid * 16 + i * 8192, R, C); const int Rb = Epi::PERM ? ((R & ~31) + perm32(R & 31)) : R;
        voffA[i] = (unsigned)(R * K + C) * 2u; voffB[i] = (unsigned)(Rb * K + C) * 2u; }
    const size_t kstep = (size_t)(BK * 2);
    const size_t hstep = (size_t)HALF * K * 2;
    const size_t tstep = 2 * hstep;
    const unsigned ldsw = (unsigned)wid * 1024u;
    const int aoff = lds_byte(wr * 64 + fr, fq * 8), boff = lds_byte(wc * 32 + fr, fq * 8);
#define PG8_SA(b, h) (((b) * 2 + (h)) * HTB)
#define PG8_SB(b, h) ((4 + (b) * 2 + (h)) * HTB)
#define PG8_STAGE(bufoff, gbase, voff) do { _Pragma("unroll") for (int _i = 0; _i < 2; ++_i) \
        __builtin_amdgcn_global_load_lds((const unsigned*)((const char*)(gbase) + (voff)[_i]), (PG8_LAS unsigned*)(lds + (bufoff) + ldsw + _i * 8192), 16, 0, 0); } while (0)
#define PG8_LDA(dst, b, h) do { _Pragma("unroll") for (int m = 0; m < 4; ++m) _Pragma("unroll") for (int k = 0; k < 2; ++k) dst[m][k] = *(const PG8_LAS bf16x8*)(lds + PG8_SA(b, h) + aoff + m * 2048 + k * 1024); } while (0)
#define PG8_LDB(dst, b, h) do { _Pragma("unroll") for (int n = 0; n < 2; ++n) _Pragma("unroll") for (int k = 0; k < 2; ++k) dst[n][k] = *(const PG8_LAS bf16x8*)(lds + PG8_SB(b, h) + boff + n * 2048 + k * 1024); } while (0)
#define PG8_MMA(ai, bj, At, Bt) do { __builtin_amdgcn_s_setprio(1); _Pragma("unroll") for (int m = 0; m < 4; ++m) _Pragma("unroll") for (int n = 0; n < 2; ++n) _Pragma("unroll") for (int k = 0; k < 2; ++k) \
        acc[ai][bj][m][n] = mma16<F16>(Bt[n][k], At[m][k], acc[ai][bj][m][n]); __builtin_amdgcn_s_setprio(0); } while (0)
#define PG8_WAIT_V(n) asm volatile("s_waitcnt vmcnt(" #n ")" ::: "memory")
#define PG8_WAIT_L(n) asm volatile("s_waitcnt lgkmcnt(" #n ")" ::: "memory")
#define PG8_BAR __builtin_amdgcn_s_barrier()
#define PG8_SCHED __builtin_amdgcn_sched_barrier(0)
    Unit cur, nxt; int ui = 0;
    if (!S.next(0, cur)) return;
    f32x4 acc[2][2][4][2];
#pragma unroll
    for (int a = 0; a < 2; ++a)
#pragma unroll
        for (int b = 0; b < 2; ++b)
#pragma unroll
            for (int m = 0; m < 4; ++m)
#pragma unroll
                for (int n = 0; n < 2; ++n) acc[a][b][m][n] = (f32x4){0.f, 0.f, 0.f, 0.f};
    bf16x8 At[4][2], B0[2][2], B1[2][2];
    const char* cA = (const char*)g.A + (size_t)cur.pm * tstep; const char* cB = (const char*)g.Bt + (size_t)cur.pn * tstep;
    S.a_ready(cur);
    if constexpr (SP2) {
        PG8_STAGE(PG8_SB(0, 0), cB, voffB); PG8_STAGE(PG8_SB(0, 1), cB + hstep, voffB); PG8_STAGE(PG8_SA(0, 0), cA, voffA); PG8_STAGE(PG8_SA(0, 1), cA + hstep, voffA);
        if (wr == 1) PG8_BAR;
        PG8_WAIT_V(2); PG8_BAR;
        PG8_STAGE(PG8_SB(1, 0), cB + kstep, voffB); PG8_STAGE(PG8_SA(1, 0), cA + kstep, voffA); PG8_STAGE(PG8_SB(1, 1), cB + hstep + kstep, voffB);
        PG8_WAIT_V(6); PG8_BAR;
    } else {
        PG8_STAGE(PG8_SB(0, 0), cB, voffB); PG8_STAGE(PG8_SA(0, 0), cA, voffA); PG8_STAGE(PG8_SB(0, 1), cB + hstep, voffB); PG8_STAGE(PG8_SA(0, 1), cA + hstep, voffA);
        if (wr == 1) PG8_BAR;
        PG8_WAIT_V(4); PG8_BAR;
        PG8_STAGE(PG8_SB(1, 0), cB + kstep, voffB); PG8_STAGE(PG8_SA(1, 0), cA + kstep, voffA); PG8_STAGE(PG8_SB(1, 1), cB + hstep + kstep, voffB);
        PG8_WAIT_V(6); PG8_BAR;
    }
    for (;;) {
        const bool has_next = S.next(ui + 1, nxt);
        const char* nA = has_next ? (const char*)g.A + (size_t)nxt.pm * tstep : cA; const char* nB = has_next ? (const char*)g.Bt + (size_t)nxt.pn * tstep : cB;
        for (int t = 0; t < nt; t += 2) {
            const bool last = (t == nt - 2);
            const char* a1 = cA + (size_t)(t + 1) * kstep;
            const char* a2 = last ? nA : cA + (size_t)(t + 2) * kstep; const char* b2 = last ? nB : cB + (size_t)(t + 2) * kstep;
            const char* a3 = a2 + kstep; const char* b3 = b2 + kstep;
            if (last && has_next) S.a_ready(nxt);
            if constexpr (SP2) {
            PG8_LDB(B0, 0, 0); PG8_LDB(B1, 0, 1); PG8_SCHED; PG8_LDA(At, 0, 0); PG8_STAGE(PG8_SA(1, 1), a1 + hstep, voffA);
            PG8_WAIT_V(8); PG8_WAIT_L(0); PG8_BAR; PG8_MMA(0, 0, At, B0); PG8_MMA(0, 1, At, B1); PG8_BAR; PG8_SCHED;
            PG8_LDA(At, 0, 1); PG8_STAGE(PG8_SB(0, 0), b2, voffB); PG8_STAGE(PG8_SB(0, 1), b2 + hstep, voffB); PG8_STAGE(PG8_SA(0, 0), a2, voffA);
            PG8_WAIT_V(8); PG8_WAIT_L(0); PG8_BAR; PG8_MMA(1, 0, At, B0); PG8_MMA(1, 1, At, B1); PG8_BAR; PG8_SCHED;
            PG8_LDB(B0, 1, 0); PG8_LDB(B1, 1, 1); PG8_SCHED; PG8_LDA(At, 1, 0); PG8_STAGE(PG8_SA(0, 1), a2 + hstep, voffA);
            PG8_WAIT_V(8); PG8_WAIT_L(0); PG8_BAR; PG8_MMA(0, 0, At, B0); PG8_MMA(0, 1, At, B1); PG8_BAR; PG8_SCHED;
            PG8_LDA(At, 1, 1); PG8_STAGE(PG8_SB(1, 0), b3, voffB); PG8_STAGE(PG8_SB(1, 1), b3 + hstep, voffB); PG8_STAGE(PG8_SA(1, 0), a3, voffA);
            PG8_WAIT_V(8); PG8_WAIT_L(0); PG8_BAR; PG8_MMA(1, 0, At, B0); PG8_MMA(1, 1, At, B1); PG8_BAR; PG8_SCHED;
            } else {
            PG8_LDB(B0, 0, 0); PG8_SCHED; PG8_LDA(At, 0, 0); PG8_STAGE(PG8_SA(1, 1), a1 + hstep, voffA);
            PG8_WAIT_L(8); PG8_BAR; PG8_WAIT_L(0); PG8_MMA(0, 0, At, B0); PG8_BAR; PG8_SCHED;
            PG8_LDB(B1, 0, 1); PG8_STAGE(PG8_SB(0, 0), b2, voffB);
            PG8_BAR; PG8_WAIT_L(0); PG8_MMA(0, 1, At, B1); PG8_BAR;
            PG8_LDA(At, 0, 1); PG8_STAGE(PG8_SA(0, 0), a2, voffA);
            PG8_BAR; PG8_WAIT_L(0); PG8_MMA(1, 0, At, B0); PG8_BAR; PG8_SCHED;
            PG8_STAGE(PG8_SB(0, 1), b2 + hstep, voffB);
            PG8_WAIT_V(6); PG8_BAR; PG8_MMA(1, 1, At, B1); PG8_BAR;
            PG8_LDB(B0, 1, 0); PG8_SCHED; PG8_LDA(At, 1, 0); PG8_STAGE(PG8_SA(0, 1), a2 + hstep, voffA);
            PG8_WAIT_L(8); PG8_BAR; PG8_WAIT_L(0); PG8_MMA(0, 0, At, B0); PG8_BAR; PG8_SCHED;
            PG8_LDB(B1, 1, 1); PG8_STAGE(PG8_SB(1, 0), b3, voffB);
            PG8_BAR; PG8_WAIT_L(0); PG8_MMA(0, 1, At, B1); PG8_BAR;
            PG8_LDA(At, 1, 1); PG8_STAGE(PG8_SA(1, 0), a3, voffA);
            PG8_BAR; PG8_WAIT_L(0); PG8_MMA(1, 0, At, B0); PG8_BAR; PG8_SCHED;
            PG8_STAGE(PG8_SB(1, 1), b3 + hstep, voffB);
            PG8_WAIT_V(6); PG8_BAR; PG8_MMA(1, 1, At, B1); PG8_BAR;
            }
        }
        if constexpr (ALIGN_EPI) { if (wr == 0) PG8_BAR; }
        if constexpr (!Epi::AFTER_DRAIN) { E(acc, cur, wr, wc, fr, fq); S.done(cur); }
        if (!has_next) break;
#pragma unroll
        for (int a = 0; a < 2; ++a)
#pragma unroll
            for (int b = 0; b < 2; ++b)
#pragma unroll
                for (int m = 0; m < 4; ++m)
#pragma unroll
                    for (int n = 0; n < 2; ++n) acc[a][b][m][n] = (f32x4){0.f, 0.f, 0.f, 0.f};
        cur = nxt; cA = nA; cB = nB; ++ui;
        if constexpr (ALIGN_EPI) { if (wr == 1) PG8_BAR; }
    }
    PG8_WAIT_V(0);
    if constexpr (!ALIGN_EPI) { if (wr == 0) PG8_BAR; }
    PG8_BAR;
    if constexpr (Epi::AFTER_DRAIN) { E.fused(acc, cur, wr, wc, fr, fq, lds, wid, lane); S.done(cur); }
#undef PG8_SA
#undef PG8_SB
#undef PG8_STAGE
#undef PG8_LDA
#undef PG8_LDB
#undef PG8_MMA
#undef PG8_WAIT_V
#undef PG8_WAIT_L
#undef PG8_BAR
#undef PG8_SCHED
}
}

#ifndef PG8_SP2
#define PG8_SP2 true
#endif
#ifndef PG8_ALIGN
#define PG8_ALIGN true
#endif
namespace pg8 {
template <int ACT> struct EpiSplit {
    static constexpr bool PERM = true, AFTER_DRAIN = false;
    bf16_t* O; int ldc; int split_cols; size_t split_stride; int scale_t; float scale0; const float* ss;
    __device__ __forceinline__ void operator()(const f32x4 (&acc)[2][2][4][2], const Unit& u, int wr, int wc, int fr, int fq) const {
        const int row0 = u.pm * BM + wr * 64 + fr; int colt = u.pn * BM; bf16_t* base = O;
        float sc = 1.f; if (split_cols) { const int t = colt / split_cols; base += (size_t)t * split_stride; colt -= t * split_cols; if (t == scale_t) sc = scale0; }
        const int col0 = colt + wc * 32 + 8 * fq;
        float rs[2][4];
        if (ACT != 2) { f32x4 pp[2][4];
#pragma unroll
        for (int ai = 0; ai < 2; ++ai)
#pragma unroll
            for (int m = 0; m < 4; ++m) pp[ai][m] = *(const f32x4*)(ss + (size_t)(row0 + ai * HALF + m * 16) * 16 + 4 * fq);
        asm volatile("" ::: "memory");
#pragma unroll
        for (int ai = 0; ai < 2; ++ai)
#pragma unroll
            for (int m = 0; m < 4; ++m) { const f32x4 p = pp[ai][m]; float sq = (p[0] + p[1]) + (p[2] + p[3]);
                sq += __uint_as_float((unsigned)__builtin_amdgcn_ds_swizzle((int)__float_as_uint(sq), (16 << 10) | 0x1f));
                { auto rr = __builtin_amdgcn_permlane32_swap(__float_as_uint(sq), __float_as_uint(sq), false, false); sq = __uint_as_float(rr[0]) + __uint_as_float(rr[1]); }
                rs[ai][m] = __builtin_amdgcn_rsqf(sq * (1.0f / 1024.0f) + 1e-6f); } }
        else {
#pragma unroll
            for (int ai = 0; ai < 2; ++ai)
#pragma unroll
                for (int m = 0; m < 4; ++m) rs[ai][m] = 1.0f; }
#pragma unroll
        for (int ai = 0; ai < 2; ++ai)
#pragma unroll
            for (int m = 0; m < 4; ++m) { bf16_t* rowp = base + (size_t)(row0 + ai * HALF + m * 16) * ldc + col0;
#pragma unroll
                for (int bj = 0; bj < 2; ++bj) { f32x4 v0 = acc[ai][bj][m][0] * rs[ai][m], v1 = acc[ai][bj][m][1] * rs[ai][m];
                    if (ACT == 2) {
#pragma unroll
                        for (int e = 0; e < 4; ++e) { const float a = fmaxf(v0[e], 0.f), b = fmaxf(v1[e], 0.f); v0[e] = a * a; v1[e] = b * b; } }
                    v0 = v0 * sc; v1 = v1 * sc; u32x4 w; w.x = cvt_pk_bf16(v0[0], v0[1]); w.y = cvt_pk_bf16(v0[2], v0[3]); w.z = cvt_pk_bf16(v1[0], v1[1]); w.w = cvt_pk_bf16(v1[2], v1[3]);
                    *(u32x4*)(rowp + bj * HALF) = w; } }
    }
};
struct EpiOddIn {
    static constexpr bool PERM = true, AFTER_DRAIN = false;
    bf16_t *Q, *K, *V, *G; const float* ss;
    __device__ __forceinline__ void operator()(const f32x4 (&acc)[2][2][4][2], const Unit& u, int wr, int wc, int fr, int fq) const {
        const int row0 = u.pm * BM + wr * 64 + fr; const int pn = u.pn; bf16_t* base; int ldc, colt;
        if (pn < 4) { base = Q; ldc = 1024; colt = pn * BM; } else if (pn < 8) { base = K; ldc = 1024; colt = (pn - 4) * BM; }
        else if (pn < 16) { base = V; ldc = 2048; colt = (pn - 8) * BM; } else { base = G; ldc = 2048; colt = (pn - 16) * BM; }
        const int col0 = colt + wc * 32 + 8 * fq;
        float rs[2][4]; f32x4 pp[2][4];
#pragma unroll
        for (int ai = 0; ai < 2; ++ai)
#pragma unroll
            for (int m = 0; m < 4; ++m) pp[ai][m] = *(const f32x4*)(ss + (size_t)(row0 + ai * HALF + m * 16) * 16 + 4 * fq);
        asm volatile("" ::: "memory");
#pragma unroll
        for (int ai = 0; ai < 2; ++ai)
#pragma unroll
            for (int m = 0; m < 4; ++m) { const f32x4 p = pp[ai][m]; float sq = (p[0] + p[1]) + (p[2] + p[3]);
                sq += __uint_as_float((unsigned)__builtin_amdgcn_ds_swizzle((int)__float_as_uint(sq), (16 << 10) | 0x1f));
                { auto rr = __builtin_amdgcn_permlane32_swap(__float_as_uint(sq), __float_as_uint(sq), false, false); sq = __uint_as_float(rr[0]) + __uint_as_float(rr[1]); }
                rs[ai][m] = __builtin_amdgcn_rsqf(sq * (1.0f / 1024.0f) + 1e-6f); }
#pragma unroll
        for (int ai = 0; ai < 2; ++ai)
#pragma unroll
            for (int m = 0; m < 4; ++m) { bf16_t* rowp = base + (size_t)(row0 + ai * HALF + m * 16) * ldc + col0;
#pragma unroll
                for (int bj = 0; bj < 2; ++bj) { const f32x4 v0 = acc[ai][bj][m][0] * rs[ai][m], v1 = acc[ai][bj][m][1] * rs[ai][m];
                    u32x4 w; w.x = cvt_pk_bf16(v0[0], v0[1]); w.y = cvt_pk_bf16(v0[2], v0[3]); w.z = cvt_pk_bf16(v1[0], v1[1]); w.w = cvt_pk_bf16(v1[2], v1[3]);
                    *(u32x4*)(rowp + bj * HALF) = w; } }
    }
};
__device__ __forceinline__ unsigned cvt_pk_f16(float lo, float hi) { typedef _Float16 h2_t __attribute__((ext_vector_type(2))); const h2_t v = {(_Float16)lo, (_Float16)hi}; return __builtin_bit_cast(unsigned, v); }
__device__ __forceinline__ float f16lo(unsigned w) { typedef _Float16 h2_t __attribute__((ext_vector_type(2))); return (float)__builtin_bit_cast(h2_t, w)[0]; }
__device__ __forceinline__ float f16hi(unsigned w) { typedef _Float16 h2_t __attribute__((ext_vector_type(2))); return (float)__builtin_bit_cast(h2_t, w)[1]; }
#ifndef STREAM_F16
#define STREAM_F16 1
#endif
__device__ __forceinline__ unsigned st_pk(float lo, float hi) { return STREAM_F16 ? cvt_pk_f16(lo, hi) : cvt_pk_bf16(lo, hi); }
__device__ __forceinline__ float st_lo(unsigned w) { return STREAM_F16 ? f16lo(w) : __uint_as_float(w << 16); }
__device__ __forceinline__ float st_hi(unsigned w) { return STREAM_F16 ? f16hi(w) : __uint_as_float(w & 0xffff0000u); }
template <bool BASEF32> struct EpiRes {
    static constexpr bool PERM = false, AFTER_DRAIN = false;
    const float* basef; bf16_t* xb; int ldc; float* ss; const float* ss2;
    __device__ __forceinline__ void operator()(const f32x4 (&acc)[2][2][4][2], const Unit& u, int wr, int wc, int fr, int fq) const {
        typedef unsigned u32x2e __attribute__((ext_vector_type(2)));
        const int col0 = u.pn * BM + wc * 32 + 4 * fq;
#pragma unroll
        for (int ai = 0; ai < 2; ++ai)
#pragma unroll
        for (int mh = 0; mh < 2; ++mh) {
            f32x4 bs[2][2][2], pq[2]; float r2[2];
#pragma unroll
            for (int mm = 0; mm < 2; ++mm) { const int m = 2 * mh + mm; const size_t row = (size_t)(u.pm * BM + ai * HALF + wr * 64 + m * 16 + fr), off = row * ldc + col0;
                if (ss2) pq[mm] = *(const f32x4*)(ss2 + row * 16 + 4 * fq);
#pragma unroll
                for (int bj = 0; bj < 2; ++bj)
#pragma unroll
                    for (int n = 0; n < 2; ++n) {
                        if (BASEF32) bs[mm][bj][n] = *(const f32x4*)(basef + off + bj * HALF + n * 16);
                        else { const u32x2e w = *(const u32x2e*)(xb + off + bj * HALF + n * 16);
                            bs[mm][bj][n] = (f32x4){st_lo(w.x), st_hi(w.x), st_lo(w.y), st_hi(w.y)}; } } }
            asm volatile("" ::: "memory");
#pragma unroll
            for (int mm = 0; mm < 2; ++mm) { r2[mm] = 1.0f;
                if (ss2) { const f32x4 p = pq[mm]; float t = (p[0] + p[1]) + (p[2] + p[3]);
                    t += __uint_as_float((unsigned)__builtin_amdgcn_ds_swizzle((int)__float_as_uint(t), (16 << 10) | 0x1f));
                    { auto rr = __builtin_amdgcn_permlane32_swap(__float_as_uint(t), __float_as_uint(t), false, false); t = __uint_as_float(rr[0]) + __uint_as_float(rr[1]); }
                    r2[mm] = __builtin_amdgcn_rcpf(t * (1.0f / 1024.0f) + 1e-6f); } }
#pragma unroll
            for (int mm = 0; mm < 2; ++mm) { const int m = 2 * mh + mm; const size_t row = (size_t)(u.pm * BM + ai * HALF + wr * 64 + m * 16 + fr), off = row * ldc + col0;
                float sq = 0.f;
#pragma unroll
                for (int bj = 0; bj < 2; ++bj)
#pragma unroll
                    for (int n = 0; n < 2; ++n) { const f32x4 xn = bs[mm][bj][n] + acc[ai][bj][m][n] * r2[mm];
                        u32x2e w; w.x = st_pk(xn[0], xn[1]); w.y = st_pk(xn[2], xn[3]); *(u32x2e*)(xb + off + bj * HALF + n * 16) = w;
                        sq += (xn[0] * xn[0] + xn[1] * xn[1]) + (xn[2] * xn[2] + xn[3] * xn[3]); }
                sq += __uint_as_float((unsigned)__builtin_amdgcn_ds_swizzle((int)__float_as_uint(sq), (16 << 10) | 0x1f));
                { auto rr = __builtin_amdgcn_permlane32_swap(__float_as_uint(sq), __float_as_uint(sq), false, false); sq = __uint_as_float(rr[0]) + __uint_as_float(rr[1]); }
                if (fq == 0) ss[row * 16 + u.pn * 4 + wc] = sq; }
            asm volatile("" ::: "memory");
        }
    }
};
}
#include <hip/hip_bf16.h>
#include <cmath>
namespace attn_body {
using bf16=__hip_bfloat16;
using bf16x8=__attribute__((ext_vector_type(8)))short;
using s16x4=__attribute__((ext_vector_type(4)))short;
using f32x16=__attribute__((ext_vector_type(16)))float;
using u32x4=__attribute__((ext_vector_type(4)))unsigned;
constexpr int BATCH=16,NHEAD=8,SEQ=4096,D=64,DM=NHEAD*D,ODM=1024;
constexpr int NW=8,QBLK=32,QB=QBLK*NW,KVBLK=64,NQB=SEQ/QB;
constexpr int ATTN_PITCH=DM, ATTN_UNIT_ROWS=QB;
__device__ __forceinline__ int crow(int r,int hi){return (r&3)+8*(r>>2)+4*hi;}
#define SBAR() __builtin_amdgcn_sched_barrier(0)
__device__ __forceinline__ void cmask(f32x16&p0,f32x16&p1,int jb,int qrel,int hi){
  const float NEG=-INFINITY; int kb=64*jb+4*hi;
  #pragma unroll
  for(int r=0;r<16;++r){int kv=kb+(r&3)+8*(r>>2); if(kv>qrel)p0[r]=NEG; if(kv+32>qrel)p1[r]=NEG;}
}

constexpr int NSLOT=3, SLOTB=8192;
constexpr int LDS_K=0, LDS_V=NSLOT*SLOTB, LDS_WS=2*NSLOT*SLOTB, LDS_OST=LDS_WS+NW*64*4, LDS_CUM=LDS_OST+NW*4096,LDS_KN=LDS_CUM+SEQ*4,LDS_BYTES=LDS_KN+256;
constexpr float C2=0.125f*1.4426950408889634f;
__device__ __forceinline__ void glds16(const void*gsrc,unsigned lds_dst){unsigned keep;
  asm volatile("s_mov_b32 %0, m0\n\ts_mov_b32 m0, %2\n\ts_nop 0\n\tglobal_load_lds_dwordx4 %1, off\n\ts_mov_b32 m0, %0":"=&s"(keep):"v"(gsrc),"s"(lds_dst):"memory");}
__device__ __forceinline__ float max3f(float a,float b,float c){float r;asm("v_max3_f32 %0, %1, %2, %3":"=v"(r):"v"(a),"v"(b),"v"(c));return r;}
__device__ __forceinline__ float max2f(float a,float b){float r;asm("v_max_f32_e32 %0, %1, %2":"=v"(r):"v"(a),"v"(b));return r;}
__device__ __forceinline__ float fadd_s(float a,float b){float r;asm("v_add_f32_e32 %0, %1, %2":"=v"(r):"v"(a),"v"(b));return r;}
__device__ __forceinline__ float fsub_s(float a,float b){float r;asm("v_sub_f32_e32 %0, %1, %2":"=v"(r):"v"(a),"v"(b));return r;}
typedef float f32x2_t __attribute__((ext_vector_type(2))); typedef __bf16 bf16x2_t __attribute__((ext_vector_type(2)));
__device__ __forceinline__ unsigned cvtpk_s(float lo,float hi){f32x2_t v={lo,hi};bf16x2_t b=__builtin_convertvector(v,bf16x2_t);return __builtin_bit_cast(unsigned,b);}
#define WAIT_BAR(N) asm volatile("s_waitcnt vmcnt(" #N ") lgkmcnt(0)\n\ts_barrier":::"memory")

__device__ __forceinline__ void qkt(f32x16&p0,f32x16&p1,const char*Kslot,const bf16x8*qr,const f32x16&negm,int r32,int hi){
  const char*kb=Kslot+hi*1024+r32*16;
  #pragma unroll
  for(int d0=0;d0<4;++d0){
    const bf16x8 b0=*reinterpret_cast<const bf16x8*>(kb+d0*2048);
    const bf16x8 b1=*reinterpret_cast<const bf16x8*>(kb+d0*2048+512);
    if(d0==0){p0=__builtin_amdgcn_mfma_f32_32x32x16_bf16(b0,qr[0],negm,0,0,0);p1=__builtin_amdgcn_mfma_f32_32x32x16_bf16(b1,qr[0],negm,0,0,0);}
    else{p0=__builtin_amdgcn_mfma_f32_32x32x16_bf16(b0,qr[d0],p0,0,0,0);p1=__builtin_amdgcn_mfma_f32_32x32x16_bf16(b1,qr[d0],p1,0,0,0);}}
}
typedef __attribute__((address_space(3))) const char* lds_cptr;
typedef short v4i16_t __attribute__((ext_vector_type(4)));
__device__ __forceinline__ void kload8(bf16x8*kf,lds_cptr kp){
  kf[0]=*(const __attribute__((address_space(3))) bf16x8*)(kp);      kf[1]=*(const __attribute__((address_space(3))) bf16x8*)(kp+512);
  kf[2]=*(const __attribute__((address_space(3))) bf16x8*)(kp+2048); kf[3]=*(const __attribute__((address_space(3))) bf16x8*)(kp+2560);
  kf[4]=*(const __attribute__((address_space(3))) bf16x8*)(kp+4096); kf[5]=*(const __attribute__((address_space(3))) bf16x8*)(kp+4608);
  kf[6]=*(const __attribute__((address_space(3))) bf16x8*)(kp+6144); kf[7]=*(const __attribute__((address_space(3))) bf16x8*)(kp+6656);
}
__device__ __forceinline__ void kload2(bf16x8*kf,lds_cptr kp,int j){ kf[2*j]=*(const __attribute__((address_space(3))) bf16x8*)(kp+j*2048); kf[2*j+1]=*(const __attribute__((address_space(3))) bf16x8*)(kp+j*2048+512); }
__device__ __forceinline__ s16x4 vtr(lds_cptr p){ return __builtin_bit_cast(s16x4,__builtin_amdgcn_ds_read_tr16_b64_v4i16((__attribute__((address_space(3))) v4i16_t*)p)); }
__device__ __forceinline__ float rowmax(const f32x16&p0,const f32x16&p1){
  float a=max3f(p0[0],p0[1],p1[0]),b=max3f(p0[2],p0[3],p1[1]);a=max3f(a,p1[2],p1[3]);
  #pragma unroll
  for(int r=4;r<16;r+=4){a=max3f(a,p0[r],p0[r+1]);b=max3f(b,p0[r+2],p0[r+3]);a=max3f(a,p1[r],p1[r+1]);b=max3f(b,p1[r+2],p1[r+3]);}
  const float m=max2f(a,b);
  auto rr=__builtin_amdgcn_permlane32_swap(__float_as_uint(m),__float_as_uint(m),false,false);
  return max2f(__uint_as_float(rr[0]),__uint_as_float(rr[1]));
}
__device__ __forceinline__ void pv(f32x16*o,int vb,bf16x8 pa0,bf16x8 pa1,bf16x8 pa2,bf16x8 pa3){
  #pragma unroll
  for(int d0=0;d0<2;++d0){s16x4 lo[4],hi[4];
    #pragma unroll
    for(int ks=0;ks<4;++ks){
      asm volatile("ds_read_b64_tr_b16 %0,%1 offset:%c2":"=&v"(lo[ks]):"v"(vb),"i"(d0*4096+ks*1024):"memory");
      asm volatile("ds_read_b64_tr_b16 %0,%1 offset:%c2":"=&v"(hi[ks]):"v"(vb),"i"(d0*4096+ks*1024+512):"memory");}
    asm volatile("s_waitcnt lgkmcnt(0)":::"memory");SBAR();
    #define PK(k) (bf16x8){lo[k][0],lo[k][1],lo[k][2],lo[k][3],hi[k][0],hi[k][1],hi[k][2],hi[k][3]}
    o[d0]=__builtin_amdgcn_mfma_f32_32x32x16_bf16(pa0,PK(0),o[d0],0,0,0);
    o[d0]=__builtin_amdgcn_mfma_f32_32x32x16_bf16(pa1,PK(1),o[d0],0,0,0);
    o[d0]=__builtin_amdgcn_mfma_f32_32x32x16_bf16(pa2,PK(2),o[d0],0,0,0);
    o[d0]=__builtin_amdgcn_mfma_f32_32x32x16_bf16(pa3,PK(3),o[d0],0,0,0);
    #undef PK
  }
}

#ifndef ATTN_STORE16
#define ATTN_STORE16(p,v) (*(u32x4*)(p)=(v))
#endif
template<int THRL> __device__ __forceinline__ void attn_unit(int b,int h,int qb,const bf16*Q,const bf16*__restrict__ K,const bf16*__restrict__ V,bf16*O,const float*__restrict__ cum,char*shm){
  int tid_l=threadIdx.x; asm volatile("":"+v"(tid_l)); const int tid=tid_l,lane=tid&63,r32=lane&31,hi=lane>>5; const int wid=__builtin_amdgcn_readfirstlane(tid>>6);
  const long rowbase=(long)b*SEQ; const int q0=qb*QB;
  const bf16*Qw=Q+(rowbase+q0+wid*QBLK)*DM+h*D;
  const bf16*Kh=K+rowbase*DM+h*D,*Vh=V+rowbase*DM+h*D;
  bf16x8 qr[4];
  _Pragma("unroll") for(int d0=0;d0<4;++d0)qr[d0]=*reinterpret_cast<const bf16x8*>(&Qw[(long)r32*DM+d0*16+hi*8]);
  typedef float f32x4c __attribute__((ext_vector_type(4)));
  __attribute__((address_space(3))) float* cks=(__attribute__((address_space(3))) float*)((__attribute__((address_space(3))) char*)shm+LDS_CUM);
  { const int nld=q0+QB, base=tid*8; f32x4c a=(f32x4c){0.f,0.f,0.f,0.f}, b4=a; if(base<nld){ a=*(const f32x4c*)(cum+base); b4=*(const f32x4c*)(cum+base+4); }
    a[1]+=a[0]; a[2]+=a[1]; a[3]+=a[2]; b4[0]+=a[3]; b4[1]+=b4[0]; b4[2]+=b4[1]; b4[3]+=b4[2];
    float inc=b4[3];
    _Pragma("unroll") for(int o_=1;o_<64;o_<<=1){ const float t_=__uint_as_float((unsigned)__builtin_amdgcn_ds_bpermute(((lane-o_)&63)*4,(int)__float_as_uint(inc))); if(lane>=o_)inc+=t_; }
    __attribute__((address_space(3))) float* wsum=(__attribute__((address_space(3))) float*)((__attribute__((address_space(3))) char*)shm+LDS_WS);
    if(lane==63)wsum[wid]=inc;
    { float ssq=0.f; _Pragma("unroll") for(int d0=0;d0<4;++d0) _Pragma("unroll") for(int e_=0;e_<8;++e_){ const float v_=__uint_as_float(((unsigned)(unsigned short)qr[d0][e_])<<16); ssq+=v_*v_; }
      { auto rr=__builtin_amdgcn_permlane32_swap(__float_as_uint(ssq),__float_as_uint(ssq),false,false); ssq=__uint_as_float(rr[0])+__uint_as_float(rr[1]); }
      #define SWMAX_(v,x) v=__builtin_fmaxf(v,__uint_as_float((unsigned)__builtin_amdgcn_ds_swizzle((int)__float_as_uint(v),((x)<<10)|0x1f)))
      SWMAX_(ssq,1); SWMAX_(ssq,2); SWMAX_(ssq,4); SWMAX_(ssq,8); SWMAX_(ssq,16);
      if(lane==0)wsum[8+wid]=ssq; }
    asm volatile("s_waitcnt lgkmcnt(0)\n\ts_barrier":::"memory");
    float off_=inc-b4[3]; _Pragma("unroll") for(int w_=0;w_<NW;++w_){ const float t_=wsum[w_]; if(w_<wid)off_+=t_; }
    if(base<nld){ const float L2E=1.4426950408889634f; *(__attribute__((address_space(3))) f32x4c*)(cks+base)=(a+off_)*L2E; *(__attribute__((address_space(3))) f32x4c*)(cks+base+4)=(b4+off_)*L2E; }
    asm volatile("s_waitcnt lgkmcnt(0)\n\ts_barrier":::"memory"); }
  int tstart=0;
  { const __attribute__((address_space(3))) float* wq=(const __attribute__((address_space(3))) float*)((__attribute__((address_space(3))) char*)shm+LDS_WS)+8;
    const __attribute__((address_space(3))) float* KN=(const __attribute__((address_space(3))) float*)((__attribute__((address_space(3))) char*)shm+LDS_KN);
    float qm=wq[0]; _Pragma("unroll") for(int w_=1;w_<NW;++w_)qm=__builtin_fmaxf(qm,wq[w_]);
    const int NT0=(q0+QB)/KVBLK, nb=NT0-4; const float kb=__builtin_fmaxf(__builtin_fmaxf(KN[NT0-4],KN[NT0-3]),__builtin_fmaxf(KN[NT0-2],KN[NT0-1]));
    const float floor_=-__builtin_sqrtf(qm*kb)-44.f, cq0=cks[q0]; bool skip=false;
    if(lane<nb){ const float ub=__builtin_sqrtf(qm*KN[lane])+cq0-cks[64*lane+63]; skip=ub<floor_; }
    const unsigned long long m_=__ballot(skip); int pre=(int)__builtin_ctzll(~m_); pre=pre<nb?pre:nb; tstart=__builtin_amdgcn_readfirstlane(pre&~1); }
  Kh+=(long)tstart*KVBLK*DM; Vh+=(long)tstart*KVBLK*DM;
  const __attribute__((address_space(3))) float* ckt=cks+tstart*KVBLK;
  #define CKSUB(P0,P1,t) do{ const __attribute__((address_space(3))) float* ckp_=ckt+(t)*64+4*hi; \
    _Pragma("unroll") for(int rr_=0;rr_<4;++rr_){ const f32x4c a_=*(const __attribute__((address_space(3))) f32x4c*)(ckp_+8*rr_); const f32x4c b_=*(const __attribute__((address_space(3))) f32x4c*)(ckp_+32+8*rr_); \
      _Pragma("unroll") for(int e_=0;e_<4;++e_){ P0[4*rr_+e_]-=a_[e_]; P1[4*rr_+e_]-=b_[e_]; } if(rr_==1)__builtin_amdgcn_sched_barrier(0); } }while(0)
  const unsigned lds0=(unsigned)(uintptr_t)shm;
  float*wsf=(float*)(shm+LDS_WS)+wid*64;
  const bf16*ksrc=Kh+(long)lane*DM+wid*8;
  const bf16*vsrc=Vh+(long)(16*(wid&3)+(lane>>2))*DM+(wid>>2)*32+(lane&3)*8;
  const unsigned kdst=lds0+LDS_K+wid*1024, vdst=lds0+LDS_V+wid*1024;
  #define DMA_K(t,slot) glds16(ksrc+(long)(t)*KVBLK*DM,(unsigned)__builtin_amdgcn_readfirstlane(kdst+(slot)))
  #define DMA_V(t,slot) glds16(vsrc+(long)(t)*KVBLK*DM,(unsigned)__builtin_amdgcn_readfirstlane(vdst+(slot)))
  const int vb0=(int)(lds0+LDS_V)+((lane>>4)&1)*32+(lane&3)*8+(4*hi+((lane&15)>>2))*64;
  const char*Kbase=shm+LDS_K; bf16x8 kf[8];
  const lds_cptr shm3=(lds_cptr)shm; const lds_cptr kp0=shm3+LDS_K+hi*1024+r32*16; const lds_cptr vp0=shm3+LDS_V+((lane>>4)&1)*32+(lane&3)*8+(4*hi+((lane&15)>>2))*64;
  const int NT=(q0+QB)/KVBLK-tstart;
  DMA_K(0,0);DMA_V(0,0);DMA_K(1,SLOTB);
  float mhat=-cks[q0+wid*QBLK+r32],l_reg=0.f;f32x16 o[2];o[0]=f32x16{};o[1]=f32x16{};f32x16 negm; _Pragma("unroll") for(int r=0;r<16;++r)negm[r]=-mhat; asm volatile("":"+v"(negm));
  const int qrel=wid*QBLK+r32;
  #define CMASK(P0,P1,t) do{int jb_=(t)-(NT-4); if(jb_>=0)cmask(P0,P1,jb_,qrel,hi);}while(0)
  bool resc=false;
  #define START(P0,P1) do{ const float rm=rowmax(P0,P1); resc=false; \
    { const float dl=rm; mhat=fadd_s(mhat,dl); \
      _Pragma("unroll") for(int r=0;r<16;++r){P0[r]=fsub_s(P0[r],dl);P1[r]=fsub_s(P1[r],dl);} \
      _Pragma("unroll") for(int r=0;r<16;++r)negm[r]=-mhat; asm volatile("":"+v"(negm)); } \
    _Pragma("unroll") for(int r=0;r<16;++r)P0[r]=__builtin_amdgcn_exp2f(P0[r]); }while(0)
  #define RESC() do{ if(resc){ asm volatile("s_waitcnt lgkmcnt(0)":::"memory"); \
      _Pragma("unroll") for(int d_=0;d_<2;++d_) _Pragma("unroll") for(int r=0;r<16;++r)o[d_][r]*=wsf[crow(r,hi)]; } }while(0)
  f32x16 pA0,pA1,pB0,pB1;
  int sl_prev=0,sl_cur=0,sl_next=SLOTB;
  #define ROT() do{sl_prev=sl_cur;sl_cur=sl_next;sl_next=(sl_next==(NSLOT-1)*SLOTB)?0:sl_next+SLOTB;}while(0)
  DMA_K(2,2*SLOTB);
  WAIT_BAR(3);
  qkt(pA0,pA1,Kbase,qr,negm,r32,hi);asm volatile("s_nop 15\n\ts_nop 7":"+v"(pA0),"+v"(pA1));CKSUB(pA0,pA1,0);CMASK(pA0,pA1,0);
  START(pA0,pA1);
  _Pragma("unroll") for(int r=0;r<16;++r)pA1[r]=__builtin_amdgcn_exp2f(pA1[r]);
  WAIT_BAR(0);
  DMA_K(3,0);DMA_V(1,SLOTB);
  ROT();
  kload8(kf,kp0+sl_cur);
  WAIT_BAR(2);
  s16x4 vlo[8],vhi[8]; u32x4 pw0,pw1,pw2,pw3;
  #define PKW(P,B) cvtpk_s(P[B],P[B+1])
  #define PAF(k) __builtin_bit_cast(bf16x8,pw##k)
  #define VFR(i) (bf16x8){vlo[i][0],vlo[i][1],vlo[i][2],vlo[i][3],vhi[i][0],vhi[i][1],vhi[i][2],vhi[i][3]}
  #define PIN(x) asm volatile("":"+v"(x))
  #define MX3(a,b,c) __builtin_fmaxf(__builtin_fmaxf((a),(b)),(c))
  #define GAPA(MF,A0,A1,A2,A3,W0,W1,PW) do{ MF; sacc+=A0; sacc+=A1; sacc+=A2; sacc+=A3; PIN(sacc); W0; W1; PIN(PW); SBAR(); }while(0)
  #define EX(v) __builtin_amdgcn_exp2f(v)
  #define GAPB(MF,X,B) do{ MF; X[B]=EX(X[B]); X[B+1]=EX(X[B+1]); X[B+2]=EX(X[B+2]); X[B+3]=EX(X[B+3]); PIN(X); SBAR(); }while(0)
  #define VRD(i) do{ vlo[i]=vtr(vp_+(((i)>>2)*4096+((i)&3)*1024)); vhi[i]=vtr(vp_+(((i)>>2)*4096+((i)&3)*1024+512)); }while(0)
  #define KRD(G,j) do{ if(G){ kload2(kf,kp0+sl_next,j); SBAR(); } }while(0)
  #define STEP(C0,C1,P0,P1,t,GK,GV,GL) do{ SBAR(); \
    const lds_cptr vp_=vp0+sl_prev; \
    VRD(0); SBAR(); float sacc=(P0[0]+P0[1]); \
    GAPA(C0=__builtin_amdgcn_mfma_f32_32x32x16_bf16(kf[0],qr[0],negm,0,0,0), P0[2],P0[3],P0[4],P0[5],     pw0[0]=PKW(P0,0), pw0[1]=PKW(P0,2), pw0); \
    VRD(4); SBAR(); GAPA(C1=__builtin_amdgcn_mfma_f32_32x32x16_bf16(kf[1],qr[0],negm,0,0,0), P0[6],P0[7],P0[8],P0[9],     pw0[2]=PKW(P0,4), pw0[3]=PKW(P0,6), pw0); \
    VRD(1); SBAR(); GAPA(C0=__builtin_amdgcn_mfma_f32_32x32x16_bf16(kf[2],qr[1],C0,0,0,0),   P0[10],P0[11],P0[12],P0[13], pw1[0]=PKW(P0,8), pw1[1]=PKW(P0,10), pw1); \
    VRD(5); SBAR(); GAPA(C1=__builtin_amdgcn_mfma_f32_32x32x16_bf16(kf[3],qr[1],C1,0,0,0),   P0[14],P0[15],P1[0],P1[1],   pw1[2]=PKW(P0,12),pw1[3]=PKW(P0,14), pw1); \
    VRD(2); SBAR(); GAPA(C0=__builtin_amdgcn_mfma_f32_32x32x16_bf16(kf[4],qr[2],C0,0,0,0),   P1[2],P1[3],P1[4],P1[5],     pw2[0]=PKW(P1,0), pw2[1]=PKW(P1,2), pw2); \
    VRD(6); SBAR(); GAPA(C1=__builtin_amdgcn_mfma_f32_32x32x16_bf16(kf[5],qr[2],C1,0,0,0),   P1[6],P1[7],P1[8],P1[9],     pw2[2]=PKW(P1,4), pw2[3]=PKW(P1,6), pw2); \
    VRD(3); SBAR(); GAPA(C0=__builtin_amdgcn_mfma_f32_32x32x16_bf16(kf[6],qr[3],C0,0,0,0),   P1[10],P1[11],P1[12],P1[13], pw3[0]=PKW(P1,8), pw3[1]=PKW(P1,10), pw3); \
    VRD(7); SBAR(); GAPA(C1=__builtin_amdgcn_mfma_f32_32x32x16_bf16(kf[7],qr[3],C1,0,0,0),   P1[14],P1[15],0.f,0.f,       pw3[2]=PKW(P1,12),pw3[3]=PKW(P1,14), pw3); \
    l_reg+=sacc; \
    if(GK){DMA_K((t)+3,sl_cur);} if(GV){DMA_V((t)+1,sl_next);} \
    CKSUB(C0,C1,t); CMASK(C0,C1,t); \
    { float a=MX3(C0[0],C0[1],C1[0]),b=MX3(C0[2],C0[3],C1[1]); a=MX3(a,C1[2],C1[3]); \
      _Pragma("unroll") for(int r=4;r<16;r+=4){a=MX3(a,C0[r],C0[r+1]);b=MX3(b,C0[r+2],C0[r+3]);a=MX3(a,C1[r],C1[r+1]);b=MX3(b,C1[r+2],C1[r+3]);} \
      float rm=__builtin_fmaxf(a,b); { auto rr=__builtin_amdgcn_permlane32_swap(__float_as_uint(rm),__float_as_uint(rm),false,false); rm=__builtin_fmaxf(__uint_as_float(rr[0]),__uint_as_float(rr[1])); } \
      resc=false; \
      if(__builtin_expect(__any(rm>(float)THRL),0)){ const float dl=__builtin_fmaxf(rm,0.f); mhat+=dl; \
        _Pragma("unroll") for(int r=0;r<16;++r){C0[r]-=dl;C1[r]-=dl;} \
        _Pragma("unroll") for(int r=0;r<16;++r)negm[r]=-mhat; asm volatile("":"+v"(negm)); \
        const float f=__builtin_amdgcn_exp2f(-dl); l_reg*=f; if(hi==0)wsf[r32]=f; resc=true; } } \
    SBAR(); \
    GAPB(o[0]=__builtin_amdgcn_mfma_f32_32x32x16_bf16(PAF(0),VFR(0),o[0],0,0,0), C0,0); \
    GAPB(o[1]=__builtin_amdgcn_mfma_f32_32x32x16_bf16(PAF(0),VFR(4),o[1],0,0,0), C0,4); \
    KRD(GL,0); GAPB(o[0]=__builtin_amdgcn_mfma_f32_32x32x16_bf16(PAF(1),VFR(1),o[0],0,0,0), C0,8); \
    KRD(GL,1); GAPB(o[1]=__builtin_amdgcn_mfma_f32_32x32x16_bf16(PAF(1),VFR(5),o[1],0,0,0), C0,12); \
    KRD(GL,2); GAPB(o[0]=__builtin_amdgcn_mfma_f32_32x32x16_bf16(PAF(2),VFR(2),o[0],0,0,0), C1,0); \
    KRD(GL,3); GAPB(o[1]=__builtin_amdgcn_mfma_f32_32x32x16_bf16(PAF(2),VFR(6),o[1],0,0,0), C1,4); \
    GAPB(o[0]=__builtin_amdgcn_mfma_f32_32x32x16_bf16(PAF(3),VFR(3),o[0],0,0,0), C1,8); \
    GAPB(o[1]=__builtin_amdgcn_mfma_f32_32x32x16_bf16(PAF(3),VFR(7),o[1],0,0,0), C1,12); \
    }while(0)
  int t=1;
  #undef CMASK
  #define CMASK(P0,P1,t) do{}while(0)
  for(;t+5<NT;t+=2){
    STEP(pB0,pB1,pA0,pA1,t,true,true,true);     WAIT_BAR(2); RESC(); ROT();
    STEP(pA0,pA1,pB0,pB1,t+1,true,true,true);   WAIT_BAR(2); RESC(); ROT();
  }
  #undef CMASK
  #define CMASK(P0,P1,t) do{int jb_=(t)-(NT-4); if(jb_>=0)cmask(P0,P1,jb_,qrel,hi);}while(0)
  #define ENDW(tt) do{ if((tt)+3<NT){WAIT_BAR(2);} else if((tt)+2<NT){WAIT_BAR(1);} else {WAIT_BAR(0);} }while(0)
  for(;t+1<NT;t+=2){
    STEP(pB0,pB1,pA0,pA1,t,(t+3<NT),(t+1<NT),(t+1<NT));       ENDW(t);   RESC(); ROT();
    STEP(pA0,pA1,pB0,pB1,t+1,(t+4<NT),(t+2<NT),(t+2<NT));     ENDW(t+1); RESC(); ROT();
  }
  STEP(pB0,pB1,pA0,pA1,NT-1,false,false,false); RESC();
  { float sacc=pB0[0]+pB0[1]; _Pragma("unroll") for(int r=2;r<16;++r)sacc+=pB0[r]; _Pragma("unroll") for(int r=0;r<16;++r)sacc+=pB1[r]; l_reg+=sacc;
    pw0=(u32x4){PKW(pB0,0),PKW(pB0,2),PKW(pB0,4),PKW(pB0,6)};pw1=(u32x4){PKW(pB0,8),PKW(pB0,10),PKW(pB0,12),PKW(pB0,14)};pw2=(u32x4){PKW(pB1,0),PKW(pB1,2),PKW(pB1,4),PKW(pB1,6)};pw3=(u32x4){PKW(pB1,8),PKW(pB1,10),PKW(pB1,12),PKW(pB1,14)};
    SBAR(); pv(o,vb0+sl_cur,PAF(0),PAF(1),PAF(2),PAF(3)); }
  #undef PKW
  #undef PAF
  #undef VFR
  #undef PIN
  #undef MX3
  #undef GAPA
  #undef GAPB
  #undef EX
  #undef VRD
  #undef KRD
  #undef STEP
  #undef ENDW
  {auto rr=__builtin_amdgcn_permlane32_swap(__float_as_uint(l_reg),__float_as_uint(l_reg),false,false);l_reg=__uint_as_float(rr[0])+__uint_as_float(rr[1]);}
  if(hi==0)wsf[32+r32]=l_reg;asm volatile("s_waitcnt lgkmcnt(0)":::"memory");
  float rli[16];
  #pragma unroll
  for(int r=0;r<16;++r)rli[r]=__builtin_amdgcn_rcpf(wsf[32+crow(r,hi)]);
  bf16*Ow=O+(rowbase+q0+wid*QBLK)*ODM+h*D;
  { bf16*stg=(bf16*)(shm+LDS_OST)+wid*2048;
    #pragma unroll
    for(int r=0;r<16;++r){const int orow=crow(r,hi);
      #pragma unroll
      for(int d0=0;d0<2;++d0)stg[orow*64+d0*32+r32]=__float2bfloat16(o[d0][r]*rli[r]);}
    asm volatile("s_waitcnt lgkmcnt(0)":::"memory");
    #pragma unroll
    for(int i=0;i<4;++i){const int row=i*8+(lane>>3),ch=lane&7; const u32x4 v=*(const u32x4*)(stg+row*64+ch*8); ATTN_STORE16(Ow+(long)row*ODM+ch*8,v);} }
  asm volatile("s_waitcnt lgkmcnt(0)\n\ts_barrier":::"memory");
  #undef CKSUB
  #undef DMA_K
  #undef DMA_V
  #undef CMASK
  #undef START
  #undef RESC
  #undef ROT
}
constexpr int ATTN_LDS_BYTES=LDS_BYTES;
struct AttnTensors { const bf16* Q; const bf16* K; const bf16* V; bf16* O; const float* CUM; };
struct AttnUnit { int bh; int qb; };
struct StaticOrder {
  int vcu;
  __device__ __forceinline__ explicit StaticOrder(int grid,int block):vcu((block%8)*(grid/8)+block/8){}
  __device__ __forceinline__ bool next(int i,AttnUnit&u)const{ if(i>=8)return false; const int s=vcu&1; u.bh=vcu>>1; const int j=7-i; u.qb=4*(j>>1)+(s==0?((j&1)?3:0):((j&1)?2:1)); return true; }
  __device__ __forceinline__ void a_ready(const AttnUnit&)const{}
  __device__ __forceinline__ void done(const AttnUnit&)const{}
};
__device__ __forceinline__ void kn_table(const bf16*K,int bh,char*shm){
  int tid_l=threadIdx.x; asm volatile("":"+v"(tid_l)); const int tid=tid_l,lane=tid&63; const bf16*kp=K+((long)(bh/NHEAD)*SEQ+8*tid)*DM+(bh%NHEAD)*D; float mx=0.f;
  _Pragma("unroll 2") for(int r=0;r<8;++r){ float ssq=0.f;
    _Pragma("unroll") for(int c=0;c<8;++c){ const u32x4 w=*reinterpret_cast<const u32x4*>(kp+(long)r*DM+c*8);
      _Pragma("unroll") for(int e_=0;e_<4;++e_){ const float lo_=__uint_as_float(w[e_]<<16), hi_=__uint_as_float(w[e_]&0xffff0000u); ssq+=lo_*lo_+hi_*hi_; } }
    mx=__builtin_fmaxf(mx,ssq); }
  #define SWMAXK_(v,x) v=__builtin_fmaxf(v,__uint_as_float((unsigned)__builtin_amdgcn_ds_swizzle((int)__float_as_uint(v),((x)<<10)|0x1f)))
  SWMAXK_(mx,1); SWMAXK_(mx,2); SWMAXK_(mx,4);
  if((lane&7)==0) ((__attribute__((address_space(3))) float*)((__attribute__((address_space(3))) char*)shm+LDS_KN))[tid>>3]=mx;
  asm volatile("s_waitcnt lgkmcnt(0)\n\ts_barrier":::"memory");
}
template<class Sched,int THRL=8> __device__ __forceinline__ void attn_phase(char*lds,const AttnTensors&T,const Sched&S){
  AttnUnit u;
  if(S.next(0,u)) kn_table(T.K,u.bh,lds);
  for(int i=0;S.next(i,u);++i){ S.a_ready(u); attn_unit<THRL>(u.bh/NHEAD,u.bh%NHEAD,u.qb,T.Q,T.K,T.V,T.O,T.CUM+(size_t)u.bh*SEQ,lds); S.done(u); }
}
#undef SBAR
#undef WAIT_BAR
}
#include <hip/hip_cooperative_groups.h>
namespace cg = cooperative_groups;
#define LAS __attribute__((address_space(3)))
typedef unsigned short bf16;
typedef unsigned v4u __attribute__((ext_vector_type(4)));
typedef unsigned v2u __attribute__((ext_vector_type(2)));
typedef float f32x4 __attribute__((ext_vector_type(4)));
typedef float f32x16 __attribute__((ext_vector_type(16)));
typedef short bf16x8 __attribute__((ext_vector_type(8)));
typedef short s16x4 __attribute__((ext_vector_type(4)));

constexpr int NWAVES = 8;
#ifndef PROBE_DOUBLE
#define PROBE_DOUBLE 0
#endif
constexpr int BATCH = 16, SEQ = 4096, DM = 1024, M = BATCH * SEQ, FF = 4096, DEPTH = 4;
constexpr int EVEN_IN = 3080, EVEN_N = 3072, ODD_IN = 6144;
constexpr float RMS_EPS = 1e-6f, GN_EPS = 1e-6f, LOG2E = 1.4426950408889634f;
constexpr size_t MiB = 1u << 20;
constexpr size_t WS_EIN = 1 * MiB, WS_EOUT = WS_EIN + 12 * MiB, WS_OIN = WS_EOUT + 4 * MiB, WS_OOUT = WS_OIN + 24 * MiB, WS_F1 = WS_OOUT + 8 * MiB, WS_F2 = WS_F1 + 32 * MiB;
constexpr size_t WS_LOGF = WS_F2 + 32 * MiB, WS_CUM = WS_LOGF + 2 * MiB, WS_LSE = WS_CUM + 2 * MiB, WS_XN = 124 * MiB, WS_ACT = 252 * MiB, WS_END = 1024 * MiB;
static_assert(WS_LSE + 6 * MiB <= WS_XN, "ws map");
constexpr size_t SEG = 64 * MiB, WS_OG = WS_ACT + 6 * SEG, WS_AO = WS_OG + 3 * SEG;
static_assert(WS_AO + 128 * MiB <= WS_END, "ws map even");
constexpr size_t WS_RQ = WS_ACT, WS_RK = WS_RQ + 128 * MiB, WS_RV = WS_RK + 128 * MiB, WS_RG = WS_RV + 256 * MiB;
static_assert(WS_RG + 256 * MiB <= WS_END, "ws map odd");
constexpr size_t WS_H = WS_ACT;
constexpr int LDS_BYTES = 147456;

__device__ __forceinline__ unsigned f2bf(float f) { unsigned u = __builtin_bit_cast(unsigned, f); return (u + 0x7fffu + ((u >> 16) & 1u)) >> 16; }
__device__ __forceinline__ unsigned pk2(float lo, float hi) { return attn_body::cvtpk_s(lo, hi); }
__device__ __forceinline__ unsigned pkh2(float lo, float hi) { return pg8::st_pk(lo, hi); }
__device__ __forceinline__ float bf2f(unsigned short b) { return __builtin_bit_cast(float, (unsigned)b << 16); }
__device__ __forceinline__ float xor32f(float v) { auto rr = __builtin_amdgcn_permlane32_swap(__float_as_uint(v), __float_as_uint(v), false, false); return __uint_as_float((threadIdx.x & 32) ? rr[0] : rr[1]); }
#define SWZ(v, x) __uint_as_float((unsigned)__builtin_amdgcn_ds_swizzle((int)__float_as_uint(v), ((x) << 10) | 0x1f))
__device__ __forceinline__ float wave_sum(float v) {
    v += SWZ(v, 1); v += SWZ(v, 2); v += SWZ(v, 4); v += SWZ(v, 8); v += SWZ(v, 16);
    auto rr = __builtin_amdgcn_permlane32_swap(__float_as_uint(v), __float_as_uint(v), false, false);
    return __uint_as_float(rr[0]) + __uint_as_float(rr[1]);
}
__device__ __forceinline__ int crow(int r, int hi) { return (r & 3) + 8 * (r >> 2) + 4 * hi; }
__device__ __forceinline__ s16x4 trrd(const LAS unsigned char* p) { typedef short v4i16_t __attribute__((ext_vector_type(4))); return __builtin_bit_cast(s16x4, __builtin_amdgcn_ds_read_tr16_b64_v4i16((LAS v4i16_t*)p)); }
#define CAT8(lo, hi) (bf16x8){lo[0], lo[1], lo[2], lo[3], hi[0], hi[1], hi[2], hi[3]}
#define LBAR() asm volatile("s_waitcnt lgkmcnt(0)\n\ts_barrier" ::: "memory")
#define MFMA32(a, b, c) __builtin_amdgcn_mfma_f32_32x32x16_bf16((a), (b), (c), 0, 0, 0)

__device__ __forceinline__ void p0_transpose_item(const float* W, int K, int N, int ldw, bf16* WT, LAS float* scr, int item, int lane, const float* gk = nullptr, bool f16 = false) {
    const int nblk = N / 32, kb = item / nblk, nb = item % nblk, k0 = 64 * kb, n0 = 32 * nb;
#pragma unroll 8
    for (int i = 0; i < 32; ++i) { const int kk = 2 * i + (lane >> 5); scr[kk * 33 + (lane & 31)] = W[(size_t)(k0 + kk) * ldw + n0 + (lane & 31)] * (gk ? gk[k0 + kk] : 1.0f); }
    asm volatile("s_waitcnt lgkmcnt(0)" ::: "memory");
    const int c = lane & 7;
#pragma unroll
    for (int j = 0; j < 4; ++j) { const int n = (lane >> 3) + 8 * j; const LAS float* s = scr + (8 * c) * 33 + n;
        v4u o; if (f16) { o.x = pkh2(s[0 * 33], s[1 * 33]); o.y = pkh2(s[2 * 33], s[3 * 33]); o.z = pkh2(s[4 * 33], s[5 * 33]); o.w = pkh2(s[6 * 33], s[7 * 33]); }
        else { o.x = pk2(s[0 * 33], s[1 * 33]); o.y = pk2(s[2 * 33], s[3 * 33]); o.z = pk2(s[4 * 33], s[5 * 33]); o.w = pk2(s[6 * 33], s[7 * 33]); }
        *(v4u*)(WT + (size_t)(n0 + n) * K + k0 + 8 * c) = o; }
    asm volatile("s_waitcnt lgkmcnt(0)" ::: "memory");
}
struct Ins { const float *x, *gmix, *gffn, *ewin, *ebf, *ewout, *owin, *owout, *f1, *f2, *gfin; };
__device__ __forceinline__ void p0_prologue(const Ins& in, unsigned char* ws, LAS unsigned char* lds, int gw, int NGW, int wave, int lane) {
    LAS float* scr = (LAS float*)(lds + wave * 16384);
    constexpr int I_EIN = 16 * 96, I_EOUT = 16 * 32, I_OIN = 16 * 192, I_OOUT = 32 * 32, I_F1 = 16 * 128, I_F2 = 64 * 32;
    constexpr int NITEMS = 2 * (I_EIN + I_EOUT + I_OIN + I_OOUT) + 4 * (I_F1 + I_F2);
    for (int it = gw; it < NITEMS; it += NGW) {
        int r = it;
        if (r < 2 * I_EIN) { const int i = r / I_EIN; p0_transpose_item(in.ewin + (size_t)i * DM * EVEN_IN, DM, EVEN_N, EVEN_IN, (bf16*)(ws + WS_EIN) + (size_t)i * EVEN_N * DM, scr, r % I_EIN, lane, in.gmix + (2 * i) * DM, STREAM_F16 != 0); continue; } r -= 2 * I_EIN;
        if (r < 2 * I_EOUT) { const int i = r / I_EOUT; p0_transpose_item(in.ewout + (size_t)i * DM * DM, DM, DM, DM, (bf16*)(ws + WS_EOUT) + (size_t)i * DM * DM, scr, r % I_EOUT, lane); continue; } r -= 2 * I_EOUT;
        if (r < 2 * I_OIN) { const int i = r / I_OIN; p0_transpose_item(in.owin + (size_t)i * DM * ODD_IN, DM, ODD_IN, ODD_IN, (bf16*)(ws + WS_OIN) + (size_t)i * ODD_IN * DM, scr, r % I_OIN, lane, in.gmix + (2 * i + 1) * DM, STREAM_F16 != 0); continue; } r -= 2 * I_OIN;
        if (r < 2 * I_OOUT) { const int i = r / I_OOUT; p0_transpose_item(in.owout + (size_t)i * 2 * DM * DM, 2 * DM, DM, DM, (bf16*)(ws + WS_OOUT) + (size_t)i * 2 * DM * DM, scr, r % I_OOUT, lane); continue; } r -= 2 * I_OOUT;
        if (r < 4 * I_F1) { const int i = r / I_F1; p0_transpose_item(in.f1 + (size_t)i * DM * FF, DM, FF, FF, (bf16*)(ws + WS_F1) + (size_t)i * FF * DM, scr, r % I_F1, lane, in.gffn + i * DM, STREAM_F16 != 0); continue; } r -= 4 * I_F1;
        { const int i = r / I_F2; p0_transpose_item(in.f2 + (size_t)i * FF * DM, FF, DM, DM, (bf16*)(ws + WS_F2) + (size_t)i * FF * DM, scr, r % I_F2, lane); }
    }
}

template <bool FIRST> __device__ __forceinline__ void gate_pass(const float* x, bf16* XB, float* SS, const float* g, const float* Wf  , const float* bfp, float* LOGF,
                                                               LAS unsigned char* lds, int gw, int NGW, int tid, int lane) {
    LAS float* wt = (LAS float*)lds;
    for (int idx = tid; idx < 8192; idx += NWAVES * 64) { const int k = idx >> 3, j = idx & 7; wt[j * 1024 + k] = Wf[(size_t)k * EVEN_IN + j] * g[k]; }
    __syncthreads();
    for (int m = gw; m < M; m += NGW) {
        f32x4 v[4]; float rstd;
        if (FIRST) { const f32x4* xr = (const f32x4*)(x + (size_t)m * DM) + lane; float s = 0.f;
#pragma unroll
            for (int j = 0; j < 4; ++j) { v[j] = xr[64 * j]; s += (v[j].x * v[j].x + v[j].y * v[j].y) + (v[j].z * v[j].z + v[j].w * v[j].w); }
            s = wave_sum(s); rstd = __builtin_amdgcn_rsqf(s * (1.f / DM) + RMS_EPS); if (lane < 16) SS[(size_t)m * 16 + lane] = (lane == 0) ? s : 0.f;
            v2u* o8 = (v2u*)(XB + (size_t)m * DM) + lane;
#pragma unroll
            for (int j = 0; j < 4; ++j) { v2u w; w.x = pkh2(v[j].x, v[j].y); w.y = pkh2(v[j].z, v[j].w); o8[64 * j] = w; }
        } else { const v2u* xr = (const v2u*)(XB + (size_t)m * DM) + lane;
#pragma unroll
            for (int j = 0; j < 4; ++j) { const v2u w = xr[64 * j]; v[j].x = pg8::st_lo(w.x); v[j].y = pg8::st_hi(w.x); v[j].z = pg8::st_lo(w.y); v[j].w = pg8::st_hi(w.y); }
            rstd = __builtin_amdgcn_rsqf(wave_sum((lane < 16) ? SS[(size_t)m * 16 + lane] : 0.f) * (1.f / DM) + RMS_EPS); }
        float mine = 0.f;
#pragma unroll
        for (int jj = 0; jj < 8; ++jj) { float d = 0.f;
#pragma unroll
            for (int j = 0; j < 4; ++j) { const f32x4 w = *((const LAS f32x4*)(wt + jj * 1024) + lane + 64 * j); d += (v[j].x * w.x + v[j].y * w.y) + (v[j].z * w.z + v[j].w * w.w); }
            d = wave_sum(d); if (lane == jj) mine = d; }
        if (lane < 8) { const float u = mine * rstd + bfp[lane]; LOGF[((size_t)(m >> 12) * 8 + lane) * SEQ + (m & (SEQ - 1))] = fminf(u, 0.f) - __logf(1.0f + __expf(-fabsf(u))); }
    }
    __syncthreads();
}

#define XB_TMO      128
#define XB_XCNT(j)  (256  + 64 * (j))
#define XB_XSUB(j)  (1280 + 64 * (j))
#define XB_XGEN(j)  (2304 + 64 * (j))
#define XB_TOP      3328
#define XB_TOPGEN   3392
#define XCD_BAR_WORDS 3456
#define XB_SPIN_CAP (1u << 18)

__device__ __forceinline__ unsigned xb_ld(unsigned* p)              { return __hip_atomic_load(p, __ATOMIC_RELAXED, __HIP_MEMORY_SCOPE_AGENT); }
__device__ __forceinline__ unsigned xb_add(unsigned* p, unsigned v) { return __hip_atomic_fetch_add(p, v, __ATOMIC_RELAXED, __HIP_MEMORY_SCOPE_AGENT); }
__device__ __forceinline__ unsigned xb_xcc_id() { return (unsigned)__builtin_amdgcn_s_getreg((3 << 11) | 20) & 0xFu; }
#define XB_SPIN(cond, bar) do { unsigned _sp = 0; while (cond) { __builtin_amdgcn_s_sleep(1); \
    if ((++_sp & 255u) == 0u) { if (xb_ld(&(bar)[XB_TMO])) break; if (_sp > XB_SPIN_CAP) { atomicAdd(&(bar)[XB_TMO], 1u); break; } } } } while (0)

struct XcdBarrier {
    unsigned* bar; unsigned x;
    volatile LAS unsigned* st;
};

__device__ __forceinline__ XcdBarrier xcd_barrier_post(unsigned* bar, volatile LAS unsigned* st) {
    XcdBarrier b; b.bar = bar; b.x = xb_xcc_id(); b.st = st;
    if (threadIdx.x == 0) (void)xb_add(&bar[XB_XCNT(b.x)], 1u);
    return b;
}
__device__ __forceinline__ void xcd_barrier_complete(unsigned* bar, unsigned x, unsigned& nloc, unsigned& nx) {
    const unsigned G = gridDim.x * gridDim.y * gridDim.z;
    unsigned sum, cnt, mine, sp = 0u;
    for (;;) {
        sum = 0u; cnt = 0u; mine = 0u;
#pragma unroll
        for (unsigned j = 0; j < 16; ++j) { const unsigned c = xb_ld(&bar[XB_XCNT(j)]); sum += c; cnt += (c > 0u) ? 1u : 0u; mine = (j == x) ? c : mine; }
        if (sum == G) break;
        __builtin_amdgcn_s_sleep(1);
        if ((++sp & 255u) == 0u) { if (xb_ld(&bar[XB_TMO])) break; if (sp > XB_SPIN_CAP) { atomicAdd(&bar[XB_TMO], 1u); break; } }
    }
    nloc = mine > 0u ? mine : 1u; nx = cnt > 0u ? cnt : 1u;
}

__device__ __forceinline__ void xcd_barrier(const XcdBarrier& b) {
    asm volatile("s_waitcnt vmcnt(0)" ::: "memory");
    __syncthreads();
    if (threadIdx.x == 0) {
        unsigned* bar = b.bar;
        __builtin_amdgcn_s_waitcnt(0);
        unsigned nloc = b.st[0], nx = b.st[1];
        unsigned bxx = b.x; asm volatile("" : "+s"(bxx));
        if (nloc == 0u) { xcd_barrier_complete(bar, bxx, nloc, nx); b.st[0] = nloc; b.st[1] = nx; }
        const unsigned old = xb_add(&bar[XB_XSUB(bxx)], 1u);
        const unsigned gen = old / nloc;
        if (old + 1u == (gen + 1u) * nloc) {
            __builtin_amdgcn_fence(__ATOMIC_RELEASE, "agent");
            asm volatile("s_waitcnt vmcnt(0)" ::: "memory");
            const unsigned og = xb_add(&bar[XB_TOP], 1u);
            const unsigned tg = og / nx;
            if (og + 1u == (tg + 1u) * nx) xb_add(&bar[XB_TOPGEN], 1u);
            else XB_SPIN(xb_ld(&bar[XB_TOPGEN]) == tg, bar);
            __builtin_amdgcn_fence(__ATOMIC_ACQUIRE, "agent");
            xb_add(&bar[XB_XGEN(bxx)], 1u);
            asm volatile("s_waitcnt vmcnt(0)" ::: "memory");
        } else {
            XB_SPIN(xb_ld(&bar[XB_XGEN(bxx)]) == gen, bar);
            __builtin_amdgcn_fence(__ATOMIC_ACQUIRE, "agent");
            asm volatile("s_waitcnt vmcnt(0)" ::: "memory");
        }
    }
    __syncthreads();
}

namespace dil {
constexpr int LK = 0, LV = 384 * 128, LSCR = LV + 384 * 144, LTOT = LSCR + NWAVES * 256;
static_assert(LTOT <= 131072, "dil lds");
struct U { int b, h, d, sr, win0; };
__device__ __forceinline__ U decode(int u) {
    U r; const int j = u & 15, g3 = (u >> 4) % 3, bh = u / 48; r.b = bh >> 3; r.h = bh & 7; int np;
    if (g3 == 0) { r.d = 1; r.sr = 0; np = j; } else if (g3 == 1) { r.d = 4; r.sr = j >> 2; np = j & 3; } else { r.d = 16; r.sr = j; np = 0; }
    r.win0 = (2 * np - 1) * 128; return r;
}
__device__ __forceinline__ void issue(const U& w, const bf16* Q, const bf16* K, const bf16* V, int tid, int wave, int lane, v4u (&kreg)[6], v4u (&vreg)[6], bf16x8 (&qr)[4]) {
    const unsigned rowbase = (unsigned)w.b * SEQ; const int r32 = lane & 31, hi = lane >> 5;
#pragma unroll
    for (int i = 0; i < 6; ++i) { const int idx = tid + 512 * i, j = idx >> 3, ch = idx & 7; const int sp = max(w.win0 + j, 0);
        const unsigned go = (rowbase + (unsigned)(sp * w.d + w.sr)) * 512u + w.h * 64 + ch * 8; kreg[i] = *(const v4u*)(K + go); vreg[i] = *(const v4u*)(V + go); }
    const unsigned tokq = rowbase + (unsigned)((w.win0 + 128 + 32 * wave + r32) * w.d + w.sr);
#pragma unroll
    for (int s = 0; s < 4; ++s) qr[s] = *(const bf16x8*)(Q + (tokq * 512u + w.h * 64 + 16 * s + 8 * hi));
}
__device__ __forceinline__ void stage(const U& w, LAS unsigned char* lds, int tid, const v4u (&kreg)[6], const v4u (&vreg)[6]) {
    unsigned zz_ = 0u; asm volatile("" : "+v"(zz_));
#pragma unroll
    for (int i = 0; i < 6; ++i) { const int idx = tid + 512 * i, j = idx >> 3, ch = idx & 7; const bool ok = (w.win0 + j) >= 0;
        v4u kv = kreg[i], vv = vreg[i]; if (!ok) { kv = (v4u){zz_, zz_, zz_, zz_}; vv = kv; }
        *(LAS v4u*)(lds + LK + j * 128 + ((ch ^ ((j >> 1) & 7)) * 16)) = kv;
        *(LAS v4u*)(lds + LV + j * 144 + ch * 16) = vv; }
}
__device__ __forceinline__ void compute(const U& w, int g3, const bf16x8 (&qr)[4], bf16* OG, float* LSE, LAS unsigned char* lds, int wave, int lane) {
    const int d = w.d, h = w.h, win0 = w.win0, sr = w.sr; const size_t rowbase = (size_t)w.b * SEQ; const int r32 = lane & 31, hi = lane >> 5;
    const int qrow = 128 + 32 * wave + r32; const size_t tokq = rowbase + (size_t)((win0 + qrow) * d + sr);
    f32x16 sc[5];
    const float csc = 0.125f * LOG2E, al = __builtin_amdgcn_exp2f(-(float)(h + 1)) * (float)d * LOG2E;
    const int sb = 128 + r32 - 4 * hi; const int stmax = min(128, win0 + qrow);
    const bool full = (win0 + 128 + 32 * wave) >= 128;
    float mx = -INFINITY;
#pragma unroll
    for (int j = 0; j < 5; ++j) { const int row = 32 * (wave + j) + r32; f32x16 a = {};
#pragma unroll
        for (int s = 0; s < 4; ++s) { const bf16x8 kf = *(const LAS bf16x8*)(lds + LK + row * 128 + (((2 * s + hi) ^ ((row >> 1) & 7)) * 16)); a = MFMA32(kf, qr[s], a); }
        int sbj = sb; asm volatile("" : "+v"(sbj) : "v"(a[15]));
        if (j >= 1 && j <= 3 && full) {
#pragma unroll
            for (int r = 0; r < 16; ++r) { const int st = sbj - (32 * j + (r & 3) + 8 * (r >> 2)); const float x = a[r] * csc - al * (float)st; a[r] = x; mx = fmaxf(mx, x); }
        } else {
#pragma unroll
        for (int r = 0; r < 16; ++r) { const int st = sbj - (32 * j + (r & 3) + 8 * (r >> 2));
            const float x = ((unsigned)st <= (unsigned)stmax) ? (a[r] * csc - al * (float)st) : -INFINITY; a[r] = x; mx = fmaxf(mx, x); } }
        sc[j] = a; }
    { auto rr = __builtin_amdgcn_permlane32_swap(__float_as_uint(mx), __float_as_uint(mx), false, false); mx = fmaxf(__uint_as_float(rr[0]), __uint_as_float(rr[1])); }
    float l = 0.f;
#pragma unroll
    for (int j = 0; j < 5; ++j)
#pragma unroll
        for (int r = 0; r < 16; ++r) { const float p = __builtin_amdgcn_exp2f(sc[j][r] - mx); sc[j][r] = p; l += p; }
    { auto rr = __builtin_amdgcn_permlane32_swap(__float_as_uint(l), __float_as_uint(l), false, false); l = __uint_as_float(rr[0]) + __uint_as_float(rr[1]); }
    f32x16 o[2]; o[0] = f32x16{}; o[1] = f32x16{};
    const int blk = (lane >> 4) & 1, q4 = (lane & 15) >> 2, p4 = lane & 3;
#pragma unroll
    for (int j = 0; j < 5; ++j)
#pragma unroll
        for (int s = 0; s < 2; ++s) {
            v4u pw; pw.x = pk2(sc[j][8 * s + 0], sc[j][8 * s + 1]); pw.y = pk2(sc[j][8 * s + 2], sc[j][8 * s + 3]); pw.z = pk2(sc[j][8 * s + 4], sc[j][8 * s + 5]); pw.w = pk2(sc[j][8 * s + 6], sc[j][8 * s + 7]);
            const bf16x8 pa = __builtin_bit_cast(bf16x8, pw);
            const int R0 = 32 * (wave + j) + 16 * s + 4 * hi + q4;
#pragma unroll
            for (int c = 0; c < 2; ++c) { const LAS unsigned char* vp = lds + LV + R0 * 144 + (32 * c + 16 * blk) * 2 + 8 * p4;
                const s16x4 lo = trrd(vp), hh = trrd(vp + 8 * 144); o[c] = MFMA32(pa, CAT8(lo, hh), o[c]); } }
    LAS float* scr = (LAS float*)(lds + LSCR + wave * 256);
    if (hi == 0) scr[r32] = 1.0f / l;
    asm volatile("s_waitcnt lgkmcnt(0)" ::: "memory");
    if (hi == 0) LSE[tokq * 8 + h] = mx + __builtin_amdgcn_logf(l);
#pragma unroll
    for (int r = 0; r < 16; ++r) { const int qq = crow(r, hi); const float inv = scr[qq]; const size_t tok = rowbase + (size_t)((win0 + 128 + 32 * wave + qq) * d + sr);
        bf16* op = OG + tok * 512 + h * 64 + r32; op[0] = (bf16)f2bf(o[0][r] * inv); op[32] = (bf16)f2bf(o[1][r] * inv); }
}
}

namespace ret {
constexpr int C = 64, KR = 528, VR = 288, SR = 528, LK = 0, LV = C * KR, LST = LV + C * VR, LTOT = LST + 128 * SR, NCH = SEQ / C;
static_assert(LTOT <= 131072, "ret lds");
__device__ __forceinline__ void unit(int b, int h, int vs, const bf16* Q, const bf16* K, bf16* V  , LAS unsigned char* lds, int tid_, int wave, int lane_, bf16* Vst, unsigned stmask) {
    const float gam = 1.0f - __builtin_amdgcn_exp2f(-5.0f - (float)h), lg = __builtin_amdgcn_logf(gam);
    const int wr = wave >> 2, wc = wave & 3;
    asm volatile("" : "+v"(tid_));
    { unsigned zz_ = 0u; asm volatile("" : "+v"(zz_)); for (int i = tid_; i < 128 * SR / 16; i += NWAVES * 64) *(LAS v4u*)(lds + LST + i * 16) = (v4u){zz_, zz_, zz_, zz_}; }
    __builtin_amdgcn_sched_barrier(0);
    const size_t rowbase = (size_t)b * SEQ;
    f32x16 S[4];
#pragma unroll
    for (int t = 0; t < 4; ++t) S[t] = f32x16{};
    const float c0 = __builtin_amdgcn_exp2f(-lg * (float)C), gC = __builtin_amdgcn_exp2f(lg * (float)C);
    v4u kreg[4], vreg[2]; bf16x8 qr[16];
    { int tp_ = tid_; asm volatile("" : "+v"(tp_)); const int tid = tp_, r32 = tp_ & 31, hi = (tp_ >> 5) & 1;
    const unsigned kg = ((unsigned)rowbase + (unsigned)(tid >> 5)) * 1024u + h * 256 + (tid & 31) * 8;
    const unsigned vg = ((unsigned)rowbase + (unsigned)(tid >> 4)) * 2048u + h * 512 + vs * 128 + (tid & 15) * 8;
    const unsigned qg = ((unsigned)rowbase + (unsigned)(32 * wr + r32)) * 1024u + h * 256 + 8 * hi;
#pragma unroll
    for (int k = 0; k < 4; ++k) kreg[k] = *(const v4u*)(K + (kg + (unsigned)(16 * k) * 1024u));
#pragma unroll
    for (int k = 0; k < 2; ++k) vreg[k] = *(const v4u*)(V + (vg + (unsigned)(32 * k) * 2048u));
#pragma unroll
    for (int s = 0; s < 16; ++s) qr[s] = *(const bf16x8*)(Q + (qg + 16u * s)); }
    for (int ci = 0; ci < NCH; ++ci) {
        const size_t t0 = rowbase + (size_t)ci * C; const bool more = (ci + 1 < NCH);
        int tl = tid_; asm volatile("" : "+v"(tl));
        const int tid = tl, lane = tl & 63, r32 = lane & 31, hi = lane >> 5, blk = (lane >> 4) & 1, q4 = (lane & 15) >> 2, p4 = lane & 3;
        const unsigned kg = ((unsigned)rowbase + (unsigned)(tid >> 5)) * 1024u + h * 256 + (tid & 31) * 8;
        const unsigned vg = ((unsigned)rowbase + (unsigned)(tid >> 4)) * 2048u + h * 512 + vs * 128 + (tid & 15) * 8;
        const unsigned qg = ((unsigned)rowbase + (unsigned)(32 * wr + r32)) * 1024u + h * 256 + 8 * hi;
#pragma unroll
        for (int k = 0; k < 4; ++k) *(LAS v4u*)(lds + LK + ((tid >> 5) + 16 * k) * KR + (tid & 31) * 16) = kreg[k];
#pragma unroll
        for (int k = 0; k < 2; ++k) { const int t = (tid >> 4) + 32 * k; const v4u raw = vreg[k];
            const float kd = __builtin_amdgcn_exp2f(lg * (float)(C - 1 - t)) * 0.0625f; v4u w;
            w.x = pk2(__builtin_bit_cast(float, raw.x << 16) * kd, __builtin_bit_cast(float, raw.x & 0xffff0000u) * kd);
            w.y = pk2(__builtin_bit_cast(float, raw.y << 16) * kd, __builtin_bit_cast(float, raw.y & 0xffff0000u) * kd);
            w.z = pk2(__builtin_bit_cast(float, raw.z << 16) * kd, __builtin_bit_cast(float, raw.z & 0xffff0000u) * kd);
            w.w = pk2(__builtin_bit_cast(float, raw.w << 16) * kd, __builtin_bit_cast(float, raw.w & 0xffff0000u) * kd);
            *(LAS v4u*)(lds + LV + t * VR + (tid & 15) * 16) = w; }
        LBAR();
        f32x16 acc = f32x16{}, it0 = f32x16{}, it1 = f32x16{};
        const LAS unsigned char* sp = lds + LST + (32 * wc + r32) * SR + 16 * hi;
        const LAS unsigned char* kp = lds + LK + r32 * KR + 16 * hi;
        const unsigned qn = qg + (unsigned)(ci + 1) * C * 1024u;
#pragma unroll
        for (int g = 0; g < 4; ++g) {
#pragma unroll
            for (int s = 0; s < 4; ++s) { const int ks = 4 * g + s; acc = MFMA32(qr[ks], *(const LAS bf16x8*)(sp + 32 * ks), acc);
                it0 = MFMA32(*(const LAS bf16x8*)(kp + 32 * ks), qr[ks], it0); if (wr) it1 = MFMA32(*(const LAS bf16x8*)(kp + 32 * KR + 32 * ks), qr[ks], it1); }
                if (more) {
#pragma unroll
                for (int s = 0; s < 4; ++s) qr[4 * g + s] = *(const bf16x8*)(Q + (qn + 16u * (4 * g + s))); }
        }
#define PVSTEP(IT, J) do { int qv = 32 * wr + r32 - 4 * hi; asm volatile("" : "+v"(qv) : "v"(IT[15])); \
            _Pragma("unroll") for (int r = 0; r < 16; ++r) { IT[r] = ((32 * (J) + (r & 3) + 8 * (r >> 2)) <= qv) ? IT[r] * c0 : 0.f; } \
            _Pragma("unroll") for (int s = 0; s < 2; ++s) { \
                v4u pw; pw.x = pk2(IT[8 * s + 0], IT[8 * s + 1]); pw.y = pk2(IT[8 * s + 2], IT[8 * s + 3]); pw.z = pk2(IT[8 * s + 4], IT[8 * s + 5]); pw.w = pk2(IT[8 * s + 6], IT[8 * s + 7]); \
                const LAS unsigned char* vp = lds + LV + (32 * (J) + 16 * s + 4 * hi + q4) * VR + (32 * wc + 16 * blk) * 2 + 8 * p4; \
                const s16x4 lo = trrd(vp), hh = trrd(vp + 8 * VR); acc = MFMA32(__builtin_bit_cast(bf16x8, pw), CAT8(lo, hh), acc); } } while (0)
        PVSTEP(it0, 0);
        if (wr) PVSTEP(it1, 1);
#undef PVSTEP
        if (more) { const unsigned nr = (unsigned)(ci + 1) * C;
#pragma unroll
            for (int k = 0; k < 4; ++k) kreg[k] = *(const v4u*)(K + (kg + (nr + 16 * k) * 1024u));
#pragma unroll
            for (int k = 0; k < 2; ++k) vreg[k] = *(const v4u*)(V + (vg + (nr + 32 * k) * 2048u)); }
        { unsigned ob = ((unsigned)t0 + 32 * wr + 4 * hi) * 2048u + h * 512 + vs * 128 + 32 * wc + r32; asm volatile("" : "+v"(ob));
          float fb = lg * (float)(32 * wr + 4 * hi + 1); asm volatile("" : "+v"(fb));
          const float f0 = __builtin_amdgcn_exp2f(fb), g2 = gam * gam, g8 = (g2 * g2) * (g2 * g2);
          float fr4 = f0;
#pragma unroll
          for (int r4 = 0; r4 < 4; ++r4) { float f = fr4;
#pragma unroll
            for (int e = 0; e < 4; ++e) { const int r = 4 * r4 + e, dq = e + 8 * r4; Vst[(ob + (unsigned)dq * 2048u) & stmask] = (bf16)f2bf(acc[r] * f); f *= gam; }
            fr4 *= g8; } }
#pragma unroll
        for (int t = 0; t < 4; ++t) S[t] = S[t] * gC;
#pragma unroll
        for (int s = 0; s < 4; ++s) {
            const LAS unsigned char* ka = lds + LK + (16 * s + 8 * hi + q4) * KR + (32 * wave + 16 * blk) * 2 + 8 * p4;
            const s16x4 klo = trrd(ka), khi = trrd(ka + 4 * KR); const bf16x8 kf = CAT8(klo, khi);
#pragma unroll
            for (int t = 0; t < 4; ++t) { const LAS unsigned char* vb = lds + LV + (16 * s + 8 * hi + q4) * VR + (32 * t + 16 * blk) * 2 + 8 * p4;
                const s16x4 vlo = trrd(vb), vhi = trrd(vb + 4 * VR); S[t] = MFMA32(kf, CAT8(vlo, vhi), S[t]); } }
        LBAR();
#pragma unroll
        for (int t = 0; t < 4; ++t)
#pragma unroll
            for (int g4 = 0; g4 < 4; ++g4) { v2u w; w.x = pk2(S[t][4 * g4 + 0], S[t][4 * g4 + 1]); w.y = pk2(S[t][4 * g4 + 2], S[t][4 * g4 + 3]);
                *(LAS v2u*)(lds + LST + (32 * t + r32) * SR + (32 * wave + 8 * g4 + 4 * hi) * 2) = w; }
    }
    __syncthreads();
}
}

struct Args { const float* in[11]; float* out; unsigned char* ws; int pad0, pad1; };
__global__ void __launch_bounds__(NWAVES * 64, 2) fwd_mk(Args args) {
    extern __shared__ __attribute__((aligned(16))) unsigned char lds_raw[];
    cg::grid_group grid = cg::this_grid();
#define GSYNC() do { xcd_barrier(xbar); if (PROBE_DOUBLE == 11) xcd_barrier(xbar); } while (0)
#ifndef PROBE_T
#define PROBE_T 0
#endif
#define GSYNCN(id) do { GSYNC(); if (PROBE_T && bx == 0 && threadIdx.x == 0) { const unsigned long long t_ = __builtin_amdgcn_s_memrealtime(); if (PROBE_T == (id) + 1) tacc[0] += t_ - tacc[1]; tacc[1] = t_; } } while (0)
    LAS unsigned char* lds = (LAS unsigned char*)lds_raw;
    int tid = threadIdx.x, lane = tid & 63, wave = __builtin_amdgcn_readfirstlane(tid >> 6);
#define RETID() do { tid = threadIdx.x; asm volatile("" : "+v"(tid)); lane = tid & 63; wave = __builtin_amdgcn_readfirstlane(tid >> 6); bx = blockIdx.x; asm volatile("" : "+s"(bx)); vcu = (bx % 8) * (G / 8) + bx / 8; gw = vcu * NWAVES + wave; RELOAD(); } while (0)
    constexpr int G = 256; int bx = blockIdx.x, vcu = (bx % 8) * (G / 8) + bx / 8;
    int gw = vcu * NWAVES + wave; constexpr int NGW = G * NWAVES;
    LAS unsigned long long* ptab = (LAS unsigned long long*)(lds + LDS_BYTES - 128);
    LAS unsigned long long* tacc = (LAS unsigned long long*)(lds + LDS_BYTES - 160);
    if (PROBE_T && threadIdx.x == 0) { tacc[0] = 0; tacc[1] = __builtin_amdgcn_s_memrealtime(); }
    if (tid == 0) {
        ptab[0] = (unsigned long long)args.in[0]; ptab[1] = (unsigned long long)args.in[1]; ptab[2] = (unsigned long long)args.in[2]; ptab[3] = (unsigned long long)args.in[3];
        ptab[4] = (unsigned long long)args.in[4]; ptab[5] = (unsigned long long)args.in[5]; ptab[6] = (unsigned long long)args.in[6]; ptab[7] = (unsigned long long)args.in[7];
        ptab[8] = (unsigned long long)args.in[8]; ptab[9] = (unsigned long long)args.in[9]; ptab[10] = (unsigned long long)args.in[10]; ptab[11] = (unsigned long long)args.out; ptab[12] = (unsigned long long)args.ws; }
    __syncthreads();
#define GASP(T, i) ((T*)(__attribute__((address_space(1))) T*)LDP(i))
#define LDP(i) ({ const unsigned long long v_ = ptab[(i) + pz_]; (((unsigned long long)(unsigned)__builtin_amdgcn_readfirstlane((int)(v_ >> 32))) << 32) | (unsigned long long)(unsigned)__builtin_amdgcn_readfirstlane((int)(unsigned)v_); })
#define RELOAD() do { int pz_ = 0; asm volatile("" : "+v"(pz_) :: "memory"); ws = GASP(unsigned char, 12); out = GASP(float, 11); in.x = GASP(const float, 0); in.gmix = GASP(const float, 1); in.gffn = GASP(const float, 2); in.ewin = GASP(const float, 3); in.ebf = GASP(const float, 4); \
        in.ewout = GASP(const float, 5); in.owin = GASP(const float, 6); in.owout = GASP(const float, 7); in.f1 = GASP(const float, 8); in.f2 = GASP(const float, 9); in.gfin = GASP(const float, 10); \
        XN = (bf16*)(ws + WS_XN); LOGF = (float*)(ws + WS_LOGF); SSM = (float*)(ws + 1020 * MiB); SSF = (float*)(ws + WS_LSE);     LSE = (float*)(ws + WS_LSE); } while (0)
    unsigned char* ws; float* out; Ins in; bf16* XN; float* LOGF; float* SSM; float* SSF; float* LSE;
    RELOAD();
    volatile LAS unsigned* xst = (volatile LAS unsigned*)(lds + LDS_BYTES - 192);
    if (threadIdx.x == 0) { xst[0] = 0u; xst[1] = 0u; }
    __syncthreads();
    XcdBarrier xbar = xcd_barrier_post((unsigned*)ws, xst);
    p0_prologue(in, ws, lds, gw, NGW, wave, lane);
    if (PROBE_DOUBLE == 10) p0_prologue(in, ws, lds, gw, NGW, wave, lane);
    __syncthreads();
#pragma unroll 1
    for (int layer = 0; layer < DEPTH; ++layer) {
        const int li = layer >> 1; const bool even = (layer & 1) == 0;
        RETID();
#define XIN ((layer == 0) ? in.x : out)
        if (layer == 0) {
            gate_pass<true>(in.x, XN, SSM, in.gmix, in.ewin + EVEN_N, in.ebf, LOGF, lds, gw, NGW, tid, lane);
            grid.sync();
            if (PROBE_T && bx == 0 && threadIdx.x == 0) { const unsigned long long t_ = __builtin_amdgcn_s_memrealtime(); if (PROBE_T == 1) tacc[0] += t_ - tacc[1]; tacc[1] = t_; }
            RETID();
        }
#define ZERO_SS(P) do { for (int i_ = vcu * (NWAVES * 64) + tid; i_ < M; i_ += G * NWAVES * 64) (P)[i_] = 0.f; } while (0)
        if (even) {
            if (layer != 0) { gate_pass<false>(nullptr, XN, SSM, in.gmix + layer * DM, in.ewin + (size_t)li * DM * EVEN_IN + EVEN_N, in.ebf + li * 8, LOGF, lds, gw, NGW, tid, lane); RETID(); }
            { pg8::Gemm g{XN, (const bf16*)(ws + WS_EIN) + (size_t)li * EVEN_N * DM, M, EVEN_N, DM}; pg8::StaticOrder S; S.init(M, EVEN_N, G, bx);
              pg8::EpiSplit<0> E{(bf16*)(ws + WS_ACT), 512, 512, SEG / 2, 3, attn_body::C2, SSM};
              for (int rp = 0; rp < (PROBE_DOUBLE == 9 ? 2 : 1); ++rp) pg8::gemm_phase<pg8::EpiSplit<0>, pg8::StaticOrder, PG8_ALIGN, PG8_SP2, STREAM_F16 != 0>(lds, g, S, E); }
            GSYNCN(1);
            { const attn_body::AttnTensors AT{(const attn_body::bf16*)(ws + WS_ACT + 3 * SEG), (const attn_body::bf16*)(ws + WS_ACT + 4 * SEG), (const attn_body::bf16*)(ws + WS_ACT + 5 * SEG),
                                              (attn_body::bf16*)(ws + WS_AO) + 512, LOGF};
              const attn_body::StaticOrder S(G, bx);
              for (int rp = 0; rp < (PROBE_DOUBLE == 2 ? 2 : 1); ++rp) attn_body::attn_phase<attn_body::StaticOrder>((char*)lds_raw, AT, S);
 }
            __syncthreads(); RETID();
            for (int rp = 0; rp < (PROBE_DOUBLE == 1 ? 2 : 1); ++rp) {
                constexpr int NU = BATCH * 8 * 3 * 16; const bf16* QA = (const bf16*)(ws + WS_ACT); const bf16* KA = (const bf16*)(ws + WS_ACT + SEG); const bf16* VA = (const bf16*)(ws + WS_ACT + 2 * SEG);
                v4u kreg[6], vreg[6]; bf16x8 qn[4];
                dil::U cur = dil::decode(vcu); dil::issue(cur, QA, KA, VA, tid, wave, lane, kreg, vreg, qn);
                for (int u = vcu; u < NU; u += G) {
                    dil::stage(cur, lds, tid, kreg, vreg);
                    bf16x8 qc[4];
#pragma unroll
                    for (int s_ = 0; s_ < 4; ++s_) qc[s_] = qn[s_];
                    LBAR();
                    const int g3 = (u >> 4) % 3; const dil::U me = cur;
                    if (u + G < NU) { cur = dil::decode(u + G); dil::issue(cur, QA, KA, VA, tid, wave, lane, kreg, vreg, qn); }
                    dil::compute(me, g3, qc, (bf16*)(ws + WS_OG + (size_t)g3 * SEG), LSE + (size_t)g3 * M * 8, lds, wave, lane);
                    LBAR();
                }
            }
            GSYNCN(2);
            RETID();
            for (int rp = 0; rp < (PROBE_DOUBLE == 5 ? 2 : 1); ++rp)
            for (int m = gw; m < M; m += NGW) { const int hh = lane >> 3;
                const float l0 = LSE[(size_t)m * 8 + hh], l1 = LSE[(size_t)M * 8 + (size_t)m * 8 + hh], l2 = LSE[(size_t)2 * M * 8 + (size_t)m * 8 + hh];
                const float mx = fmaxf(l0, fmaxf(l1, l2)); float w0 = __builtin_amdgcn_exp2f(l0 - mx), w1 = __builtin_amdgcn_exp2f(l1 - mx), w2 = __builtin_amdgcn_exp2f(l2 - mx); const float inv = 1.0f / (w0 + w1 + w2); w0 *= inv; w1 *= inv; w2 *= inv;
                const v4u a = *((const v4u*)((const bf16*)(ws + WS_OG) + (size_t)m * 512) + lane), bq = *((const v4u*)((const bf16*)(ws + WS_OG + SEG) + (size_t)m * 512) + lane), c = *((const v4u*)((const bf16*)(ws + WS_OG + 2 * SEG) + (size_t)m * 512) + lane);
                v4u o;
#define CMB(f) { const float lo = w0 * __builtin_bit_cast(float, a.f << 16) + w1 * __builtin_bit_cast(float, bq.f << 16) + w2 * __builtin_bit_cast(float, c.f << 16); \
                 const float hi_ = w0 * __builtin_bit_cast(float, a.f & 0xffff0000u) + w1 * __builtin_bit_cast(float, bq.f & 0xffff0000u) + w2 * __builtin_bit_cast(float, c.f & 0xffff0000u); o.f = pk2(lo, hi_); }
                CMB(x) CMB(y) CMB(z) CMB(w)
#undef CMB
                *((v4u*)((bf16*)(ws + WS_AO) + (size_t)m * 1024) + lane) = o; }
            GSYNCN(3);
            RETID();
            { pg8::Gemm g{(const bf16*)(ws + WS_AO), (const bf16*)(ws + WS_EOUT) + (size_t)li * DM * DM, M, DM, DM}; pg8::StaticOrder S; S.init(M, DM, G, bx);
              if (layer == 0) { pg8::EpiRes<true> E{in.x, XN, DM, SSF, nullptr}; pg8::gemm_phase<pg8::EpiRes<true>, pg8::StaticOrder, PG8_ALIGN, PG8_SP2>(lds, g, S, E); }
              else { pg8::EpiRes<false> E{nullptr, XN, DM, SSF, nullptr}; pg8::gemm_phase<pg8::EpiRes<false>, pg8::StaticOrder, PG8_ALIGN, PG8_SP2>(lds, g, S, E); } }
        } else {
            RETID();
            { pg8::Gemm g{XN, (const bf16*)(ws + WS_OIN) + (size_t)li * ODD_IN * DM, M, ODD_IN, DM}; pg8::StaticOrder S; S.init(M, ODD_IN, G, bx);
              pg8::EpiOddIn E{(bf16*)(ws + WS_RQ), (bf16*)(ws + WS_RK), (bf16*)(ws + WS_RV), (bf16*)(ws + WS_RG), SSM};
              for (int rp = 0; rp < (PROBE_DOUBLE == 13 ? 2 : 1); ++rp) pg8::gemm_phase<pg8::EpiOddIn, pg8::StaticOrder, PG8_ALIGN, PG8_SP2, STREAM_F16 != 0>(lds, g, S, E); }
            GSYNCN(4);
            RETID();
            for (int u = vcu; u < BATCH * 4 * 4; u += G) { const int vs = u & 3, bh = u >> 2;
                for (int rp = (PROBE_DOUBLE == 3 ? 0 : 1); rp < 2; ++rp) ret::unit(bh >> 2, bh & 3, vs, (const bf16*)(ws + WS_RQ), (const bf16*)(ws + WS_RK), (bf16*)(ws + WS_RV), lds, tid, wave, lane, (rp == 0) ? (bf16*)ws : (bf16*)(ws + WS_RV), (rp == 0) ? 0x7ffffu : 0xffffffffu); }
            GSYNCN(5);
            RETID();
            for (int it = gw; it < M * 4; it += NGW) { const size_t off = (size_t)(it >> 2) * 2048 + (it & 3) * 512 + lane * 8;
                const v4u ov = *(const v4u*)((const bf16*)(ws + WS_RV) + off), gv = *(const v4u*)((const bf16*)(ws + WS_RG) + off);
                float o[8], gg[8];
                o[0] = __builtin_bit_cast(float, ov.x << 16); o[1] = __builtin_bit_cast(float, ov.x & 0xffff0000u); o[2] = __builtin_bit_cast(float, ov.y << 16); o[3] = __builtin_bit_cast(float, ov.y & 0xffff0000u);
                o[4] = __builtin_bit_cast(float, ov.z << 16); o[5] = __builtin_bit_cast(float, ov.z & 0xffff0000u); o[6] = __builtin_bit_cast(float, ov.w << 16); o[7] = __builtin_bit_cast(float, ov.w & 0xffff0000u);
                gg[0] = __builtin_bit_cast(float, gv.x << 16); gg[1] = __builtin_bit_cast(float, gv.x & 0xffff0000u); gg[2] = __builtin_bit_cast(float, gv.y << 16); gg[3] = __builtin_bit_cast(float, gv.y & 0xffff0000u);
                gg[4] = __builtin_bit_cast(float, gv.z << 16); gg[5] = __builtin_bit_cast(float, gv.z & 0xffff0000u); gg[6] = __builtin_bit_cast(float, gv.w << 16); gg[7] = __builtin_bit_cast(float, gv.w & 0xffff0000u);
                float s = 0.f;
#pragma unroll
                for (int e = 0; e < 8; ++e) s += o[e];
                const float mu = wave_sum(s) * (1.f / 512.f); float q = 0.f;
#pragma unroll
                for (int e = 0; e < 8; ++e) { o[e] -= mu; q += o[e] * o[e]; }
                const float rs = 1.0f / sqrtf(wave_sum(q) * (1.f / 512.f) + GN_EPS);
                float y[8];
#pragma unroll
                for (int e = 0; e < 8; ++e) y[e] = gg[e] / (1.0f + __expf(-gg[e])) * (o[e] * rs);
                v4u w; w.x = pk2(y[0], y[1]); w.y = pk2(y[2], y[3]); w.z = pk2(y[4], y[5]); w.w = pk2(y[6], y[7]);
                *(v4u*)((bf16*)(ws + WS_RG) + off) = w; }
            GSYNCN(6);
            RETID();
            { pg8::Gemm g{(const bf16*)(ws + WS_RG), (const bf16*)(ws + WS_OOUT) + (size_t)li * 2 * DM * DM, M, DM, 2 * DM}; pg8::StaticOrder S; S.init(M, DM, G, bx);
              pg8::EpiRes<false> E{nullptr, XN, DM, SSF, nullptr}; pg8::gemm_phase<pg8::EpiRes<false>, pg8::StaticOrder, PG8_ALIGN, PG8_SP2>(lds, g, S, E); }
        }
        GSYNCN(7);
        RETID();
        if (PROBE_DOUBLE == 20) { const unsigned long long t0_ = __builtin_amdgcn_s_memrealtime(); while (__builtin_amdgcn_s_memrealtime() - t0_ < 25000ull) __builtin_amdgcn_s_sleep(16); }
        { pg8::Gemm g{XN, (const bf16*)(ws + WS_F1) + (size_t)layer * FF * DM, M, FF, DM}; pg8::StaticOrder S; S.init(M, FF, G, bx);
          pg8::EpiSplit<2> E{(bf16*)(ws + WS_H), FF, 0, 0, -1, 1.f, SSF};
          for (int rp = 0; rp < (PROBE_DOUBLE == 7 ? 2 : 1); ++rp) pg8::gemm_phase<pg8::EpiSplit<2>, pg8::StaticOrder, PG8_ALIGN, PG8_SP2, STREAM_F16 != 0>(lds, g, S, E); }
        GSYNCN(9);
        RETID();
        { pg8::Gemm g{(const bf16*)(ws + WS_H), (const bf16*)(ws + WS_F2) + (size_t)layer * FF * DM, M, DM, FF}; pg8::StaticOrder S; S.init(M, DM, G, bx);
          pg8::EpiRes<false> E{nullptr, XN, DM, SSM, SSF}; pg8::gemm_phase<pg8::EpiRes<false>, pg8::StaticOrder, PG8_ALIGN, PG8_SP2>(lds, g, S, E); }
        GSYNCN(10);
    }
    RETID();
    { f32x4 gv[4];
#pragma unroll
      for (int j = 0; j < 4; ++j) gv[j] = *((const f32x4*)in.gfin + lane + 64 * j);
      for (int m = gw; m < M; m += NGW) { const v2u* xr = (const v2u*)(XN + (size_t)m * DM) + lane; f32x4 v[4]; float s = 0.f;
#pragma unroll
          for (int j = 0; j < 4; ++j) { const v2u w = xr[64 * j]; v[j].x = pg8::st_lo(w.x); v[j].y = pg8::st_hi(w.x); v[j].z = pg8::st_lo(w.y); v[j].w = pg8::st_hi(w.y);
              s += (v[j].x * v[j].x + v[j].y * v[j].y) + (v[j].z * v[j].z + v[j].w * v[j].w); }
          const float rstd = 1.0f / sqrtf(wave_sum(s) * (1.f / DM) + RMS_EPS); f32x4* orow = (f32x4*)(out + (size_t)m * DM) + lane;
#pragma unroll
          for (int j = 0; j < 4; ++j) orow[64 * j] = v[j] * rstd * gv[j]; } }
    if (PROBE_T && bx == 0 && threadIdx.x == 0) { const unsigned long long t0_ = __builtin_amdgcn_s_memrealtime(), w_ = 10ull * tacc[0]; while (__builtin_amdgcn_s_memrealtime() - t0_ < w_) __builtin_amdgcn_s_sleep(8); }
}

extern "C" void kernel_launch(void* const* d_in, const int* in_sizes, int n_in, void* d_out, int out_size, void* d_ws, size_t ws_size, hipStream_t stream) {
    static int grid = 0;
    if (grid == 0) {
        if (n_in != 11 || in_sizes[0] != M * DM || out_size != M * DM || ws_size < WS_END) { fprintf(stderr, "kernel_launch: unexpected shapes (n_in %d, ws %zu)\n", n_in, ws_size); grid = -1; return; }
        if (hipFuncSetAttribute((const void*)fwd_mk, hipFuncAttributeMaxDynamicSharedMemorySize, LDS_BYTES) != hipSuccess) { fprintf(stderr, "kernel_launch: hipFuncSetAttribute failed\n"); grid = -1; return; }
        int dev = 0, cus = 0, per_cu = 0;
        hipGetDevice(&dev); hipDeviceGetAttribute(&cus, hipDeviceAttributeMultiprocessorCount, dev);
        hipOccupancyMaxActiveBlocksPerMultiprocessor(&per_cu, (const void*)fwd_mk, NWAVES * 64, LDS_BYTES);
        (void)hipGetLastError();
        if (per_cu < 1) per_cu = 1;
        grid = cus;
        if (grid != 256) { fprintf(stderr, "kernel_launch: built for a 256-CU device, found %d\n", cus); grid = -1; return; }
    }
    if (grid < 0) return;
    if (hipMemsetAsync(d_ws, 0, 16384, stream) != hipSuccess) { fprintf(stderr, "kernel_launch: memset failed\n"); return; }
    Args a{};
    for (int i = 0; i < 11; ++i) a.in[i] = (const float*)d_in[i];
    a.out = (float*)d_out; a.ws = (unsigned char*)d_ws;
    void* kargs[] = {&a};
    hipError_t e = hipLaunchCooperativeKernel((const void*)fwd_mk, dim3(grid), dim3(NWAVES * 64), kargs, LDS_BYTES, stream);
    if (e != hipSuccess) fprintf(stderr, "cooperative launch failed: %s (grid %d)\n", hipGetErrorString(e), grid);
}
```

```cpp
#include <hip/hip_runtime.h>
#include <cstdio>
#include <cstdint>
namespace pg8 {
#define PG8_LAS __attribute__((address_space(3)))
typedef unsigned short bf16_t;
typedef short bf16x8 __attribute__((ext_vector_type(8)));
typedef float f32x4 __attribute__((ext_vector_type(4)));
typedef unsigned u32x4 __attribute__((ext_vector_type(4)));
constexpr int BM = 256, BK = 64, HALF = 128, HTB = HALF * BK * 2  , STAGE_BYTES = 8 * HTB, NXCD = 8, WGM = 8;

__host__ __device__ __forceinline__ int lds_byte(int r, int c) { const int st = (r >> 4) * 2 + (c >> 5), rr = r & 15, cc = c & 31, ob = rr * 64 + cc * 2; return st * 1024 + (ob ^ (((ob >> 9) & 1) << 5)); }
__host__ __device__ __forceinline__ void stage_rc(int b, int& R, int& C) { const int st = b / 1024, sb = b % 1024, swz = sb ^ (((sb >> 9) & 1) << 5); R = (st >> 1) * 16 + swz / 64; C = (st & 1) * 32 + (swz % 64) / 2; }
__host__ __device__ __forceinline__ int perm32(int rho) { const int n = rho >> 4, i = rho & 15; return 8 * (i >> 2) + 4 * n + (i & 3); }

struct Unit { int pm, pn; };
struct Gemm { const bf16_t* A; const bf16_t* Bt; int M, N, K; };

struct StaticOrder {
    int nM, nN, nwg, G, c;
    __host__ __device__ void init(int M, int N, int G_, int c_) { nM = M / BM; nN = N / BM; nwg = nM * nN; G = G_; c = c_; }
    __host__ __device__ bool next(int i, Unit& u) const {
        const long L = (long)i * G + c; if (L >= nwg) return false;
        int wgid = (int)L; { const int q = nwg / NXCD, r = nwg % NXCD, xcd = wgid % NXCD, off = wgid / NXCD; wgid = (xcd < r ? xcd * (q + 1) : r * (q + 1) + (xcd - r) * q) + off; }
        const int nig = WGM * nN, gid = wgid / nig, fm = gid * WGM, gsz = (nM - fm) < WGM ? (nM - fm) : WGM;
        u.pm = fm + ((wgid % nig) % gsz); u.pn = (wgid % nig) / gsz; return true;
    }
    __device__ __forceinline__ void a_ready(const Unit&) const {}
    __device__ __forceinline__ void done(const Unit&) const {}
};

__device__ __forceinline__ unsigned cvt_pk_bf16(float lo, float hi) { unsigned r; asm volatile("v_cvt_pk_bf16_f32 %0, %1, %2" : "=v"(r) : "v"(lo), "v"(hi)); return r; }
typedef float f32x2 __attribute__((ext_vector_type(2)));
__device__ __forceinline__ f32x2 gelu_pk(f32x2 v) {
    const f32x2 av = __builtin_elementwise_abs(v), d = av * 0.2316418882f + 1.0f;
    f32x2 t; t.x = __builtin_amdgcn_rcpf(d.x); t.y = __builtin_amdgcn_rcpf(d.y);
    f32x2 q = t * 0.5307027145f + (-0.7265760135f); q = q * t + 0.7107068705f; q = q * t + (-0.142248368f); q = q * t + 0.127414796f; q = q * t;
    const f32x2 s = (v * v) * (-0.72134752044f);
    f32x2 e; e.x = __builtin_amdgcn_exp2f(s.x); e.y = __builtin_amdgcn_exp2f(s.y);
    const f32x2 m = v * (q * e), r = v - m;
    f32x2 o; o.x = v.x < 0.f ? m.x : r.x; o.y = v.y < 0.f ? m.y : r.y; return o;
}

template <int ACT  > struct EpiBf16 {
    static constexpr bool PERM = true, AFTER_DRAIN = false; static_assert(ACT == 0 || ACT == 1, "EpiBf16: ACT is 0 (none) or 1 (gelu_pk)");
    bf16_t* O; int ldc; const float* bias; int split_cols; size_t split_stride; float scale0;
    __device__ __forceinline__ void operator()(const f32x4 (&acc)[2][2][4][2], const Unit& u, int wr, int wc, int fr, int fq) const {
        const int row0 = u.pm * BM + wr * 64 + fr; int colt = u.pn * BM; bf16_t* base = O;
        float sc = 1.f; if (split_cols) { const int t = colt / split_cols; base += (size_t)t * split_stride; colt -= t * split_cols; if (t == 0) sc = scale0; }
        const int col0 = colt + wc * 32 + 8 * fq, bcol0 = u.pn * BM + wc * 32 + 8 * fq;
        f32x4 bv[2][2];
#pragma unroll
        for (int bj = 0; bj < 2; ++bj)
#pragma unroll
            for (int n = 0; n < 2; ++n) bv[bj][n] = bias ? *(const f32x4*)(bias + bcol0 + bj * HALF + 4 * n) : (f32x4){0.f, 0.f, 0.f, 0.f};
#pragma unroll
        for (int ai = 0; ai < 2; ++ai)
#pragma unroll
            for (int m = 0; m < 4; ++m) { bf16_t* rowp = base + (size_t)(row0 + ai * HALF + m * 16) * ldc + col0;
#pragma unroll
                for (int bj = 0; bj < 2; ++bj) { f32x4 v0 = acc[ai][bj][m][0] + bv[bj][0], v1 = acc[ai][bj][m][1] + bv[bj][1];
                    if (ACT == 1) { f32x2 a = gelu_pk((f32x2){v0[0], v0[1]}), b = gelu_pk((f32x2){v0[2], v0[3]}), c = gelu_pk((f32x2){v1[0], v1[1]}), d = gelu_pk((f32x2){v1[2], v1[3]});
                        v0 = (f32x4){a.x, a.y, b.x, b.y}; v1 = (f32x4){c.x, c.y, d.x, d.y}; }
                    v0 = v0 * sc; v1 = v1 * sc; u32x4 w; w.x = cvt_pk_bf16(v0[0], v0[1]); w.y = cvt_pk_bf16(v0[2], v0[3]); w.z = cvt_pk_bf16(v1[0], v1[1]); w.w = cvt_pk_bf16(v1[2], v1[3]);
                    *(u32x4*)(rowp + bj * HALF) = w; } }
    }
};

struct PanelStats {
    unsigned* xbuf;
    unsigned* cnt;
    unsigned* tmo;
    int ntn; float eps;
    unsigned code;
    __device__ __forceinline__ bool run(const f32x4 (&v)[2][2][4][2], const Unit& u, int wr, int wc, int fr, int fq, PG8_LAS unsigned char* lds, int wid, int lane) const {
        typedef float f32x2v __attribute__((ext_vector_type(2)));
        PG8_LAS f32x2v* P = (PG8_LAS f32x2v*)lds;
        PG8_LAS f32x2v* S = (PG8_LAS f32x2v*)(lds + 8192);
        PG8_LAS unsigned* flag = (PG8_LAS unsigned*)(lds + 8192 + 2048);
#pragma unroll
        for (int ai = 0; ai < 2; ++ai)
#pragma unroll
            for (int m = 0; m < 4; ++m) {
                float s = 0.f;
#pragma unroll
                for (int bj = 0; bj < 2; ++bj)
#pragma unroll
                    for (int n = 0; n < 2; ++n) { const f32x4 x = v[ai][bj][m][n]; s += (x[0] + x[1]) + (x[2] + x[3]); }
                s += __shfl_xor(s, 16); s += __shfl_xor(s, 32);
                const float mw = s * (1.0f / 64.0f); float q = 0.f;
#pragma unroll
                for (int bj = 0; bj < 2; ++bj)
#pragma unroll
                    for (int n = 0; n < 2; ++n) { const f32x4 d = v[ai][bj][m][n] - mw; q += (d[0] * d[0] + d[1] * d[1]) + (d[2] * d[2] + d[3] * d[3]); }
                q += __shfl_xor(q, 16); q += __shfl_xor(q, 32);
                if (fq == 0) P[(ai * HALF + wr * 64 + m * 16 + fr) * 4 + wc] = (f32x2v){mw, q};
            }
        asm volatile("s_waitcnt lgkmcnt(0)" ::: "memory"); __builtin_amdgcn_s_barrier(); asm volatile("" ::: "memory");
#if defined(BROKEN_EXCHANGE_NO_WAIT)
#warning BROKEN CONTROL BUILD: the row-statistics exchange does not wait; results are wrong by design
        if (blockIdx.x >= 64) { const long long t0_ = clock64(); while (clock64() - t0_ < 60000) __builtin_amdgcn_s_sleep(8); }
#endif
        const int row = wid * 32 + (lane & 31);
        if (lane < 32) {
            const f32x2v a = P[row * 4 + 0], b = P[row * 4 + 1], c = P[row * 4 + 2], d = P[row * 4 + 3];
            const float mt = (a.x + b.x + c.x + d.x) * 0.25f;
            const float da = a.x - mt, db = b.x - mt, dc = c.x - mt, dd = d.x - mt;
            const float m2 = (a.y + b.y) + (c.y + d.y) + 64.0f * ((da * da + db * db) + (dc * dc + dd * dd));
            unsigned long long* slot = (unsigned long long*)xbuf + ((size_t)(u.pm * BM + row) * 4 + u.pn);
            __hip_atomic_store(slot, ((unsigned long long)__float_as_uint(m2) << 32) | __float_as_uint(mt), __ATOMIC_RELAXED, __HIP_MEMORY_SCOPE_AGENT);
        }
        asm volatile("s_waitcnt vmcnt(0)" ::: "memory");
        if (lane == 0) __hip_atomic_fetch_add(cnt + 64 * u.pm, 1u, __ATOMIC_RELAXED, __HIP_MEMORY_SCOPE_AGENT);
        if (wid == 0) {
            bool dead = false; const unsigned long long t0 = __builtin_amdgcn_s_memrealtime(); const unsigned want = 8u * (unsigned)ntn;
            for (;;) {
#if defined(BROKEN_EXCHANGE_NO_WAIT)
                break;
#endif
                if ((unsigned)__builtin_amdgcn_readfirstlane(__hip_atomic_load(cnt + 64 * u.pm, __ATOMIC_RELAXED, __HIP_MEMORY_SCOPE_AGENT)) >= want) break;
                if (__builtin_amdgcn_s_memrealtime() - t0 > 2000000ull) {
                    if (lane == 0) { unsigned expect = 0u; __hip_atomic_compare_exchange_strong(tmo + 1, &expect, code | (unsigned)(u.pm & 0xff), __ATOMIC_RELAXED, __ATOMIC_RELAXED, __HIP_MEMORY_SCOPE_AGENT);
                                     __hip_atomic_store(tmo, 1u, __ATOMIC_RELAXED, __HIP_MEMORY_SCOPE_AGENT); }
                    dead = true; break; }
                __builtin_amdgcn_s_sleep(2);
            }
            __builtin_amdgcn_fence(__ATOMIC_ACQUIRE, "agent");
            if (lane == 0) flag[0] = dead ? 1u : 0u;
        }
        asm volatile("s_waitcnt vmcnt(0) lgkmcnt(0)" ::: "memory"); __builtin_amdgcn_s_barrier(); asm volatile("" ::: "memory");
        const bool bad = flag[0] != 0u;
        if (lane < 32) {
            const unsigned long long* slot = (const unsigned long long*)xbuf + (size_t)(u.pm * BM + row) * 4; float mt[4], m2[4]; float ms = 0.f;
#pragma unroll
            for (int t = 0; t < 4; ++t) { if (t < ntn) { const unsigned long long w = __hip_atomic_load(slot + t, __ATOMIC_RELAXED, __HIP_MEMORY_SCOPE_AGENT); mt[t] = __uint_as_float((unsigned)w); m2[t] = __uint_as_float((unsigned)(w >> 32)); } else { mt[t] = 0.f; m2[t] = 0.f; } ms += mt[t]; }
            const float mean = ms / (float)ntn; float q = 0.f;
#pragma unroll
            for (int t = 0; t < 4; ++t) if (t < ntn) { const float dm = mt[t] - mean; q += m2[t] + 256.0f * dm * dm; }
            S[row] = (f32x2v){mean, 1.0f / sqrtf(q / (256.0f * (float)ntn) + eps)};
        }
        asm volatile("s_waitcnt lgkmcnt(0)" ::: "memory"); __builtin_amdgcn_s_barrier(); asm volatile("" ::: "memory");
        return bad;
    }
};
struct EpiLnRes {
    static constexpr bool PERM = false, AFTER_DRAIN = true;
    const float* base; float* out; int ldc; const float* bias; PanelStats st; unsigned poison;
    __device__ __forceinline__ void fused(f32x4 (&acc)[2][2][4][2], const Unit& u, int wr, int wc, int fr, int fq, PG8_LAS unsigned char* lds, int wid, int lane) const {
        typedef float f32x2v __attribute__((ext_vector_type(2)));
        const PG8_LAS f32x2v* S = (const PG8_LAS f32x2v*)(lds + 8192);
        const int col0 = u.pn * BM + wc * 32 + 4 * fq;
#pragma unroll
        for (int bj = 0; bj < 2; ++bj)
#pragma unroll
            for (int n = 0; n < 2; ++n) { const f32x4 bv = bias ? *(const f32x4*)(bias + col0 + bj * HALF + n * 16) : (f32x4){0.f, 0.f, 0.f, 0.f};
#pragma unroll
                for (int ai = 0; ai < 2; ++ai)
#pragma unroll
                    for (int m = 0; m < 4; ++m) acc[ai][bj][m][n] += bv; }
        f32x4 pre[4][2][2];
#pragma unroll
        for (int m = 0; m < 4; ++m) { const size_t off = (size_t)(u.pm * BM + wr * 64 + m * 16 + fr) * ldc + col0;
#pragma unroll
            for (int bj = 0; bj < 2; ++bj)
#pragma unroll
                for (int n = 0; n < 2; ++n) pre[m][bj][n] = *(const f32x4*)(base + off + bj * HALF + n * 16); }
        const bool bad = st.run(acc, u, wr, wc, fr, fq, lds, wid, lane) || poison != 0u;
        const float qnan = __builtin_nanf("");
#pragma unroll
        for (int ai = 0; ai < 2; ++ai)
#pragma unroll
            for (int m = 0; m < 4; ++m) { const int r = ai * HALF + wr * 64 + m * 16 + fr; const f32x2v sr = S[r]; const size_t off = (size_t)(u.pm * BM + r) * ldc + col0;
#pragma unroll
                for (int bj = 0; bj < 2; ++bj)
#pragma unroll
                    for (int n = 0; n < 2; ++n) { const f32x4 bs = ai == 0 ? pre[m][bj][n] : *(const f32x4*)(base + off + bj * HALF + n * 16); f32x4 o = bs + (acc[ai][bj][m][n] - sr.x) * sr.y;
                        if (bad) o = (f32x4){qnan, qnan, qnan, qnan}; *(f32x4*)(out + off + bj * HALF + n * 16) = o; }
                if (m & 1) asm volatile("" ::: "memory"); }
    }
};
struct EpiLnResLn {
    static constexpr bool PERM = false, AFTER_DRAIN = true;
    const float* base; float* out; bf16_t* xn; int ldc; const float* bias; PanelStats st1, st2; unsigned poison;
    __device__ __forceinline__ void fused(f32x4 (&acc)[2][2][4][2], const Unit& u, int wr, int wc, int fr, int fq, PG8_LAS unsigned char* lds, int wid, int lane) const {
        typedef float f32x2v __attribute__((ext_vector_type(2))); typedef unsigned u32x2v __attribute__((ext_vector_type(2)));
        const PG8_LAS f32x2v* S = (const PG8_LAS f32x2v*)(lds + 8192);
        const int col0 = u.pn * BM + wc * 32 + 4 * fq;
#pragma unroll
        for (int bj = 0; bj < 2; ++bj)
#pragma unroll
            for (int n = 0; n < 2; ++n) { const f32x4 bv = bias ? *(const f32x4*)(bias + col0 + bj * HALF + n * 16) : (f32x4){0.f, 0.f, 0.f, 0.f};
#pragma unroll
                for (int ai = 0; ai < 2; ++ai)
#pragma unroll
                    for (int m = 0; m < 4; ++m) acc[ai][bj][m][n] += bv; }
        bool bad = st1.run(acc, u, wr, wc, fr, fq, lds, wid, lane) || poison != 0u;
        const float qnan = __builtin_nanf("");
#pragma unroll
        for (int ai = 0; ai < 2; ++ai)
#pragma unroll
            for (int m = 0; m < 4; ++m) { const int r = ai * HALF + wr * 64 + m * 16 + fr; const f32x2v sr = S[r]; const size_t off = (size_t)(u.pm * BM + r) * ldc + col0;
#pragma unroll
                for (int bj = 0; bj < 2; ++bj)
#pragma unroll
                    for (int n = 0; n < 2; ++n) { const f32x4 bs = *(const f32x4*)(base + off + bj * HALF + n * 16); acc[ai][bj][m][n] = bs + (acc[ai][bj][m][n] - sr.x) * sr.y; }
                asm volatile("" : "+v"(acc[ai][0][m][0]), "+v"(acc[ai][0][m][1]), "+v"(acc[ai][1][m][0]), "+v"(acc[ai][1][m][1]));
                if (m & 1) asm volatile("" ::: "memory"); }
        const bool bad1 = bad;
        bad = st2.run(acc, u, wr, wc, fr, fq, lds, wid, lane) || bad;
#pragma unroll
        for (int ai = 0; ai < 2; ++ai)
#pragma unroll
            for (int m = 0; m < 4; ++m) { const int r = ai * HALF + wr * 64 + m * 16 + fr; const f32x2v sr = S[r]; const size_t off = (size_t)(u.pm * BM + r) * ldc + col0;
#pragma unroll
                for (int bj = 0; bj < 2; ++bj)
#pragma unroll
                    for (int n = 0; n < 2; ++n) { const f32x4 x1 = acc[ai][bj][m][n]; *(f32x4*)(out + off + bj * HALF + n * 16) = bad1 ? (f32x4){qnan, qnan, qnan, qnan} : x1;
                        const f32x4 o = (x1 - sr.x) * sr.y; u32x2v w; w.x = cvt_pk_bf16(o[0], o[1]); w.y = cvt_pk_bf16(o[2], o[3]);
                        if (bad) { w.x = 0x7fc07fc0u; w.y = 0x7fc07fc0u; } *(u32x2v*)(xn + off + bj * HALF + n * 16) = w; }
                asm volatile("" ::: "memory"); }
    }
};

template <bool F16> __device__ __forceinline__ f32x4 mma16(bf16x8 b, bf16x8 a, f32x4 c) {
    if constexpr (F16) { typedef _Float16 h8_t __attribute__((ext_vector_type(8))); return __builtin_amdgcn_mfma_f32_16x16x32_f16(__builtin_bit_cast(h8_t, b), __builtin_bit_cast(h8_t, a), c, 0, 0, 0); }
    else return __builtin_amdgcn_mfma_f32_16x16x32_bf16(b, a, c, 0, 0, 0);
}
template <class Epi, class Sched, bool ALIGN_EPI = false, bool SP2 = false, bool F16 = false>
__device__ __forceinline__ void gemm_phase(PG8_LAS unsigned char* lds, const Gemm g, const Sched& S, const Epi& E) {
#ifdef NO_GEMM
    return;
#endif
    int tid_l = threadIdx.x; asm volatile("" : "+v"(tid_l));
    const int tid = tid_l, wid = __builtin_amdgcn_readfirstlane(tid >> 6), lane = tid & 63, wr = wid >> 2, wc = wid & 3, fr = lane & 15, fq = lane >> 4;
    const int K = g.K, nt = K / BK;
    unsigned voffA[2], voffB[2];
#pragma unroll
    for (int i = 0; i < 2; ++i) { int R, C; stage_rc(tid * 16 + i * 8192, R, C); const int Rb = Epi::PERM ? ((R & ~31) + perm32(R & 31)) : R;
        voffA[i] = (unsigned)(R * K + C) * 2u; voffB[i] = (unsigned)(Rb * K + C) * 2u; }
    const size_t kstep = (size_t)(BK * 2);
    const size_t hstep = (size_t)HALF * K * 2;
    const size_t tstep = 2 * hstep;
    const unsigned ldsw = (unsigned)wid * 1024u;
    const int aoff = lds_byte(wr * 64 + fr, fq * 8), boff = lds_byte(wc * 32 + fr, fq * 8);
#define PG8_SA(b, h) (((b) * 2 + (h)) * HTB)
#define PG8_SB(b, h) ((4 + (b) * 2 + (h)) * HTB)
#define PG8_STAGE(bufoff, gbase, voff) do { _Pragma("unroll") for (int _i = 0; _i < 2; ++_i) \
        __builtin_amdgcn_global_load_lds((const unsigned*)((const char*)(gbase) + (voff)[_i]), (PG8_LAS unsigned*)(lds + (bufoff) + ldsw + _i * 8192), 16, 0, 0); } while (0)
#define PG8_LDA(dst, b, h) do { _Pragma("unroll") for (int m = 0; m < 4; ++m) _Pragma("unroll") for (int k = 0; k < 2; ++k) dst[m][k] = *(const PG8_LAS bf16x8*)(lds + PG8_SA(b, h) + aoff + m * 2048 + k * 1024); } while (0)
#define PG8_LDB(dst, b, h) do { _Pragma("unroll") for (int n = 0; n < 2; ++n) _Pragma("unroll") for (int k = 0; k < 2; ++k) dst[n][k] = *(const PG8_LAS bf16x8*)(lds + PG8_SB(b, h) + boff + n * 2048 + k * 1024); } while (0)
#define PG8_MMA(ai, bj, At, Bt) do { __builtin_amdgcn_s_setprio(1); _Pragma("unroll") for (int m = 0; m < 4; ++m) _Pragma("unroll") for (int n = 0; n < 2; ++n) _Pragma("unroll") for (int k = 0; k < 2; ++k) \
        acc[ai][bj][m][n] = mma16<F16>(Bt[n][k], At[m][k], acc[ai][bj][m][n]); __builtin_amdgcn_s_setprio(0); } while (0)
#define PG8_WAIT_V(n) asm volatile("s_waitcnt vmcnt(" #n ")" ::: "memory")
#define PG8_WAIT_L(n) asm volatile("s_waitcnt lgkmcnt(" #n ")" ::: "memory")
#define PG8_BAR __builtin_amdgcn_s_barrier()
#define PG8_SCHED __builtin_amdgcn_sched_barrier(0)
    Unit cur, nxt; int ui = 0;
    if (!S.next(0, cur)) return;
    f32x4 acc[2][2][4][2];
#pragma unroll
    for (int a = 0; a < 2; ++a)
#pragma unroll
        for (int b = 0; b < 2; ++b)
#pragma unroll
            for (int m = 0; m < 4; ++m)
#pragma unroll
                for (int n = 0; n < 2; ++n) acc[a][b][m][n] = (f32x4){0.f, 0.f, 0.f, 0.f};
    bf16x8 At[4][2], B0[2][2], B1[2][2];
    const char* cA = (const char*)g.A + (size_t)cur.pm * tstep; const char* cB = (const char*)g.Bt + (size_t)cur.pn * tstep;
    S.a_ready(cur);
    if constexpr (SP2) {
        PG8_STAGE(PG8_SB(0, 0), cB, voffB); PG8_STAGE(PG8_SB(0, 1), cB + hstep, voffB); PG8_STAGE(PG8_SA(0, 0), cA, voffA); PG8_STAGE(PG8_SA(0, 1), cA + hstep, voffA);
        if (wr == 1) PG8_BAR;
        PG8_WAIT_V(2); PG8_BAR;
        PG8_STAGE(PG8_SB(1, 0), cB + kstep, voffB); PG8_STAGE(PG8_SA(1, 0), cA + kstep, voffA); PG8_STAGE(PG8_SB(1, 1), cB + hstep + kstep, voffB);
        PG8_WAIT_V(6); PG8_BAR;
    } else {
        PG8_STAGE(PG8_SB(0, 0), cB, voffB); PG8_STAGE(PG8_SA(0, 0), cA, voffA); PG8_STAGE(PG8_SB(0, 1), cB + hstep, voffB); PG8_STAGE(PG8_SA(0, 1), cA + hstep, voffA);
        if (wr == 1) PG8_BAR;
        PG8_WAIT_V(4); PG8_BAR;
        PG8_STAGE(PG8_SB(1, 0), cB + kstep, voffB); PG8_STAGE(PG8_SA(1, 0), cA + kstep, voffA); PG8_STAGE(PG8_SB(1, 1), cB + hstep + kstep, voffB);
        PG8_WAIT_V(6); PG8_BAR;
    }
    for (;;) {
        const bool has_next = S.next(ui + 1, nxt);
        const char* nA = has_next ? (const char*)g.A + (size_t)nxt.pm * tstep : cA; const char* nB = has_next ? (const char*)g.Bt + (size_t)nxt.pn * tstep : cB;
        for (int t = 0; t < nt; t += 2) {
            const bool last = (t == nt - 2);
            const char* a1 = cA + (size_t)(t + 1) * kstep;
            const char* a2 = last ? nA : cA + (size_t)(t + 2) * kstep; const char* b2 = last ? nB : cB + (size_t)(t + 2) * kstep;
            const char* a3 = a2 + kstep; const char* b3 = b2 + kstep;
            if (last && has_next) S.a_ready(nxt);
            if constexpr (SP2) {
            PG8_LDB(B0, 0, 0); PG8_LDB(B1, 0, 1); PG8_SCHED; PG8_LDA(At, 0, 0); PG8_STAGE(PG8_SA(1, 1), a1 + hstep, voffA);
            PG8_WAIT_V(8); PG8_WAIT_L(0); PG8_BAR; PG8_MMA(0, 0, At, B0); PG8_MMA(0, 1, At, B1); PG8_BAR; PG8_SCHED;
            PG8_LDA(At, 0, 1); PG8_STAGE(PG8_SB(0, 0), b2, voffB); PG8_STAGE(PG8_SB(0, 1), b2 + hstep, voffB); PG8_STAGE(PG8_SA(0, 0), a2, voffA);
            PG8_WAIT_V(8); PG8_WAIT_L(0); PG8_BAR; PG8_MMA(1, 0, At, B0); PG8_MMA(1, 1, At, B1); PG8_BAR; PG8_SCHED;
            PG8_LDB(B0, 1, 0); PG8_LDB(B1, 1, 1); PG8_SCHED; PG8_LDA(At, 1, 0); PG8_STAGE(PG8_SA(0, 1), a2 + hstep, voffA);
            PG8_WAIT_V(8); PG8_WAIT_L(0); PG8_BAR; PG8_MMA(0, 0, At, B0); PG8_MMA(0, 1, At, B1); PG8_BAR; PG8_SCHED;
            PG8_LDA(At, 1, 1); PG8_STAGE(PG8_SB(1, 0), b3, voffB); PG8_STAGE(PG8_SB(1, 1), b3 + hstep, voffB); PG8_STAGE(PG8_SA(1, 0), a3, voffA);
            PG8_WAIT_V(8); PG8_WAIT_L(0); PG8_BAR; PG8_MMA(1, 0, At, B0); PG8_MMA(1, 1, At, B1); PG8_BAR; PG8_SCHED;
            } else {
            PG8_LDB(B0, 0, 0); PG8_SCHED; PG8_LDA(At, 0, 0); PG8_STAGE(PG8_SA(1, 1), a1 + hstep, voffA);
            PG8_WAIT_L(8); PG8_BAR; PG8_WAIT_L(0); PG8_MMA(0, 0, At, B0); PG8_BAR; PG8_SCHED;
            PG8_LDB(B1, 0, 1); PG8_STAGE(PG8_SB(0, 0), b2, voffB);
            PG8_BAR; PG8_WAIT_L(0); PG8_MMA(0, 1, At, B1); PG8_BAR;
            PG8_LDA(At, 0, 1); PG8_STAGE(PG8_SA(0, 0), a2, voffA);
            PG8_BAR; PG8_WAIT_L(0); PG8_MMA(1, 0, At, B0); PG8_BAR; PG8_SCHED;
            PG8_STAGE(PG8_SB(0, 1), b2 + hstep, voffB);
            PG8_WAIT_V(6); PG8_BAR; PG8_MMA(1, 1, At, B1); PG8_BAR;
            PG8_LDB(B0, 1, 0); PG8_SCHED; PG8_LDA(At, 1, 0); PG8_STAGE(PG8_SA(0, 1), a2 + hstep, voffA);
            PG8_WAIT_L(8); PG8_BAR; PG8_WAIT_L(0); PG8_MMA(0, 0, At, B0); PG8_BAR; PG8_SCHED;
            PG8_LDB(B1, 1, 1); PG8_STAGE(PG8_SB(1, 0), b3, voffB);
            PG8_BAR; PG8_WAIT_L(0); PG8_MMA(0, 1, At, B1); PG8_BAR;
            PG8_LDA(At, 1, 1); PG8_STAGE(PG8_SA(1, 0), a3, voffA);
            PG8_BAR; PG8_WAIT_L(0); PG8_MMA(1, 0, At, B0); PG8_BAR; PG8_SCHED;
            PG8_STAGE(PG8_SB(1, 1), b3 + hstep, voffB);
            PG8_WAIT_V(6); PG8_BAR; PG8_MMA(1, 1, At, B1); PG8_BAR;
            }
        }
        if constexpr (ALIGN_EPI) { if (wr == 0) PG8_BAR; }
        if constexpr (!Epi::AFTER_DRAIN) { E(acc, cur, wr, wc, fr, fq); S.done(cur); }
        if (!has_next) break;
#pragma unroll
        for (int a = 0; a < 2; ++a)
#pragma unroll
            for (int b = 0; b < 2; ++b)
#pragma unroll
                for (int m = 0; m < 4; ++m)
#pragma unroll
                    for (int n = 0; n < 2; ++n) acc[a][b][m][n] = (f32x4){0.f, 0.f, 0.f, 0.f};
        cur = nxt; cA = nA; cB = nB; ++ui;
        if constexpr (ALIGN_EPI) { if (wr == 1) PG8_BAR; }
    }
    PG8_WAIT_V(0);
    if constexpr (!ALIGN_EPI) { if (wr == 0) PG8_BAR; }
    PG8_BAR;
    if constexpr (Epi::AFTER_DRAIN) { E.fused(acc, cur, wr, wc, fr, fq, lds, wid, lane); S.done(cur); }
#undef PG8_SA
#undef PG8_SB
#undef PG8_STAGE
#undef PG8_LDA
#undef PG8_LDB
#undef PG8_MMA
#undef PG8_WAIT_V
#undef PG8_WAIT_L
#undef PG8_BAR
#undef PG8_SCHED
}
}

#ifndef PG8_SP2
#define PG8_SP2 true
#endif
#ifndef PG8_ALIGN
#define PG8_ALIGN true
#endif
namespace pg8 {
template <int ACT> struct EpiSplit {
    static constexpr bool PERM = true, AFTER_DRAIN = false;
    bf16_t* O; int ldc; int split_cols; size_t split_stride; int scale_t; float scale0; const float* ss;
    __device__ __forceinline__ void operator()(const f32x4 (&acc)[2][2][4][2], const Unit& u, int wr, int wc, int fr, int fq) const {
        const int row0 = u.pm * BM + wr * 64 + fr; int colt = u.pn * BM; bf16_t* base = O;
        float sc = 1.f; if (split_cols) { const int t = colt / split_cols; base += (size_t)t * split_stride; colt -= t * split_cols; if (t == scale_t) sc = scale0; }
        const int col0 = colt + wc * 32 + 8 * fq;
        float rs[2][4];
        if (ACT != 2) { f32x4 pp[2][4];
#pragma unroll
        for (int ai = 0; ai < 2; ++ai)
#pragma unroll
            for (int m = 0; m < 4; ++m) pp[ai][m] = *(const f32x4*)(ss + (size_t)(row0 + ai * HALF + m * 16) * 16 + 4 * fq);
        asm volatile("" ::: "memory");
#pragma unroll
        for (int ai = 0; ai < 2; ++ai)
#pragma unroll
            for (int m = 0; m < 4; ++m) { const f32x4 p = pp[ai][m]; float sq = (p[0] + p[1]) + (p[2] + p[3]);
                sq += __uint_as_float((unsigned)__builtin_amdgcn_ds_swizzle((int)__float_as_uint(sq), (16 << 10) | 0x1f));
                { auto rr = __builtin_amdgcn_permlane32_swap(__float_as_uint(sq), __float_as_uint(sq), false, false); sq = __uint_as_float(rr[0]) + __uint_as_float(rr[1]); }
                rs[ai][m] = __builtin_amdgcn_rsqf(sq * (1.0f / 1024.0f) + 1e-6f); } }
        else {
#pragma unroll
            for (int ai = 0; ai < 2; ++ai)
#pragma unroll
                for (int m = 0; m < 4; ++m) rs[ai][m] = 1.0f; }
#pragma unroll
        for (int ai = 0; ai < 2; ++ai)
#pragma unroll
            for (int m = 0; m < 4; ++m) { bf16_t* rowp = base + (size_t)(row0 + ai * HALF + m * 16) * ldc + col0;
#pragma unroll
                for (int bj = 0; bj < 2; ++bj) { f32x4 v0 = acc[ai][bj][m][0] * rs[ai][m], v1 = acc[ai][bj][m][1] * rs[ai][m];
                    if (ACT == 2) {
#pragma unroll
                        for (int e = 0; e < 4; ++e) { const float a = fmaxf(v0[e], 0.f), b = fmaxf(v1[e], 0.f); v0[e] = a * a; v1[e] = b * b; } }
                    v0 = v0 * sc; v1 = v1 * sc; u32x4 w; w.x = cvt_pk_bf16(v0[0], v0[1]); w.y = cvt_pk_bf16(v0[2], v0[3]); w.z = cvt_pk_bf16(v1[0], v1[1]); w.w = cvt_pk_bf16(v1[2], v1[3]);
                    *(u32x4*)(rowp + bj * HALF) = w; } }
    }
};
struct EpiOddIn {
    static constexpr bool PERM = true, AFTER_DRAIN = false;
    bf16_t *Q, *K, *V, *G; const float* ss;
    __device__ __forceinline__ void operator()(const f32x4 (&acc)[2][2][4][2], const Unit& u, int wr, int wc, int fr, int fq) const {
        const int row0 = u.pm * BM + wr * 64 + fr; const int pn = u.pn; bf16_t* base; int ldc, colt;
        if (pn < 4) { base = Q; ldc = 1024; colt = pn * BM; } else if (pn < 8) { base = K; ldc = 1024; colt = (pn - 4) * BM; }
        else if (pn < 16) { base = V; ldc = 2048; colt = (pn - 8) * BM; } else { base = G; ldc = 2048; colt = (pn - 16) * BM; }
        const int col0 = colt + wc * 32 + 8 * fq;
        float rs[2][4]; f32x4 pp[2][4];
#pragma unroll
        for (int ai = 0; ai < 2; ++ai)
#pragma unroll
            for (int m = 0; m < 4; ++m) pp[ai][m] = *(const f32x4*)(ss + (size_t)(row0 + ai * HALF + m * 16) * 16 + 4 * fq);
        asm volatile("" ::: "memory");
#pragma unroll
        for (int ai = 0; ai < 2; ++ai)
#pragma unroll
            for (int m = 0; m < 4; ++m) { const f32x4 p = pp[ai][m]; float sq = (p[0] + p[1]) + (p[2] + p[3]);
                sq += __uint_as_float((unsigned)__builtin_amdgcn_ds_swizzle((int)__float_as_uint(sq), (16 << 10) | 0x1f));
                { auto rr = __builtin_amdgcn_permlane32_swap(__float_as_uint(sq), __float_as_uint(sq), false, false); sq = __uint_as_float(rr[0]) + __uint_as_float(rr[1]); }
                rs[ai][m] = __builtin_amdgcn_rsqf(sq * (1.0f / 1024.0f) + 1e-6f); }
#pragma unroll
        for (int ai = 0; ai < 2; ++ai)
#pragma unroll
            for (int m = 0; m < 4; ++m) { bf16_t* rowp = base + (size_t)(row0 + ai * HALF + m * 16) * ldc + col0;
#pragma unroll
                for (int bj = 0; bj < 2; ++bj) { const f32x4 v0 = acc[ai][bj][m][0] * rs[ai][m], v1 = acc[ai][bj][m][1] * rs[ai][m];
                    u32x4 w; w.x = cvt_pk_bf16(v0[0], v0[1]); w.y = cvt_pk_bf16(v0[2], v0[3]); w.z = cvt_pk_bf16(v1[0], v1[1]); w.w = cvt_pk_bf16(v1[2], v1[3]);
                    *(u32x4*)(rowp + bj * HALF) = w; } }
    }
};
__device__ __forceinline__ unsigned cvt_pk_f16(float lo, float hi) { typedef _Float16 h2_t __attribute__((ext_vector_type(2))); const h2_t v = {(_Float16)lo, (_Float16)hi}; return __builtin_bit_cast(unsigned, v); }
__device__ __forceinline__ float f16lo(unsigned w) { typedef _Float16 h2_t __attribute__((ext_vector_type(2))); return (float)__builtin_bit_cast(h2_t, w)[0]; }
__device__ __forceinline__ float f16hi(unsigned w) { typedef _Float16 h2_t __attribute__((ext_vector_type(2))); return (float)__builtin_bit_cast(h2_t, w)[1]; }
#ifndef STREAM_F16
#define STREAM_F16 1
#endif
__device__ __forceinline__ unsigned st_pk(float lo, float hi) { return STREAM_F16 ? cvt_pk_f16(lo, hi) : cvt_pk_bf16(lo, hi); }
__device__ __forceinline__ float st_lo(unsigned w) { return STREAM_F16 ? f16lo(w) : __uint_as_float(w << 16); }
__device__ __forceinline__ float st_hi(unsigned w) { return STREAM_F16 ? f16hi(w) : __uint_as_float(w & 0xffff0000u); }
template <bool BASEF32> struct EpiRes {
    static constexpr bool PERM = false, AFTER_DRAIN = false;
    const float* basef; bf16_t* xb; int ldc; float* ss; const float* ss2;
    __device__ __forceinline__ void operator()(const f32x4 (&acc)[2][2][4][2], const Unit& u, int wr, int wc, int fr, int fq) const {
        typedef unsigned u32x2e __attribute__((ext_vector_type(2)));
        const int col0 = u.pn * BM + wc * 32 + 4 * fq;
#pragma unroll
        for (int ai = 0; ai < 2; ++ai)
#pragma unroll
        for (int mh = 0; mh < 2; ++mh) {
            f32x4 bs[2][2][2], pq[2]; float r2[2];
#pragma unroll
            for (int mm = 0; mm < 2; ++mm) { const int m = 2 * mh + mm; const size_t row = (size_t)(u.pm * BM + ai * HALF + wr * 64 + m * 16 + fr), off = row * ldc + col0;
                if (ss2) pq[mm] = *(const f32x4*)(ss2 + row * 16 + 4 * fq);
#pragma unroll
                for (int bj = 0; bj < 2; ++bj)
#pragma unroll
                    for (int n = 0; n < 2; ++n) {
                        if (BASEF32) bs[mm][bj][n] = *(const f32x4*)(basef + off + bj * HALF + n * 16);
                        else { const u32x2e w = *(const u32x2e*)(xb + off + bj * HALF + n * 16);
                            bs[mm][bj][n] = (f32x4){st_lo(w.x), st_hi(w.x), st_lo(w.y), st_hi(w.y)}; } } }
            asm volatile("" ::: "memory");
#pragma unroll
            for (int mm = 0; mm < 2; ++mm) { r2[mm] = 1.0f;
                if (ss2) { const f32x4 p = pq[mm]; float t = (p[0] + p[1]) + (p[2] + p[3]);
                    t += __uint_as_float((unsigned)__builtin_amdgcn_ds_swizzle((int)__float_as_uint(t), (16 << 10) | 0x1f));
                    { auto rr = __builtin_amdgcn_permlane32_swap(__float_as_uint(t), __float_as_uint(t), false, false); t = __uint_as_float(rr[0]) + __uint_as_float(rr[1]); }
                    r2[mm] = __builtin_amdgcn_rcpf(t * (1.0f / 1024.0f) + 1e-6f); } }
#pragma unroll
            for (int mm = 0; mm < 2; ++mm) { const int m = 2 * mh + mm; const size_t row = (size_t)(u.pm * BM + ai * HALF + wr * 64 + m * 16 + fr), off = row * ldc + col0;
                float sq = 0.f;
#pragma unroll
                for (int bj = 0; bj < 2; ++bj)
#pragma unroll
                    for (int n = 0; n < 2; ++n) { const f32x4 xn = bs[mm][bj][n] + acc[ai][bj][m][n] * r2[mm];
                        u32x2e w; w.x = st_pk(xn[0], xn[1]); w.y = st_pk(xn[2], xn[3]); *(u32x2e*)(xb + off + bj * HALF + n * 16) = w;
                        sq += (xn[0] * xn[0] + xn[1] * xn[1]) + (xn[2] * xn[2] + xn[3] * xn[3]); }
                sq += __uint_as_float((unsigned)__builtin_amdgcn_ds_swizzle((int)__float_as_uint(sq), (16 << 10) | 0x1f));
                { auto rr = __builtin_amdgcn_permlane32_swap(__float_as_uint(sq), __float_as_uint(sq), false, false); sq = __uint_as_float(rr[0]) + __uint_as_float(rr[1]); }
                if (fq == 0) ss[row * 16 + u.pn * 4 + wc] = sq; }
            asm volatile("" ::: "memory");
        }
    }
};
}
#include <hip/hip_bf16.h>
#include <cmath>
namespace attn_body {
using bf16=__hip_bfloat16;
using bf16x8=__attribute__((ext_vector_type(8)))short;
using s16x4=__attribute__((ext_vector_type(4)))short;
using f32x16=__attribute__((ext_vector_type(16)))float;
using u32x4=__attribute__((ext_vector_type(4)))unsigned;
constexpr int BATCH=16,NHEAD=8,SEQ=4096,D=64,DM=NHEAD*D,ODM=1024;
constexpr int NW=8,QBLK=32,QB=QBLK*NW,KVBLK=64,NQB=SEQ/QB;
constexpr int ATTN_PITCH=DM, ATTN_UNIT_ROWS=QB;
__device__ __forceinline__ int crow(int r,int hi){return (r&3)+8*(r>>2)+4*hi;}
#define SBAR() __builtin_amdgcn_sched_barrier(0)
__device__ __forceinline__ void cmask(f32x16&p0,f32x16&p1,int jb,int qrel,int hi){
  const float NEG=-INFINITY; int kb=64*jb+4*hi;
  #pragma unroll
  for(int r=0;r<16;++r){int kv=kb+(r&3)+8*(r>>2); if(kv>qrel)p0[r]=NEG; if(kv+32>qrel)p1[r]=NEG;}
}

constexpr int NSLOT=3, SLOTB=8192;
constexpr int LDS_K=0, LDS_V=NSLOT*SLOTB, LDS_WS=2*NSLOT*SLOTB, LDS_OST=LDS_WS+NW*64*4, LDS_CUM=LDS_OST+NW*4096,LDS_KN=LDS_CUM+SEQ*4,LDS_BYTES=LDS_KN+256;
constexpr float C2=0.125f*1.4426950408889634f;
__device__ __forceinline__ void glds16(const void*gsrc,unsigned lds_dst){unsigned keep;
  asm volatile("s_mov_b32 %0, m0\n\ts_mov_b32 m0, %2\n\ts_nop 0\n\tglobal_load_lds_dwordx4 %1, off\n\ts_mov_b32 m0, %0":"=&s"(keep):"v"(gsrc),"s"(lds_dst):"memory");}
__device__ __forceinline__ float max3f(float a,float b,float c){float r;asm("v_max3_f32 %0, %1, %2, %3":"=v"(r):"v"(a),"v"(b),"v"(c));return r;}
__device__ __forceinline__ float max2f(float a,float b){float r;asm("v_max_f32_e32 %0, %1, %2":"=v"(r):"v"(a),"v"(b));return r;}
__device__ __forceinline__ float fadd_s(float a,float b){float r;asm("v_add_f32_e32 %0, %1, %2":"=v"(r):"v"(a),"v"(b));return r;}
__device__ __forceinline__ float fsub_s(float a,float b){float r;asm("v_sub_f32_e32 %0, %1, %2":"=v"(r):"v"(a),"v"(b));return r;}
typedef float f32x2_t __attribute__((ext_vector_type(2))); typedef __bf16 bf16x2_t __attribute__((ext_vector_type(2)));
__device__ __forceinline__ unsigned cvtpk_s(float lo,float hi){f32x2_t v={lo,hi};bf16x2_t b=__builtin_convertvector(v,bf16x2_t);return __builtin_bit_cast(unsigned,b);}
#define WAIT_BAR(N) asm volatile("s_waitcnt vmcnt(" #N ") lgkmcnt(0)\n\ts_barrier":::"memory")

__device__ __forceinline__ void qkt(f32x16&p0,f32x16&p1,const char*Kslot,const bf16x8*qr,const f32x16&negm,int r32,int hi){
  const char*kb=Kslot+hi*1024+r32*16;
  #pragma unroll
  for(int d0=0;d0<4;++d0){
    const bf16x8 b0=*reinterpret_cast<const bf16x8*>(kb+d0*2048);
    const bf16x8 b1=*reinterpret_cast<const bf16x8*>(kb+d0*2048+512);
    if(d0==0){p0=__builtin_amdgcn_mfma_f32_32x32x16_bf16(b0,qr[0],negm,0,0,0);p1=__builtin_amdgcn_mfma_f32_32x32x16_bf16(b1,qr[0],negm,0,0,0);}
    else{p0=__builtin_amdgcn_mfma_f32_32x32x16_bf16(b0,qr[d0],p0,0,0,0);p1=__builtin_amdgcn_mfma_f32_32x32x16_bf16(b1,qr[d0],p1,0,0,0);}}
}
typedef __attribute__((address_space(3))) const char* lds_cptr;
typedef short v4i16_t __attribute__((ext_vector_type(4)));
__device__ __forceinline__ void kload8(bf16x8*kf,lds_cptr kp){
  kf[0]=*(const __attribute__((address_space(3))) bf16x8*)(kp);      kf[1]=*(const __attribute__((address_space(3))) bf16x8*)(kp+512);
  kf[2]=*(const __attribute__((address_space(3))) bf16x8*)(kp+2048); kf[3]=*(const __attribute__((address_space(3))) bf16x8*)(kp+2560);
  kf[4]=*(const __attribute__((address_space(3))) bf16x8*)(kp+4096); kf[5]=*(const __attribute__((address_space(3))) bf16x8*)(kp+4608);
  kf[6]=*(const __attribute__((address_space(3))) bf16x8*)(kp+6144); kf[7]=*(const __attribute__((address_space(3))) bf16x8*)(kp+6656);
}
__device__ __forceinline__ void kload2(bf16x8*kf,lds_cptr kp,int j){ kf[2*j]=*(const __attribute__((address_space(3))) bf16x8*)(kp+j*2048); kf[2*j+1]=*(const __attribute__((address_space(3))) bf16x8*)(kp+j*2048+512); }
__device__ __forceinline__ s16x4 vtr(lds_cptr p){ return __builtin_bit_cast(s16x4,__builtin_amdgcn_ds_read_tr16_b64_v4i16((__attribute__((address_space(3))) v4i16_t*)p)); }
__device__ __forceinline__ float rowmax(const f32x16&p0,const f32x16&p1){
  float a=max3f(p0[0],p0[1],p1[0]),b=max3f(p0[2],p0[3],p1[1]);a=max3f(a,p1[2],p1[3]);
  #pragma unroll
  for(int r=4;r<16;r+=4){a=max3f(a,p0[r],p0[r+1]);b=max3f(b,p0[r+2],p0[r+3]);a=max3f(a,p1[r],p1[r+1]);b=max3f(b,p1[r+2],p1[r+3]);}
  const float m=max2f(a,b);
  auto rr=__builtin_amdgcn_permlane32_swap(__float_as_uint(m),__float_as_uint(m),false,false);
  return max2f(__uint_as_float(rr[0]),__uint_as_float(rr[1]));
}
__device__ __forceinline__ void pv(f32x16*o,int vb,bf16x8 pa0,bf16x8 pa1,bf16x8 pa2,bf16x8 pa3){
  #pragma unroll
  for(int d0=0;d0<2;++d0){s16x4 lo[4],hi[4];
    #pragma unroll
    for(int ks=0;ks<4;++ks){
      asm volatile("ds_read_b64_tr_b16 %0,%1 offset:%c2":"=&v"(lo[ks]):"v"(vb),"i"(d0*4096+ks*1024):"memory");
      asm volatile("ds_read_b64_tr_b16 %0,%1 offset:%c2":"=&v"(hi[ks]):"v"(vb),"i"(d0*4096+ks*1024+512):"memory");}
    asm volatile("s_waitcnt lgkmcnt(0)":::"memory");SBAR();
    #define PK(k) (bf16x8){lo[k][0],lo[k][1],lo[k][2],lo[k][3],hi[k][0],hi[k][1],hi[k][2],hi[k][3]}
    o[d0]=__builtin_amdgcn_mfma_f32_32x32x16_bf16(pa0,PK(0),o[d0],0,0,0);
    o[d0]=__builtin_amdgcn_mfma_f32_32x32x16_bf16(pa1,PK(1),o[d0],0,0,0);
    o[d0]=__builtin_amdgcn_mfma_f32_32x32x16_bf16(pa2,PK(2),o[d0],0,0,0);
    o[d0]=__builtin_amdgcn_mfma_f32_32x32x16_bf16(pa3,PK(3),o[d0],0,0,0);
    #undef PK
  }
}

#ifndef ATTN_STORE16
#define ATTN_STORE16(p,v) (*(u32x4*)(p)=(v))
#endif
template<int THRL> __device__ __forceinline__ void attn_unit(int b,int h,int qb,const bf16*Q,const bf16*__restrict__ K,const bf16*__restrict__ V,bf16*O,const float*__restrict__ cum,char*shm){
  int tid_l=threadIdx.x; asm volatile("":"+v"(tid_l)); const int tid=tid_l,lane=tid&63,r32=lane&31,hi=lane>>5; const int wid=__builtin_amdgcn_readfirstlane(tid>>6);
  const long rowbase=(long)b*SEQ; const int q0=qb*QB;
  const bf16*Qw=Q+(rowbase+q0+wid*QBLK)*DM+h*D;
  const bf16*Kh=K+rowbase*DM+h*D,*Vh=V+rowbase*DM+h*D;
  bf16x8 qr[4];
  _Pragma("unroll") for(int d0=0;d0<4;++d0)qr[d0]=*reinterpret_cast<const bf16x8*>(&Qw[(long)r32*DM+d0*16+hi*8]);
  typedef float f32x4c __attribute__((ext_vector_type(4)));
  __attribute__((address_space(3))) float* cks=(__attribute__((address_space(3))) float*)((__attribute__((address_space(3))) char*)shm+LDS_CUM);
  { const int nld=q0+QB, base=tid*8; f32x4c a=(f32x4c){0.f,0.f,0.f,0.f}, b4=a; if(base<nld){ a=*(const f32x4c*)(cum+base); b4=*(const f32x4c*)(cum+base+4); }
    a[1]+=a[0]; a[2]+=a[1]; a[3]+=a[2]; b4[0]+=a[3]; b4[1]+=b4[0]; b4[2]+=b4[1]; b4[3]+=b4[2];
    float inc=b4[3];
    _Pragma("unroll") for(int o_=1;o_<64;o_<<=1){ const float t_=__uint_as_float((unsigned)__builtin_amdgcn_ds_bpermute(((lane-o_)&63)*4,(int)__float_as_uint(inc))); if(lane>=o_)inc+=t_; }
    __attribute__((address_space(3))) float* wsum=(__attribute__((address_space(3))) float*)((__attribute__((address_space(3))) char*)shm+LDS_WS);
    if(lane==63)wsum[wid]=inc;
    { float ssq=0.f; _Pragma("unroll") for(int d0=0;d0<4;++d0) _Pragma("unroll") for(int e_=0;e_<8;++e_){ const float v_=__uint_as_float(((unsigned)(unsigned short)qr[d0][e_])<<16); ssq+=v_*v_; }
      { auto rr=__builtin_amdgcn_permlane32_swap(__float_as_uint(ssq),__float_as_uint(ssq),false,false); ssq=__uint_as_float(rr[0])+__uint_as_float(rr[1]); }
      #define SWMAX_(v,x) v=__builtin_fmaxf(v,__uint_as_float((unsigned)__builtin_amdgcn_ds_swizzle((int)__float_as_uint(v),((x)<<10)|0x1f)))
      SWMAX_(ssq,1); SWMAX_(ssq,2); SWMAX_(ssq,4); SWMAX_(ssq,8); SWMAX_(ssq,16);
      if(lane==0)wsum[8+wid]=ssq; }
    asm volatile("s_waitcnt lgkmcnt(0)\n\ts_barrier":::"memory");
    float off_=inc-b4[3]; _Pragma("unroll") for(int w_=0;w_<NW;++w_){ const float t_=wsum[w_]; if(w_<wid)off_+=t_; }
    if(base<nld){ const float L2E=1.4426950408889634f; *(__attribute__((address_space(3))) f32x4c*)(cks+base)=(a+off_)*L2E; *(__attribute__((address_space(3))) f32x4c*)(cks+base+4)=(b4+off_)*L2E; }
    asm volatile("s_waitcnt lgkmcnt(0)\n\ts_barrier":::"memory"); }
  int tstart=0;
  { const __attribute__((address_space(3))) float* wq=(const __attribute__((address_space(3))) float*)((__attribute__((address_space(3))) char*)shm+LDS_WS)+8;
    const __attribute__((address_space(3))) float* KN=(const __attribute__((address_space(3))) float*)((__attribute__((address_space(3))) char*)shm+LDS_KN);
    float qm=wq[0]; _Pragma("unroll") for(int w_=1;w_<NW;++w_)qm=__builtin_fmaxf(qm,wq[w_]);
    const int NT0=(q0+QB)/KVBLK, nb=NT0-4; const float kb=__builtin_fmaxf(__builtin_fmaxf(KN[NT0-4],KN[NT0-3]),__builtin_fmaxf(KN[NT0-2],KN[NT0-1]));
    const float floor_=-__builtin_sqrtf(qm*kb)-44.f, cq0=cks[q0]; bool skip=false;
    if(lane<nb){ const float ub=__builtin_sqrtf(qm*KN[lane])+cq0-cks[64*lane+63]; skip=ub<floor_; }
    const unsigned long long m_=__ballot(skip); int pre=(int)__builtin_ctzll(~m_); pre=pre<nb?pre:nb; tstart=__builtin_amdgcn_readfirstlane(pre&~1); }
  Kh+=(long)tstart*KVBLK*DM; Vh+=(long)tstart*KVBLK*DM;
  const __attribute__((address_space(3))) float* ckt=cks+tstart*KVBLK;
  #define CKSUB(P0,P1,t) do{ const __attribute__((address_space(3))) float* ckp_=ckt+(t)*64+4*hi; \
    _Pragma("unroll") for(int rr_=0;rr_<4;++rr_){ const f32x4c a_=*(const __attribute__((address_space(3))) f32x4c*)(ckp_+8*rr_); const f32x4c b_=*(const __attribute__((address_space(3))) f32x4c*)(ckp_+32+8*rr_); \
      _Pragma("unroll") for(int e_=0;e_<4;++e_){ P0[4*rr_+e_]-=a_[e_]; P1[4*rr_+e_]-=b_[e_]; } if(rr_==1)__builtin_amdgcn_sched_barrier(0); } }while(0)
  const unsigned lds0=(unsigned)(uintptr_t)shm;
  float*wsf=(float*)(shm+LDS_WS)+wid*64;
  const bf16*ksrc=Kh+(long)lane*DM+wid*8;
  const bf16*vsrc=Vh+(long)(16*(wid&3)+(lane>>2))*DM+(wid>>2)*32+(lane&3)*8;
  const unsigned kdst=lds0+LDS_K+wid*1024, vdst=lds0+LDS_V+wid*1024;
  #define DMA_K(t,slot) glds16(ksrc+(long)(t)*KVBLK*DM,(unsigned)__builtin_amdgcn_readfirstlane(kdst+(slot)))
  #define DMA_V(t,slot) glds16(vsrc+(long)(t)*KVBLK*DM,(unsigned)__builtin_amdgcn_readfirstlane(vdst+(slot)))
  const int vb0=(int)(lds0+LDS_V)+((lane>>4)&1)*32+(lane&3)*8+(4*hi+((lane&15)>>2))*64;
  const char*Kbase=shm+LDS_K; bf16x8 kf[8];
  const lds_cptr shm3=(lds_cptr)shm; const lds_cptr kp0=shm3+LDS_K+hi*1024+r32*16; const lds_cptr vp0=shm3+LDS_V+((lane>>4)&1)*32+(lane&3)*8+(4*hi+((lane&15)>>2))*64;
  const int NT=(q0+QB)/KVBLK-tstart;
  DMA_K(0,0);DMA_V(0,0);DMA_K(1,SLOTB);
  float mhat=-cks[q0+wid*QBLK+r32],l_reg=0.f;f32x16 o[2];o[0]=f32x16{};o[1]=f32x16{};f32x16 negm; _Pragma("unroll") for(int r=0;r<16;++r)negm[r]=-mhat; asm volatile("":"+v"(negm));
  const int qrel=wid*QBLK+r32;
  #define CMASK(P0,P1,t) do{int jb_=(t)-(NT-4); if(jb_>=0)cmask(P0,P1,jb_,qrel,hi);}while(0)
  bool resc=false;
  #define START(P0,P1) do{ const float rm=rowmax(P0,P1); resc=false; \
    { const float dl=rm; mhat=fadd_s(mhat,dl); \
      _Pragma("unroll") for(int r=0;r<16;++r){P0[r]=fsub_s(P0[r],dl);P1[r]=fsub_s(P1[r],dl);} \
      _Pragma("unroll") for(int r=0;r<16;++r)negm[r]=-mhat; asm volatile("":"+v"(negm)); } \
    _Pragma("unroll") for(int r=0;r<16;++r)P0[r]=__builtin_amdgcn_exp2f(P0[r]); }while(0)
  #define RESC() do{ if(resc){ asm volatile("s_waitcnt lgkmcnt(0)":::"memory"); \
      _Pragma("unroll") for(int d_=0;d_<2;++d_) _Pragma("unroll") for(int r=0;r<16;++r)o[d_][r]*=wsf[crow(r,hi)]; } }while(0)
  f32x16 pA0,pA1,pB0,pB1;
  int sl_prev=0,sl_cur=0,sl_next=SLOTB;
  #define ROT() do{sl_prev=sl_cur;sl_cur=sl_next;sl_next=(sl_next==(NSLOT-1)*SLOTB)?0:sl_next+SLOTB;}while(0)
  DMA_K(2,2*SLOTB);
  WAIT_BAR(3);
  qkt(pA0,pA1,Kbase,qr,negm,r32,hi);asm volatile("s_nop 15\n\ts_nop 7":"+v"(pA0),"+v"(pA1));CKSUB(pA0,pA1,0);CMASK(pA0,pA1,0);
  START(pA0,pA1);
  _Pragma("unroll") for(int r=0;r<16;++r)pA1[r]=__builtin_amdgcn_exp2f(pA1[r]);
  WAIT_BAR(0);
  DMA_K(3,0);DMA_V(1,SLOTB);
  ROT();
  kload8(kf,kp0+sl_cur);
  WAIT_BAR(2);
  s16x4 vlo[8],vhi[8]; u32x4 pw0,pw1,pw2,pw3;
  #define PKW(P,B) cvtpk_s(P[B],P[B+1])
  #define PAF(k) __builtin_bit_cast(bf16x8,pw##k)
  #define VFR(i) (bf16x8){vlo[i][0],vlo[i][1],vlo[i][2],vlo[i][3],vhi[i][0],vhi[i][1],vhi[i][2],vhi[i][3]}
  #define PIN(x) asm volatile("":"+v"(x))
  #define MX3(a,b,c) __builtin_fmaxf(__builtin_fmaxf((a),(b)),(c))
  #define GAPA(MF,A0,A1,A2,A3,W0,W1,PW) do{ MF; sacc+=A0; sacc+=A1; sacc+=A2; sacc+=A3; PIN(sacc); W0; W1; PIN(PW); SBAR(); }while(0)
  #define EX(v) __builtin_amdgcn_exp2f(v)
  #define GAPB(MF,X,B) do{ MF; X[B]=EX(X[B]); X[B+1]=EX(X[B+1]); X[B+2]=EX(X[B+2]); X[B+3]=EX(X[B+3]); PIN(X); SBAR(); }while(0)
  #define VRD(i) do{ vlo[i]=vtr(vp_+(((i)>>2)*4096+((i)&3)*1024)); vhi[i]=vtr(vp_+(((i)>>2)*4096+((i)&3)*1024+512)); }while(0)
  #define KRD(G,j) do{ if(G){ kload2(kf,kp0+sl_next,j); SBAR(); } }while(0)
  #define STEP(C0,C1,P0,P1,t,GK,GV,GL) do{ SBAR(); \
    const lds_cptr vp_=vp0+sl_prev; \
    VRD(0); SBAR(); float sacc=(P0[0]+P0[1]); \
    GAPA(C0=__builtin_amdgcn_mfma_f32_32x32x16_bf16(kf[0],qr[0],negm,0,0,0), P0[2],P0[3],P0[4],P0[5],     pw0[0]=PKW(P0,0), pw0[1]=PKW(P0,2), pw0); \
    VRD(4); SBAR(); GAPA(C1=__builtin_amdgcn_mfma_f32_32x32x16_bf16(kf[1],qr[0],negm,0,0,0), P0[6],P0[7],P0[8],P0[9],     pw0[2]=PKW(P0,4), pw0[3]=PKW(P0,6), pw0); \
    VRD(1); SBAR(); GAPA(C0=__builtin_amdgcn_mfma_f32_32x32x16_bf16(kf[2],qr[1],C0,0,0,0),   P0[10],P0[11],P0[12],P0[13], pw1[0]=PKW(P0,8), pw1[1]=PKW(P0,10), pw1); \
    VRD(5); SBAR(); GAPA(C1=__builtin_amdgcn_mfma_f32_32x32x16_bf16(kf[3],qr[1],C1,0,0,0),   P0[14],P0[15],P1[0],P1[1],   pw1[2]=PKW(P0,12),pw1[3]=PKW(P0,14), pw1); \
    VRD(2); SBAR(); GAPA(C0=__builtin_amdgcn_mfma_f32_32x32x16_bf16(kf[4],qr[2],C0,0,0,0),   P1[2],P1[3],P1[4],P1[5],     pw2[0]=PKW(P1,0), pw2[1]=PKW(P1,2), pw2); \
    VRD(6); SBAR(); GAPA(C1=__builtin_amdgcn_mfma_f32_32x32x16_bf16(kf[5],qr[2],C1,0,0,0),   P1[6],P1[7],P1[8],P1[9],     pw2[2]=PKW(P1,4), pw2[3]=PKW(P1,6), pw2); \
    VRD(3); SBAR(); GAPA(C0=__builtin_amdgcn_mfma_f32_32x32x16_bf16(kf[6],qr[3],C0,0,0,0),   P1[10],P1[11],P1[12],P1[13], pw3[0]=PKW(P1,8), pw3[1]=PKW(P1,10), pw3); \
    VRD(7); SBAR(); GAPA(C1=__builtin_amdgcn_mfma_f32_32x32x16_bf16(kf[7],qr[3],C1,0,0,0),   P1[14],P1[15],0.f,0.f,       pw3[2]=PKW(P1,12),pw3[3]=PKW(P1,14), pw3); \
    l_reg+=sacc; \
    if(GK){DMA_K((t)+3,sl_cur);} if(GV){DMA_V((t)+1,sl_next);} \
    CKSUB(C0,C1,t); CMASK(C0,C1,t); \
    { float a=MX3(C0[0],C0[1],C1[0]),b=MX3(C0[2],C0[3],C1[1]); a=MX3(a,C1[2],C1[3]); \
      _Pragma("unroll") for(int r=4;r<16;r+=4){a=MX3(a,C0[r],C0[r+1]);b=MX3(b,C0[r+2],C0[r+3]);a=MX3(a,C1[r],C1[r+1]);b=MX3(b,C1[r+2],C1[r+3]);} \
      float rm=__builtin_fmaxf(a,b); { auto rr=__builtin_amdgcn_permlane32_swap(__float_as_uint(rm),__float_as_uint(rm),false,false); rm=__builtin_fmaxf(__uint_as_float(rr[0]),__uint_as_float(rr[1])); } \
      resc=false; \
      if(__builtin_expect(__any(rm>(float)THRL),0)){ const float dl=__builtin_fmaxf(rm,0.f); mhat+=dl; \
        _Pragma("unroll") for(int r=0;r<16;++r){C0[r]-=dl;C1[r]-=dl;} \
        _Pragma("unroll") for(int r=0;r<16;++r)negm[r]=-mhat; asm volatile("":"+v"(negm)); \
        const float f=__builtin_amdgcn_exp2f(-dl); l_reg*=f; if(hi==0)wsf[r32]=f; resc=true; } } \
    SBAR(); \
    GAPB(o[0]=__builtin_amdgcn_mfma_f32_32x32x16_bf16(PAF(0),VFR(0),o[0],0,0,0), C0,0); \
    GAPB(o[1]=__builtin_amdgcn_mfma_f32_32x32x16_bf16(PAF(0),VFR(4),o[1],0,0,0), C0,4); \
    KRD(GL,0); GAPB(o[0]=__builtin_amdgcn_mfma_f32_32x32x16_bf16(PAF(1),VFR(1),o[0],0,0,0), C0,8); \
    KRD(GL,1); GAPB(o[1]=__builtin_amdgcn_mfma_f32_32x32x16_bf16(PAF(1),VFR(5),o[1],0,0,0), C0,12); \
    KRD(GL,2); GAPB(o[0]=__builtin_amdgcn_mfma_f32_32x32x16_bf16(PAF(2),VFR(2),o[0],0,0,0), C1,0); \
    KRD(GL,3); GAPB(o[1]=__builtin_amdgcn_mfma_f32_32x32x16_bf16(PAF(2),VFR(6),o[1],0,0,0), C1,4); \
    GAPB(o[0]=__builtin_amdgcn_mfma_f32_32x32x16_bf16(PAF(3),VFR(3),o[0],0,0,0), C1,8); \
    GAPB(o[1]=__builtin_amdgcn_mfma_f32_32x32x16_bf16(PAF(3),VFR(7),o[1],0,0,0), C1,12); \
    }while(0)
  int t=1;
  #undef CMASK
  #define CMASK(P0,P1,t) do{}while(0)
  for(;t+5<NT;t+=2){
    STEP(pB0,pB1,pA0,pA1,t,true,true,true);     WAIT_BAR(2); RESC(); ROT();
    STEP(pA0,pA1,pB0,pB1,t+1,true,true,true);   WAIT_BAR(2); RESC(); ROT();
  }
  #undef CMASK
  #define CMASK(P0,P1,t) do{int jb_=(t)-(NT-4); if(jb_>=0)cmask(P0,P1,jb_,qrel,hi);}while(0)
  #define ENDW(tt) do{ if((tt)+3<NT){WAIT_BAR(2);} else if((tt)+2<NT){WAIT_BAR(1);} else {WAIT_BAR(0);} }while(0)
  for(;t+1<NT;t+=2){
    STEP(pB0,pB1,pA0,pA1,t,(t+3<NT),(t+1<NT),(t+1<NT));       ENDW(t);   RESC(); ROT();
    STEP(pA0,pA1,pB0,pB1,t+1,(t+4<NT),(t+2<NT),(t+2<NT));     ENDW(t+1); RESC(); ROT();
  }
  STEP(pB0,pB1,pA0,pA1,NT-1,false,false,false); RESC();
  { float sacc=pB0[0]+pB0[1]; _Pragma("unroll") for(int r=2;r<16;++r)sacc+=pB0[r]; _Pragma("unroll") for(int r=0;r<16;++r)sacc+=pB1[r]; l_reg+=sacc;
    pw0=(u32x4){PKW(pB0,0),PKW(pB0,2),PKW(pB0,4),PKW(pB0,6)};pw1=(u32x4){PKW(pB0,8),PKW(pB0,10),PKW(pB0,12),PKW(pB0,14)};pw2=(u32x4){PKW(pB1,0),PKW(pB1,2),PKW(pB1,4),PKW(pB1,6)};pw3=(u32x4){PKW(pB1,8),PKW(pB1,10),PKW(pB1,12),PKW(pB1,14)};
    SBAR(); pv(o,vb0+sl_cur,PAF(0),PAF(1),PAF(2),PAF(3)); }
  #undef PKW
  #undef PAF
  #undef VFR
  #undef PIN
  #undef MX3
  #undef GAPA
  #undef GAPB
  #undef EX
  #undef VRD
  #undef KRD
  #undef STEP
  #undef ENDW
  {auto rr=__builtin_amdgcn_permlane32_swap(__float_as_uint(l_reg),__float_as_uint(l_reg),false,false);l_reg=__uint_as_float(rr[0])+__uint_as_float(rr[1]);}
  if(hi==0)wsf[32+r32]=l_reg;asm volatile("s_waitcnt lgkmcnt(0)":::"memory");
  float rli[16];
  #pragma unroll
  for(int r=0;r<16;++r)rli[r]=__builtin_amdgcn_rcpf(wsf[32+crow(r,hi)]);
  bf16*Ow=O+(rowbase+q0+wid*QBLK)*ODM+h*D;
  { bf16*stg=(bf16*)(shm+LDS_OST)+wid*2048;
    #pragma unroll
    for(int r=0;r<16;++r){const int orow=crow(r,hi);
      #pragma unroll
      for(int d0=0;d0<2;++d0)stg[orow*64+d0*32+r32]=__float2bfloat16(o[d0][r]*rli[r]);}
    asm volatile("s_waitcnt lgkmcnt(0)":::"memory");
    #pragma unroll
    for(int i=0;i<4;++i){const int row=i*8+(lane>>3),ch=lane&7; const u32x4 v=*(const u32x4*)(stg+row*64+ch*8); ATTN_STORE16(Ow+(long)row*ODM+ch*8,v);} }
  asm volatile("s_waitcnt lgkmcnt(0)\n\ts_barrier":::"memory");
  #undef CKSUB
  #undef DMA_K
  #undef DMA_V
  #undef CMASK
  #undef START
  #undef RESC
  #undef ROT
}
constexpr int ATTN_LDS_BYTES=LDS_BYTES;
struct AttnTensors { const bf16* Q; const bf16* K; const bf16* V; bf16* O; const float* CUM; };
struct AttnUnit { int bh; int qb; };
struct StaticOrder {
  int vcu;
  __device__ __forceinline__ explicit StaticOrder(int grid,int block):vcu((block%8)*(grid/8)+block/8){}
  __device__ __forceinline__ bool next(int i,AttnUnit&u)const{ if(i>=8)return false; const int s=vcu&1; u.bh=vcu>>1; const int j=7-i; u.qb=4*(j>>1)+(s==0?((j&1)?3:0):((j&1)?2:1)); return true; }
  __device__ __forceinline__ void a_ready(const AttnUnit&)const{}
  __device__ __forceinline__ void done(const AttnUnit&)const{}
};
__device__ __forceinline__ void kn_table(const bf16*K,int bh,char*shm){
  int tid_l=threadIdx.x; asm volatile("":"+v"(tid_l)); const int tid=tid_l,lane=tid&63; const bf16*kp=K+((long)(bh/NHEAD)*SEQ+8*tid)*DM+(bh%NHEAD)*D; float mx=0.f;
  _Pragma("unroll 2") for(int r=0;r<8;++r){ float ssq=0.f;
    _Pragma("unroll") for(int c=0;c<8;++c){ const u32x4 w=*reinterpret_cast<const u32x4*>(kp+(long)r*DM+c*8);
      _Pragma("unroll") for(int e_=0;e_<4;++e_){ const float lo_=__uint_as_float(w[e_]<<16), hi_=__uint_as_float(w[e_]&0xffff0000u); ssq+=lo_*lo_+hi_*hi_; } }
    mx=__builtin_fmaxf(mx,ssq); }
  #define SWMAXK_(v,x) v=__builtin_fmaxf(v,__uint_as_float((unsigned)__builtin_amdgcn_ds_swizzle((int)__float_as_uint(v),((x)<<10)|0x1f)))
  SWMAXK_(mx,1); SWMAXK_(mx,2); SWMAXK_(mx,4);
  if((lane&7)==0) ((__attribute__((address_space(3))) float*)((__attribute__((address_space(3))) char*)shm+LDS_KN))[tid>>3]=mx;
  asm volatile("s_waitcnt lgkmcnt(0)\n\ts_barrier":::"memory");
}
template<class Sched,int THRL=8> __device__ __forceinline__ void attn_phase(char*lds,const AttnTensors&T,const Sched&S){
  AttnUnit u;
  if(S.next(0,u)) kn_table(T.K,u.bh,lds);
  for(int i=0;S.next(i,u);++i){ S.a_ready(u); attn_unit<THRL>(u.bh/NHEAD,u.bh%NHEAD,u.qb,T.Q,T.K,T.V,T.O,T.CUM+(size_t)u.bh*SEQ,lds); S.done(u); }
}
#undef SBAR
#undef WAIT_BAR
}
#include <hip/hip_cooperative_groups.h>
namespace cg = cooperative_groups;
#define LAS __attribute__((address_space(3)))
typedef unsigned short bf16;
typedef unsigned v4u __attribute__((ext_vector_type(4)));
typedef unsigned v2u __attribute__((ext_vector_type(2)));
typedef float f32x4 __attribute__((ext_vector_type(4)));
typedef float f32x16 __attribute__((ext_vector_type(16)));
typedef short bf16x8 __attribute__((ext_vector_type(8)));
typedef short s16x4 __attribute__((ext_vector_type(4)));

constexpr int NWAVES = 8;
#ifndef EPIRES_ALIGN
#define EPIRES_ALIGN true
#endif
#ifndef PROBE_DOUBLE
#define PROBE_DOUBLE 0
#endif
constexpr int BATCH = 16, SEQ = 4096, DM = 1024, M = BATCH * SEQ, FF = 4096, DEPTH = 4;
constexpr int EVEN_IN = 3080, EVEN_N = 3072, ODD_IN = 6144;
constexpr float RMS_EPS = 1e-6f, GN_EPS = 1e-6f, LOG2E = 1.4426950408889634f;
constexpr size_t MiB = 1u << 20;
constexpr size_t WS_EIN = 1 * MiB, WS_EOUT = WS_EIN + 12 * MiB, WS_OIN = WS_EOUT + 4 * MiB, WS_OOUT = WS_OIN + 24 * MiB, WS_F1 = WS_OOUT + 8 * MiB, WS_F2 = WS_F1 + 32 * MiB;
constexpr size_t WS_LOGF = WS_F2 + 32 * MiB, WS_CUM = WS_LOGF + 2 * MiB, WS_LSE = WS_CUM + 2 * MiB, WS_XN = 124 * MiB, WS_ACT = 252 * MiB, WS_END = 1024 * MiB;
static_assert(WS_LSE + 6 * MiB <= WS_XN, "ws map");
constexpr size_t SEG = 64 * MiB, WS_OG = WS_ACT + 6 * SEG, WS_AO = WS_OG + 3 * SEG;
static_assert(WS_AO + 128 * MiB <= WS_END, "ws map even");
constexpr size_t WS_RQ = WS_ACT, WS_RK = WS_RQ + 128 * MiB, WS_RV = WS_RK + 128 * MiB, WS_RG = WS_RV + 256 * MiB;
static_assert(WS_RG + 256 * MiB <= WS_END, "ws map odd");
constexpr size_t WS_H = WS_ACT;
constexpr int LDS_BYTES = 147456;

__device__ __forceinline__ unsigned f2bf(float f) { unsigned u = __builtin_bit_cast(unsigned, f); return (u + 0x7fffu + ((u >> 16) & 1u)) >> 16; }
__device__ __forceinline__ unsigned pk2(float lo, float hi) { return attn_body::cvtpk_s(lo, hi); }
__device__ __forceinline__ unsigned pkh2(float lo, float hi) { return pg8::st_pk(lo, hi); }
__device__ __forceinline__ float bf2f(unsigned short b) { return __builtin_bit_cast(float, (unsigned)b << 16); }
__device__ __forceinline__ float xor32f(float v) { auto rr = __builtin_amdgcn_permlane32_swap(__float_as_uint(v), __float_as_uint(v), false, false); return __uint_as_float((threadIdx.x & 32) ? rr[0] : rr[1]); }
#define SWZ(v, x) __uint_as_float((unsigned)__builtin_amdgcn_ds_swizzle((int)__float_as_uint(v), ((x) << 10) | 0x1f))
__device__ __forceinline__ float wave_sum(float v) {
    v += SWZ(v, 1); v += SWZ(v, 2); v += SWZ(v, 4); v += SWZ(v, 8); v += SWZ(v, 16);
    auto rr = __builtin_amdgcn_permlane32_swap(__float_as_uint(v), __float_as_uint(v), false, false);
    return __uint_as_float(rr[0]) + __uint_as_float(rr[1]);
}
__device__ __forceinline__ int crow(int r, int hi) { return (r & 3) + 8 * (r >> 2) + 4 * hi; }
__device__ __forceinline__ s16x4 trrd(const LAS unsigned char* p) { typedef short v4i16_t __attribute__((ext_vector_type(4))); return __builtin_bit_cast(s16x4, __builtin_amdgcn_ds_read_tr16_b64_v4i16((LAS v4i16_t*)p)); }
#define CAT8(lo, hi) (bf16x8){lo[0], lo[1], lo[2], lo[3], hi[0], hi[1], hi[2], hi[3]}
#define LBAR() asm volatile("s_waitcnt lgkmcnt(0)\n\ts_barrier" ::: "memory")
#define MFMA32(a, b, c) __builtin_amdgcn_mfma_f32_32x32x16_bf16((a), (b), (c), 0, 0, 0)

__device__ __forceinline__ void p0_transpose_item(const float* W, int K, int N, int ldw, bf16* WT, LAS float* scr, int item, int lane, const float* gk = nullptr, bool f16 = false) {
    const int nblk = N / 32, kb = item / nblk, nb = item % nblk, k0 = 64 * kb, n0 = 32 * nb;
#pragma unroll
    for (int i = 0; i < 8; ++i) { const int idx = lane + 64 * i, kk = idx >> 3, c4 = idx & 7;
        f32x4 v = *(const f32x4*)(W + (size_t)(k0 + kk) * ldw + n0 + 4 * c4); if (gk) v = v * gk[k0 + kk];
        LAS float* d = scr + kk * 33 + 4 * c4; d[0] = v.x; d[1] = v.y; d[2] = v.z; d[3] = v.w; }
    asm volatile("s_waitcnt lgkmcnt(0)" ::: "memory");
    const int c = lane & 7;
#pragma unroll
    for (int j = 0; j < 4; ++j) { const int n = (lane >> 3) + 8 * j; const LAS float* s = scr + (8 * c) * 33 + n;
        v4u o; if (f16) { o.x = pkh2(s[0 * 33], s[1 * 33]); o.y = pkh2(s[2 * 33], s[3 * 33]); o.z = pkh2(s[4 * 33], s[5 * 33]); o.w = pkh2(s[6 * 33], s[7 * 33]); }
        else { o.x = pk2(s[0 * 33], s[1 * 33]); o.y = pk2(s[2 * 33], s[3 * 33]); o.z = pk2(s[4 * 33], s[5 * 33]); o.w = pk2(s[6 * 33], s[7 * 33]); }
        *(v4u*)(WT + (size_t)(n0 + n) * K + k0 + 8 * c) = o; }
    asm volatile("s_waitcnt lgkmcnt(0)" ::: "memory");
}
struct Ins { const float *x, *gmix, *gffn, *ewin, *ebf, *ewout, *owin, *owout, *f1, *f2, *gfin; };
__device__ __forceinline__ void p0_prologue(const Ins& in, unsigned char* ws, LAS unsigned char* lds, int gw, int NGW, int wave, int lane) {
    LAS float* scr = (LAS float*)(lds + wave * 16384);
    constexpr int I_EIN = 16 * 96, I_EOUT = 16 * 32, I_OIN = 16 * 192, I_OOUT = 32 * 32, I_F1 = 16 * 128, I_F2 = 64 * 32;
    constexpr int NITEMS = 2 * (I_EIN + I_EOUT + I_OIN + I_OOUT) + 4 * (I_F1 + I_F2);
    for (int it = gw; it < NITEMS; it += NGW) {
        int r = it;
        if (r < 2 * I_EIN) { const int i = r / I_EIN; p0_transpose_item(in.ewin + (size_t)i * DM * EVEN_IN, DM, EVEN_N, EVEN_IN, (bf16*)(ws + WS_EIN) + (size_t)i * EVEN_N * DM, scr, r % I_EIN, lane, in.gmix + (2 * i) * DM, STREAM_F16 != 0); continue; } r -= 2 * I_EIN;
        if (r < 2 * I_EOUT) { const int i = r / I_EOUT; p0_transpose_item(in.ewout + (size_t)i * DM * DM, DM, DM, DM, (bf16*)(ws + WS_EOUT) + (size_t)i * DM * DM, scr, r % I_EOUT, lane); continue; } r -= 2 * I_EOUT;
        if (r < 2 * I_OIN) { const int i = r / I_OIN; p0_transpose_item(in.owin + (size_t)i * DM * ODD_IN, DM, ODD_IN, ODD_IN, (bf16*)(ws + WS_OIN) + (size_t)i * ODD_IN * DM, scr, r % I_OIN, lane, in.gmix + (2 * i + 1) * DM, STREAM_F16 != 0); continue; } r -= 2 * I_OIN;
        if (r < 2 * I_OOUT) { const int i = r / I_OOUT; p0_transpose_item(in.owout + (size_t)i * 2 * DM * DM, 2 * DM, DM, DM, (bf16*)(ws + WS_OOUT) + (size_t)i * 2 * DM * DM, scr, r % I_OOUT, lane); continue; } r -= 2 * I_OOUT;
        if (r < 4 * I_F1) { const int i = r / I_F1; p0_transpose_item(in.f1 + (size_t)i * DM * FF, DM, FF, FF, (bf16*)(ws + WS_F1) + (size_t)i * FF * DM, scr, r % I_F1, lane, in.gffn + i * DM, STREAM_F16 != 0); continue; } r -= 4 * I_F1;
        { const int i = r / I_F2; p0_transpose_item(in.f2 + (size_t)i * FF * DM, FF, DM, DM, (bf16*)(ws + WS_F2) + (size_t)i * FF * DM, scr, r % I_F2, lane); }
    }
}

template <bool FIRST> __device__ __forceinline__ void gate_pass(const float* x, bf16* XB, float* SS, const float* g, const float* Wf  , const float* bfp, float* LOGF,
                                                               LAS unsigned char* lds, int gw, int NGW, int tid, int lane) {
    LAS float* wt = (LAS float*)lds;
    for (int idx = tid; idx < 8192; idx += NWAVES * 64) { const int k = idx >> 3, j = idx & 7; wt[j * 1024 + k] = Wf[(size_t)k * EVEN_IN + j] * g[k]; }
    __syncthreads();
    for (int m = gw; m < M; m += NGW) {
        f32x4 v[4]; float rstd;
        if (FIRST) { const f32x4* xr = (const f32x4*)(x + (size_t)m * DM) + lane; float s = 0.f;
#pragma unroll
            for (int j = 0; j < 4; ++j) { v[j] = xr[64 * j]; s += (v[j].x * v[j].x + v[j].y * v[j].y) + (v[j].z * v[j].z + v[j].w * v[j].w); }
            s = wave_sum(s); rstd = __builtin_amdgcn_rsqf(s * (1.f / DM) + RMS_EPS); if (lane < 16) SS[(size_t)m * 16 + lane] = (lane == 0) ? s : 0.f;
            v2u* o8 = (v2u*)(XB + (size_t)m * DM) + lane;
#pragma unroll
            for (int j = 0; j < 4; ++j) { v2u w; w.x = pkh2(v[j].x, v[j].y); w.y = pkh2(v[j].z, v[j].w); o8[64 * j] = w; }
        } else { const v2u* xr = (const v2u*)(XB + (size_t)m * DM) + lane;
#pragma unroll
            for (int j = 0; j < 4; ++j) { const v2u w = xr[64 * j]; v[j].x = pg8::st_lo(w.x); v[j].y = pg8::st_hi(w.x); v[j].z = pg8::st_lo(w.y); v[j].w = pg8::st_hi(w.y); }
            rstd = __builtin_amdgcn_rsqf(wave_sum((lane < 16) ? SS[(size_t)m * 16 + lane] : 0.f) * (1.f / DM) + RMS_EPS); }
        float mine = 0.f;
#pragma unroll
        for (int jj = 0; jj < 8; ++jj) { float d = 0.f;
#pragma unroll
            for (int j = 0; j < 4; ++j) { const f32x4 w = *((const LAS f32x4*)(wt + jj * 1024) + lane + 64 * j); d += (v[j].x * w.x + v[j].y * w.y) + (v[j].z * w.z + v[j].w * w.w); }
            d = wave_sum(d); if (lane == jj) mine = d; }
        if (lane < 8) { const float u = mine * rstd + bfp[lane]; LOGF[((size_t)(m >> 12) * 8 + lane) * SEQ + (m & (SEQ - 1))] = fminf(u, 0.f) - __logf(1.0f + __expf(-fabsf(u))); }
    }
    __syncthreads();
}

#define XB_TMO      128
#define XB_XCNT(j)  (256  + 64 * (j))
#define XB_XSUB(j)  (1280 + 64 * (j))
#define XB_XGEN(j)  (2304 + 64 * (j))
#define XB_TOP      3328
#define XB_TOPGEN   3392
#define XCD_BAR_WORDS 3456
#define XB_SPIN_CAP (1u << 18)

__device__ __forceinline__ unsigned xb_ld(unsigned* p)              { return __hip_atomic_load(p, __ATOMIC_RELAXED, __HIP_MEMORY_SCOPE_AGENT); }
__device__ __forceinline__ unsigned xb_add(unsigned* p, unsigned v) { return __hip_atomic_fetch_add(p, v, __ATOMIC_RELAXED, __HIP_MEMORY_SCOPE_AGENT); }
__device__ __forceinline__ unsigned xb_xcc_id() { return (unsigned)__builtin_amdgcn_s_getreg((3 << 11) | 20) & 0xFu; }
#define XB_SPIN(cond, bar) do { unsigned _sp = 0; while (cond) { __builtin_amdgcn_s_sleep(1); \
    if ((++_sp & 255u) == 0u) { if (xb_ld(&(bar)[XB_TMO])) break; if (_sp > XB_SPIN_CAP) { atomicAdd(&(bar)[XB_TMO], 1u); break; } } } } while (0)

struct XcdBarrier {
    unsigned* bar; unsigned x;
    volatile LAS unsigned* st;
};

__device__ __forceinline__ XcdBarrier xcd_barrier_post(unsigned* bar, volatile LAS unsigned* st) {
    XcdBarrier b; b.bar = bar; b.x = xb_xcc_id(); b.st = st;
    if (threadIdx.x == 0) (void)xb_add(&bar[XB_XCNT(b.x)], 1u);
    return b;
}
__device__ __forceinline__ void xcd_barrier_complete(unsigned* bar, unsigned x, unsigned& nloc, unsigned& nx) {
    const unsigned G = gridDim.x * gridDim.y * gridDim.z;
    unsigned sum, cnt, mine, sp = 0u;
    for (;;) {
        sum = 0u; cnt = 0u; mine = 0u;
#pragma unroll
        for (unsigned j = 0; j < 16; ++j) { const unsigned c = xb_ld(&bar[XB_XCNT(j)]); sum += c; cnt += (c > 0u) ? 1u : 0u; mine = (j == x) ? c : mine; }
        if (sum == G) break;
        __builtin_amdgcn_s_sleep(1);
        if ((++sp & 255u) == 0u) { if (xb_ld(&bar[XB_TMO])) break; if (sp > XB_SPIN_CAP) { atomicAdd(&bar[XB_TMO], 1u); break; } }
    }
    nloc = mine > 0u ? mine : 1u; nx = cnt > 0u ? cnt : 1u;
}

__device__ __forceinline__ void xcd_barrier(const XcdBarrier& b) {
    asm volatile("s_waitcnt vmcnt(0)" ::: "memory");
    __syncthreads();
    if (threadIdx.x == 0) {
        unsigned* bar = b.bar;
        __builtin_amdgcn_s_waitcnt(0);
        unsigned nloc = b.st[0], nx = b.st[1];
        unsigned bxx = b.x; asm volatile("" : "+s"(bxx));
        if (nloc == 0u) { xcd_barrier_complete(bar, bxx, nloc, nx); b.st[0] = nloc; b.st[1] = nx; }
        const unsigned old = xb_add(&bar[XB_XSUB(bxx)], 1u);
        const unsigned gen = old / nloc;
        if (old + 1u == (gen + 1u) * nloc) {
            __builtin_amdgcn_fence(__ATOMIC_RELEASE, "agent");
            asm volatile("s_waitcnt vmcnt(0)" ::: "memory");
            const unsigned og = xb_add(&bar[XB_TOP], 1u);
            const unsigned tg = og / nx;
            if (og + 1u == (tg + 1u) * nx) xb_add(&bar[XB_TOPGEN], 1u);
            else XB_SPIN(xb_ld(&bar[XB_TOPGEN]) == tg, bar);
            __builtin_amdgcn_fence(__ATOMIC_ACQUIRE, "agent");
            xb_add(&bar[XB_XGEN(bxx)], 1u);
            asm volatile("s_waitcnt vmcnt(0)" ::: "memory");
        } else {
            XB_SPIN(xb_ld(&bar[XB_XGEN(bxx)]) == gen, bar);
            __builtin_amdgcn_fence(__ATOMIC_ACQUIRE, "agent");
            asm volatile("s_waitcnt vmcnt(0)" ::: "memory");
        }
    }
    __syncthreads();
}

namespace dil {
constexpr int LK = 0, LV = 384 * 128, LSCR = LV + 384 * 144, LTOT = LSCR + NWAVES * 256;
static_assert(LTOT <= 131072, "dil lds");
struct U { int b, h, d, sr, win0; };
__device__ __forceinline__ U decode(int u) {
    U r; const int j = u & 15, g3 = (u >> 4) % 3, bh = u / 48; r.b = bh >> 3; r.h = bh & 7; int np;
    if (g3 == 0) { r.d = 1; r.sr = 0; np = j; } else if (g3 == 1) { r.d = 4; r.sr = j >> 2; np = j & 3; } else { r.d = 16; r.sr = j; np = 0; }
    r.win0 = (2 * np - 1) * 128; return r;
}
__device__ __forceinline__ void issue(const U& w, const bf16* Q, const bf16* K, const bf16* V, int tid, int wave, int lane, v4u (&kreg)[6], v4u (&vreg)[6], bf16x8 (&qr)[4]) {
    const unsigned rowbase = (unsigned)w.b * SEQ; const int r32 = lane & 31, hi = lane >> 5;
#pragma unroll
    for (int i = 0; i < 6; ++i) { const int idx = tid + 512 * i, j = idx >> 3, ch = idx & 7; const int sp = max(w.win0 + j, 0);
        const unsigned go = (rowbase + (unsigned)(sp * w.d + w.sr)) * 512u + w.h * 64 + ch * 8; kreg[i] = *(const v4u*)(K + go); vreg[i] = *(const v4u*)(V + go); }
    const unsigned tokq = rowbase + (unsigned)((w.win0 + 128 + 32 * wave + r32) * w.d + w.sr);
#pragma unroll
    for (int s = 0; s < 4; ++s) qr[s] = *(const bf16x8*)(Q + (tokq * 512u + w.h * 64 + 16 * s + 8 * hi));
}
__device__ __forceinline__ void stage(const U& w, LAS unsigned char* lds, int tid, const v4u (&kreg)[6], const v4u (&vreg)[6]) {
    unsigned zz_ = 0u; asm volatile("" : "+v"(zz_));
#pragma unroll
    for (int i = 0; i < 6; ++i) { const int idx = tid + 512 * i, j = idx >> 3, ch = idx & 7; const bool ok = (w.win0 + j) >= 0;
        v4u kv = kreg[i], vv = vreg[i]; if (!ok) { kv = (v4u){zz_, zz_, zz_, zz_}; vv = kv; }
        *(LAS v4u*)(lds + LK + j * 128 + ((ch ^ ((j >> 1) & 7)) * 16)) = kv;
        *(LAS v4u*)(lds + LV + j * 144 + ch * 16) = vv; }
}
__device__ __forceinline__ void compute(const U& w, int g3, const bf16x8 (&qr)[4], bf16* OG, float* LSE, LAS unsigned char* lds, int wave, int lane) {
    const int d = w.d, h = w.h, win0 = w.win0, sr = w.sr; const size_t rowbase = (size_t)w.b * SEQ; const int r32 = lane & 31, hi = lane >> 5;
    const int qrow = 128 + 32 * wave + r32; const size_t tokq = rowbase + (size_t)((win0 + qrow) * d + sr);
    f32x16 sc[5];
    const float csc = 0.125f * LOG2E, al = __builtin_amdgcn_exp2f(-(float)(h + 1)) * (float)d * LOG2E;
    const int sb = 128 + r32 - 4 * hi; const int stmax = min(128, win0 + qrow);
    const bool full = (win0 + 128 + 32 * wave) >= 128;
    float mx = -INFINITY;
#pragma unroll
    for (int j = 0; j < 5; ++j) { const int row = 32 * (wave + j) + r32; f32x16 a = {};
#pragma unroll
        for (int s = 0; s < 4; ++s) { const bf16x8 kf = *(const LAS bf16x8*)(lds + LK + row * 128 + (((2 * s + hi) ^ ((row >> 1) & 7)) * 16)); a = MFMA32(kf, qr[s], a); }
        int sbj = sb; asm volatile("" : "+v"(sbj) : "v"(a[15]));
        if (j >= 1 && j <= 3 && full) {
            const float b0 = -al * (float)sbj;
#pragma unroll
            for (int r = 0; r < 16; ++r) { const float x = __builtin_fmaf(a[r], csc, __builtin_fmaf(al, (float)(32 * j + (r & 3) + 8 * (r >> 2)), b0)); a[r] = x; mx = fmaxf(mx, x); }
        } else {
#pragma unroll
        for (int r = 0; r < 16; ++r) { const int st = sbj - (32 * j + (r & 3) + 8 * (r >> 2));
            const float x = ((unsigned)st <= (unsigned)stmax) ? (a[r] * csc - al * (float)st) : -INFINITY; a[r] = x; mx = fmaxf(mx, x); } }
        sc[j] = a; }
    { auto rr = __builtin_amdgcn_permlane32_swap(__float_as_uint(mx), __float_as_uint(mx), false, false); mx = fmaxf(__uint_as_float(rr[0]), __uint_as_float(rr[1])); }
    float l = 0.f;
#pragma unroll
    for (int j = 0; j < 5; ++j)
#pragma unroll
        for (int r = 0; r < 16; ++r) { const float p = __builtin_amdgcn_exp2f(sc[j][r] - mx); sc[j][r] = p; l += p; }
    { auto rr = __builtin_amdgcn_permlane32_swap(__float_as_uint(l), __float_as_uint(l), false, false); l = __uint_as_float(rr[0]) + __uint_as_float(rr[1]); }
    f32x16 o[2]; o[0] = f32x16{}; o[1] = f32x16{};
    const int blk = (lane >> 4) & 1, q4 = (lane & 15) >> 2, p4 = lane & 3;
#pragma unroll
    for (int j = 0; j < 5; ++j)
#pragma unroll
        for (int s = 0; s < 2; ++s) {
            v4u pw; pw.x = pk2(sc[j][8 * s + 0], sc[j][8 * s + 1]); pw.y = pk2(sc[j][8 * s + 2], sc[j][8 * s + 3]); pw.z = pk2(sc[j][8 * s + 4], sc[j][8 * s + 5]); pw.w = pk2(sc[j][8 * s + 6], sc[j][8 * s + 7]);
            const bf16x8 pa = __builtin_bit_cast(bf16x8, pw);
            const int R0 = 32 * (wave + j) + 16 * s + 4 * hi + q4;
#pragma unroll
            for (int c = 0; c < 2; ++c) { const LAS unsigned char* vp = lds + LV + R0 * 144 + (32 * c + 16 * blk) * 2 + 8 * p4;
                const s16x4 lo = trrd(vp), hh = trrd(vp + 8 * 144); o[c] = MFMA32(pa, CAT8(lo, hh), o[c]); } }
    LAS float* scr = (LAS float*)(lds + LSCR + wave * 256);
    if (hi == 0) scr[r32] = 1.0f / l;
    asm volatile("s_waitcnt lgkmcnt(0)" ::: "memory");
    if (hi == 0) LSE[tokq * 8 + h] = mx + __builtin_amdgcn_logf(l);
#pragma unroll
    for (int r = 0; r < 16; ++r) { const int qq = crow(r, hi); const float inv = scr[qq]; const size_t tok = rowbase + (size_t)((win0 + 128 + 32 * wave + qq) * d + sr);
        bf16* op = OG + tok * 512 + h * 64 + r32; op[0] = (bf16)f2bf(o[0][r] * inv); op[32] = (bf16)f2bf(o[1][r] * inv); }
}
}

namespace ret {
constexpr int C = 64, KR = 528, VR = 288, SR = 528, LK = 0, LV = C * KR, LST = LV + C * VR, LTOT = LST + 128 * SR, NCH = SEQ / C;
static_assert(LTOT <= 131072, "ret lds");
__device__ __forceinline__ void unit(int b, int h, int vs, const bf16* Q, const bf16* K, bf16* V  , LAS unsigned char* lds, int tid_, int wave, int lane_, bf16* Vst, unsigned stmask) {
    const float gam = 1.0f - __builtin_amdgcn_exp2f(-5.0f - (float)h), lg = __builtin_amdgcn_logf(gam);
    const int wr = wave >> 2, wc = wave & 3;
    asm volatile("" : "+v"(tid_));
    { unsigned zz_ = 0u; asm volatile("" : "+v"(zz_)); for (int i = tid_; i < 128 * SR / 16; i += NWAVES * 64) *(LAS v4u*)(lds + LST + i * 16) = (v4u){zz_, zz_, zz_, zz_}; }
    __builtin_amdgcn_sched_barrier(0);
    const size_t rowbase = (size_t)b * SEQ;
    f32x16 S[4];
#pragma unroll
    for (int t = 0; t < 4; ++t) S[t] = f32x16{};
    const float c0 = __builtin_amdgcn_exp2f(-lg * (float)C), gC = __builtin_amdgcn_exp2f(lg * (float)C);
    v4u kreg[4], vreg[2]; bf16x8 qr[16];
    { int tp_ = tid_; asm volatile("" : "+v"(tp_)); const int tid = tp_, r32 = tp_ & 31, hi = (tp_ >> 5) & 1;
    const unsigned kg = ((unsigned)rowbase + (unsigned)(tid >> 5)) * 1024u + h * 256 + (tid & 31) * 8;
    const unsigned vg = ((unsigned)rowbase + (unsigned)(tid >> 4)) * 2048u + h * 512 + vs * 128 + (tid & 15) * 8;
    const unsigned qg = ((unsigned)rowbase + (unsigned)(32 * wr + r32)) * 1024u + h * 256 + 8 * hi;
#pragma unroll
    for (int k = 0; k < 4; ++k) kreg[k] = *(const v4u*)(K + (kg + (unsigned)(16 * k) * 1024u));
#pragma unroll
    for (int k = 0; k < 2; ++k) vreg[k] = *(const v4u*)(V + (vg + (unsigned)(32 * k) * 2048u));
#pragma unroll
    for (int s = 0; s < 16; ++s) qr[s] = *(const bf16x8*)(Q + (qg + 16u * s)); }
    for (int ci = 0; ci < NCH; ++ci) {
        const size_t t0 = rowbase + (size_t)ci * C; const bool more = (ci + 1 < NCH);
        int tl = tid_; asm volatile("" : "+v"(tl));
        const int tid = tl, lane = tl & 63, r32 = lane & 31, hi = lane >> 5, blk = (lane >> 4) & 1, q4 = (lane & 15) >> 2, p4 = lane & 3;
        const unsigned kg = ((unsigned)rowbase + (unsigned)(tid >> 5)) * 1024u + h * 256 + (tid & 31) * 8;
        const unsigned vg = ((unsigned)rowbase + (unsigned)(tid >> 4)) * 2048u + h * 512 + vs * 128 + (tid & 15) * 8;
        const unsigned qg = ((unsigned)rowbase + (unsigned)(32 * wr + r32)) * 1024u + h * 256 + 8 * hi;
#pragma unroll
        for (int k = 0; k < 4; ++k) *(LAS v4u*)(lds + LK + ((tid >> 5) + 16 * k) * KR + (tid & 31) * 16) = kreg[k];
#pragma unroll
        for (int k = 0; k < 2; ++k) { const int t = (tid >> 4) + 32 * k; const v4u raw = vreg[k];
            const float kd = __builtin_amdgcn_exp2f(lg * (float)(C - 1 - t)) * 0.0625f; v4u w;
            w.x = pk2(__builtin_bit_cast(float, raw.x << 16) * kd, __builtin_bit_cast(float, raw.x & 0xffff0000u) * kd);
            w.y = pk2(__builtin_bit_cast(float, raw.y << 16) * kd, __builtin_bit_cast(float, raw.y & 0xffff0000u) * kd);
            w.z = pk2(__builtin_bit_cast(float, raw.z << 16) * kd, __builtin_bit_cast(float, raw.z & 0xffff0000u) * kd);
            w.w = pk2(__builtin_bit_cast(float, raw.w << 16) * kd, __builtin_bit_cast(float, raw.w & 0xffff0000u) * kd);
            *(LAS v4u*)(lds + LV + t * VR + (tid & 15) * 16) = w; }
        LBAR();
        f32x16 acc = f32x16{}, it0 = f32x16{}, it1 = f32x16{};
        const LAS unsigned char* sp = lds + LST + (32 * wc + r32) * SR + 16 * hi;
        const LAS unsigned char* kp = lds + LK + r32 * KR + 16 * hi;
        const unsigned qn = qg + (unsigned)(ci + 1) * C * 1024u;
#pragma unroll
        for (int g = 0; g < 4; ++g) {
#pragma unroll
            for (int s = 0; s < 4; ++s) { const int ks = 4 * g + s; acc = MFMA32(qr[ks], *(const LAS bf16x8*)(sp + 32 * ks), acc);
                it0 = MFMA32(*(const LAS bf16x8*)(kp + 32 * ks), qr[ks], it0); if (wr) it1 = MFMA32(*(const LAS bf16x8*)(kp + 32 * KR + 32 * ks), qr[ks], it1); }
                if (more) {
#pragma unroll
                for (int s = 0; s < 4; ++s) qr[4 * g + s] = *(const bf16x8*)(Q + (qn + 16u * (4 * g + s))); }
        }
#define PVSTEP(IT, J) do { int qv = 32 * wr + r32 - 4 * hi; asm volatile("" : "+v"(qv) : "v"(IT[15])); \
            _Pragma("unroll") for (int r = 0; r < 16; ++r) { IT[r] = ((32 * (J) + (r & 3) + 8 * (r >> 2)) <= qv) ? IT[r] * c0 : 0.f; } \
            _Pragma("unroll") for (int s = 0; s < 2; ++s) { \
                v4u pw; pw.x = pk2(IT[8 * s + 0], IT[8 * s + 1]); pw.y = pk2(IT[8 * s + 2], IT[8 * s + 3]); pw.z = pk2(IT[8 * s + 4], IT[8 * s + 5]); pw.w = pk2(IT[8 * s + 6], IT[8 * s + 7]); \
                const LAS unsigned char* vp = lds + LV + (32 * (J) + 16 * s + 4 * hi + q4) * VR + (32 * wc + 16 * blk) * 2 + 8 * p4; \
                const s16x4 lo = trrd(vp), hh = trrd(vp + 8 * VR); acc = MFMA32(__builtin_bit_cast(bf16x8, pw), CAT8(lo, hh), acc); } } while (0)
        PVSTEP(it0, 0);
        if (wr) PVSTEP(it1, 1);
#undef PVSTEP
        if (more) { const unsigned nr = (unsigned)(ci + 1) * C;
#pragma unroll
            for (int k = 0; k < 4; ++k) kreg[k] = *(const v4u*)(K + (kg + (nr + 16 * k) * 1024u));
#pragma unroll
            for (int k = 0; k < 2; ++k) vreg[k] = *(const v4u*)(V + (vg + (nr + 32 * k) * 2048u)); }
        { unsigned ob = ((unsigned)t0 + 32 * wr + 4 * hi) * 2048u + h * 512 + vs * 128 + 32 * wc + r32; asm volatile("" : "+v"(ob));
          float fb = lg * (float)(32 * wr + 4 * hi + 1); asm volatile("" : "+v"(fb));
          const float f0 = __builtin_amdgcn_exp2f(fb), g2 = gam * gam, g8 = (g2 * g2) * (g2 * g2);
          float fr4 = f0;
#pragma unroll
          for (int r4 = 0; r4 < 4; ++r4) { float f = fr4;
#pragma unroll
            for (int e = 0; e < 4; ++e) { const int r = 4 * r4 + e, dq = e + 8 * r4; Vst[(ob + (unsigned)dq * 2048u) & stmask] = (bf16)f2bf(acc[r] * f); f *= gam; }
            fr4 *= g8; } }
#pragma unroll
        for (int t = 0; t < 4; ++t) S[t] = S[t] * gC;
#pragma unroll
        for (int s = 0; s < 4; ++s) {
            const LAS unsigned char* ka = lds + LK + (16 * s + 8 * hi + q4) * KR + (32 * wave + 16 * blk) * 2 + 8 * p4;
            const s16x4 klo = trrd(ka), khi = trrd(ka + 4 * KR); const bf16x8 kf = CAT8(klo, khi);
#pragma unroll
            for (int t = 0; t < 4; ++t) { const LAS unsigned char* vb = lds + LV + (16 * s + 8 * hi + q4) * VR + (32 * t + 16 * blk) * 2 + 8 * p4;
                const s16x4 vlo = trrd(vb), vhi = trrd(vb + 4 * VR); S[t] = MFMA32(kf, CAT8(vlo, vhi), S[t]); } }
        LBAR();
#pragma unroll
        for (int t = 0; t < 4; ++t)
#pragma unroll
            for (int g4 = 0; g4 < 4; ++g4) { v2u w; w.x = pk2(S[t][4 * g4 + 0], S[t][4 * g4 + 1]); w.y = pk2(S[t][4 * g4 + 2], S[t][4 * g4 + 3]);
                *(LAS v2u*)(lds + LST + (32 * t + r32) * SR + (32 * wave + 8 * g4 + 4 * hi) * 2) = w; }
    }
    __syncthreads();
}
}

struct Args { const float* in[11]; float* out; unsigned char* ws; int pad0, pad1; };
__global__ void __launch_bounds__(NWAVES * 64, 2) fwd_mk(Args args) {
    extern __shared__ __attribute__((aligned(16))) unsigned char lds_raw[];
    cg::grid_group grid = cg::this_grid();
#define GSYNC() do { xcd_barrier(xbar); if (PROBE_DOUBLE == 11) xcd_barrier(xbar); } while (0)
#ifndef PROBE_T
#define PROBE_T 0
#endif
#define GSYNCN(id) do { GSYNC(); if (PROBE_T && bx == 0 && threadIdx.x == 0) { const unsigned long long t_ = __builtin_amdgcn_s_memrealtime(); if (PROBE_T == (id) + 1) tacc[0] += t_ - tacc[1]; tacc[1] = t_; } } while (0)
    LAS unsigned char* lds = (LAS unsigned char*)lds_raw;
    int tid = threadIdx.x, lane = tid & 63, wave = __builtin_amdgcn_readfirstlane(tid >> 6);
#define RETID() do { tid = threadIdx.x; asm volatile("" : "+v"(tid)); lane = tid & 63; wave = __builtin_amdgcn_readfirstlane(tid >> 6); bx = blockIdx.x; asm volatile("" : "+s"(bx)); vcu = (bx % 8) * (G / 8) + bx / 8; gw = vcu * NWAVES + wave; RELOAD(); } while (0)
    constexpr int G = 256; int bx = blockIdx.x, vcu = (bx % 8) * (G / 8) + bx / 8;
    int gw = vcu * NWAVES + wave; constexpr int NGW = G * NWAVES;
    LAS unsigned long long* ptab = (LAS unsigned long long*)(lds + LDS_BYTES - 128);
    LAS unsigned long long* tacc = (LAS unsigned long long*)(lds + LDS_BYTES - 160);
    if (PROBE_T && threadIdx.x == 0) { tacc[0] = 0; tacc[1] = __builtin_amdgcn_s_memrealtime(); }
    if (tid == 0) {
        ptab[0] = (unsigned long long)args.in[0]; ptab[1] = (unsigned long long)args.in[1]; ptab[2] = (unsigned long long)args.in[2]; ptab[3] = (unsigned long long)args.in[3];
        ptab[4] = (unsigned long long)args.in[4]; ptab[5] = (unsigned long long)args.in[5]; ptab[6] = (unsigned long long)args.in[6]; ptab[7] = (unsigned long long)args.in[7];
        ptab[8] = (unsigned long long)args.in[8]; ptab[9] = (unsigned long long)args.in[9]; ptab[10] = (unsigned long long)args.in[10]; ptab[11] = (unsigned long long)args.out; ptab[12] = (unsigned long long)args.ws; }
    __syncthreads();
#define GASP(T, i) ((T*)(__attribute__((address_space(1))) T*)LDP(i))
#define LDP(i) ({ const unsigned long long v_ = ptab[(i) + pz_]; (((unsigned long long)(unsigned)__builtin_amdgcn_readfirstlane((int)(v_ >> 32))) << 32) | (unsigned long long)(unsigned)__builtin_amdgcn_readfirstlane((int)(unsigned)v_); })
#define RELOAD() do { int pz_ = 0; asm volatile("" : "+v"(pz_) :: "memory"); ws = GASP(unsigned char, 12); out = GASP(float, 11); in.x = GASP(const float, 0); in.gmix = GASP(const float, 1); in.gffn = GASP(const float, 2); in.ewin = GASP(const float, 3); in.ebf = GASP(const float, 4); \
        in.ewout = GASP(const float, 5); in.owin = GASP(const float, 6); in.owout = GASP(const float, 7); in.f1 = GASP(const float, 8); in.f2 = GASP(const float, 9); in.gfin = GASP(const float, 10); \
        XN = (bf16*)(ws + WS_XN); LOGF = (float*)(ws + WS_LOGF); SSM = (float*)(ws + 1020 * MiB); SSF = (float*)(ws + WS_LSE);     LSE = (float*)(ws + WS_LSE); } while (0)
    unsigned char* ws; float* out; Ins in; bf16* XN; float* LOGF; float* SSM; float* SSF; float* LSE;
    RELOAD();
    volatile LAS unsigned* xst = (volatile LAS unsigned*)(lds + LDS_BYTES - 192);
    if (threadIdx.x == 0) { xst[0] = 0u; xst[1] = 0u; }
    __syncthreads();
    XcdBarrier xbar = xcd_barrier_post((unsigned*)ws, xst);
    p0_prologue(in, ws, lds, gw, NGW, wave, lane);
    if (PROBE_DOUBLE == 10) p0_prologue(in, ws, lds, gw, NGW, wave, lane);
    __syncthreads();
#pragma unroll 1
    for (int layer = 0; layer < DEPTH; ++layer) {
        const int li = layer >> 1; const bool even = (layer & 1) == 0;
        RETID();
#define XIN ((layer == 0) ? in.x : out)
        if (layer == 0) {
            gate_pass<true>(in.x, XN, SSM, in.gmix, in.ewin + EVEN_N, in.ebf, LOGF, lds, gw, NGW, tid, lane);
            grid.sync();
            if (PROBE_T && bx == 0 && threadIdx.x == 0) { const unsigned long long t_ = __builtin_amdgcn_s_memrealtime(); if (PROBE_T == 1) tacc[0] += t_ - tacc[1]; tacc[1] = t_; }
            RETID();
        }
#define ZERO_SS(P) do { for (int i_ = vcu * (NWAVES * 64) + tid; i_ < M; i_ += G * NWAVES * 64) (P)[i_] = 0.f; } while (0)
        if (even) {
            if (layer != 0) { gate_pass<false>(nullptr, XN, SSM, in.gmix + layer * DM, in.ewin + (size_t)li * DM * EVEN_IN + EVEN_N, in.ebf + li * 8, LOGF, lds, gw, NGW, tid, lane); RETID(); }
            { pg8::Gemm g{XN, (const bf16*)(ws + WS_EIN) + (size_t)li * EVEN_N * DM, M, EVEN_N, DM}; pg8::StaticOrder S; S.init(M, EVEN_N, G, bx);
              pg8::EpiSplit<0> E{(bf16*)(ws + WS_ACT), 512, 512, SEG / 2, 3, attn_body::C2, SSM};
              for (int rp = 0; rp < (PROBE_DOUBLE == 9 ? 2 : 1); ++rp) pg8::gemm_phase<pg8::EpiSplit<0>, pg8::StaticOrder, PG8_ALIGN, PG8_SP2, STREAM_F16 != 0>(lds, g, S, E); }
            GSYNCN(1);
            { const attn_body::AttnTensors AT{(const attn_body::bf16*)(ws + WS_ACT + 3 * SEG), (const attn_body::bf16*)(ws + WS_ACT + 4 * SEG), (const attn_body::bf16*)(ws + WS_ACT + 5 * SEG),
                                              (attn_body::bf16*)(ws + WS_AO) + 512, LOGF};
              const attn_body::StaticOrder S(G, bx);
              for (int rp = 0; rp < (PROBE_DOUBLE == 2 ? 2 : 1); ++rp) attn_body::attn_phase<attn_body::StaticOrder>((char*)lds_raw, AT, S);
 }
            __syncthreads(); RETID();
            for (int rp = 0; rp < (PROBE_DOUBLE == 1 ? 2 : 1); ++rp) {
                constexpr int NU = BATCH * 8 * 3 * 16; const bf16* QA = (const bf16*)(ws + WS_ACT); const bf16* KA = (const bf16*)(ws + WS_ACT + SEG); const bf16* VA = (const bf16*)(ws + WS_ACT + 2 * SEG);
                v4u kreg[6], vreg[6]; bf16x8 qn[4];
                dil::U cur = dil::decode(vcu); dil::issue(cur, QA, KA, VA, tid, wave, lane, kreg, vreg, qn);
                for (int u = vcu; u < NU; u += G) {
                    dil::stage(cur, lds, tid, kreg, vreg);
                    bf16x8 qc[4];
#pragma unroll
                    for (int s_ = 0; s_ < 4; ++s_) qc[s_] = qn[s_];
                    LBAR();
                    const int g3 = (u >> 4) % 3; const dil::U me = cur;
                    if (u + G < NU) { cur = dil::decode(u + G); dil::issue(cur, QA, KA, VA, tid, wave, lane, kreg, vreg, qn); }
                    dil::compute(me, g3, qc, (bf16*)(ws + WS_OG + (size_t)g3 * SEG), LSE + (size_t)g3 * M * 8, lds, wave, lane);
                    LBAR();
                }
            }
            GSYNCN(2);
            RETID();
            for (int rp = 0; rp < (PROBE_DOUBLE == 5 ? 2 : 1); ++rp)
            for (int m0 = gw; m0 < M; m0 += 4 * NGW) { const int hh = lane >> 3;
                float l0s[4], l1s[4], l2s[4]; v4u as[4], bs_[4], cs[4];
#pragma unroll
                for (int k = 0; k < 4; ++k) { const size_t m = (size_t)(m0 + k * NGW);
                    l0s[k] = LSE[m * 8 + hh]; l1s[k] = LSE[(size_t)M * 8 + m * 8 + hh]; l2s[k] = LSE[(size_t)2 * M * 8 + m * 8 + hh];
                    as[k] = *((const v4u*)((const bf16*)(ws + WS_OG) + m * 512) + lane); bs_[k] = *((const v4u*)((const bf16*)(ws + WS_OG + SEG) + m * 512) + lane); cs[k] = *((const v4u*)((const bf16*)(ws + WS_OG + 2 * SEG) + m * 512) + lane); }
                asm volatile("" ::: "memory");
#pragma unroll
                for (int k = 0; k < 4; ++k) { const size_t m = (size_t)(m0 + k * NGW); const float l0 = l0s[k], l1 = l1s[k], l2 = l2s[k]; const v4u a = as[k], bq = bs_[k], c = cs[k];
                const float mx = fmaxf(l0, fmaxf(l1, l2)); float w0 = __builtin_amdgcn_exp2f(l0 - mx), w1 = __builtin_amdgcn_exp2f(l1 - mx), w2 = __builtin_amdgcn_exp2f(l2 - mx); const float inv = 1.0f / (w0 + w1 + w2); w0 *= inv; w1 *= inv; w2 *= inv;
                v4u o;
#define CMB(f) { const float lo = w0 * __builtin_bit_cast(float, a.f << 16) + w1 * __builtin_bit_cast(float, bq.f << 16) + w2 * __builtin_bit_cast(float, c.f << 16); \
                 const float hi_ = w0 * __builtin_bit_cast(float, a.f & 0xffff0000u) + w1 * __builtin_bit_cast(float, bq.f & 0xffff0000u) + w2 * __builtin_bit_cast(float, c.f & 0xffff0000u); o.f = pk2(lo, hi_); }
                CMB(x) CMB(y) CMB(z) CMB(w)
#undef CMB
                *((v4u*)((bf16*)(ws + WS_AO) + m * 1024) + lane) = o; } }
            GSYNCN(3);
            RETID();
            { pg8::Gemm g{(const bf16*)(ws + WS_AO), (const bf16*)(ws + WS_EOUT) + (size_t)li * DM * DM, M, DM, DM}; pg8::StaticOrder S; S.init(M, DM, G, bx);
              if (layer == 0) { pg8::EpiRes<true> E{in.x, XN, DM, SSF, nullptr}; pg8::gemm_phase<pg8::EpiRes<true>, pg8::StaticOrder, EPIRES_ALIGN, PG8_SP2>(lds, g, S, E); }
              else { pg8::EpiRes<false> E{nullptr, XN, DM, SSF, nullptr}; pg8::gemm_phase<pg8::EpiRes<false>, pg8::StaticOrder, EPIRES_ALIGN, PG8_SP2>(lds, g, S, E); } }
        } else {
            RETID();
            { pg8::Gemm g{XN, (const bf16*)(ws + WS_OIN) + (size_t)li * ODD_IN * DM, M, ODD_IN, DM}; pg8::StaticOrder S; S.init(M, ODD_IN, G, bx);
              pg8::EpiOddIn E{(bf16*)(ws + WS_RQ), (bf16*)(ws + WS_RK), (bf16*)(ws + WS_RV), (bf16*)(ws + WS_RG), SSM};
              for (int rp = 0; rp < (PROBE_DOUBLE == 13 ? 2 : 1); ++rp) pg8::gemm_phase<pg8::EpiOddIn, pg8::StaticOrder, PG8_ALIGN, PG8_SP2, STREAM_F16 != 0>(lds, g, S, E); }
            GSYNCN(4);
            RETID();
            for (int u = vcu; u < BATCH * 4 * 4; u += G) { const int vs = u & 3, bh = u >> 2;
                for (int rp = (PROBE_DOUBLE == 3 ? 0 : 1); rp < 2; ++rp) ret::unit(bh >> 2, bh & 3, vs, (const bf16*)(ws + WS_RQ), (const bf16*)(ws + WS_RK), (bf16*)(ws + WS_RV), lds, tid, wave, lane, (rp == 0) ? (bf16*)ws : (bf16*)(ws + WS_RV), (rp == 0) ? 0x7ffffu : 0xffffffffu); }
            GSYNCN(5);
            RETID();
            for (int it = gw; it < M * 4; it += 4 * NGW) {
                v4u ovs[4], gvs[4]; size_t offs[4];
#pragma unroll
                for (int k = 0; k < 4; ++k) { const int i2 = it + k * NGW; offs[k] = (size_t)(i2 >> 2) * 2048 + (i2 & 3) * 512 + lane * 8;
                    ovs[k] = *(const v4u*)((const bf16*)(ws + WS_RV) + offs[k]); gvs[k] = *(const v4u*)((const bf16*)(ws + WS_RG) + offs[k]); }
                asm volatile("" ::: "memory");
#pragma unroll
                for (int k = 0; k < 4; ++k) { const v4u ov = ovs[k], gv = gvs[k];
                float o[8], gg[8];
                o[0] = __builtin_bit_cast(float, ov.x << 16); o[1] = __builtin_bit_cast(float, ov.x & 0xffff0000u); o[2] = __builtin_bit_cast(float, ov.y << 16); o[3] = __builtin_bit_cast(float, ov.y & 0xffff0000u);
                o[4] = __builtin_bit_cast(float, ov.z << 16); o[5] = __builtin_bit_cast(float, ov.z & 0xffff0000u); o[6] = __builtin_bit_cast(float, ov.w << 16); o[7] = __builtin_bit_cast(float, ov.w & 0xffff0000u);
                gg[0] = __builtin_bit_cast(float, gv.x << 16); gg[1] = __builtin_bit_cast(float, gv.x & 0xffff0000u); gg[2] = __builtin_bit_cast(float, gv.y << 16); gg[3] = __builtin_bit_cast(float, gv.y & 0xffff0000u);
                gg[4] = __builtin_bit_cast(float, gv.z << 16); gg[5] = __builtin_bit_cast(float, gv.z & 0xffff0000u); gg[6] = __builtin_bit_cast(float, gv.w << 16); gg[7] = __builtin_bit_cast(float, gv.w & 0xffff0000u);
                float s = 0.f;
#pragma unroll
                for (int e = 0; e < 8; ++e) s += o[e];
                const float mu = wave_sum(s) * (1.f / 512.f); float q = 0.f;
#pragma unroll
                for (int e = 0; e < 8; ++e) { o[e] -= mu; q += o[e] * o[e]; }
                const float rs = 1.0f / sqrtf(wave_sum(q) * (1.f / 512.f) + GN_EPS);
                float y[8];
#pragma unroll
                for (int e = 0; e < 8; ++e) y[e] = gg[e] / (1.0f + __expf(-gg[e])) * (o[e] * rs);
                v4u w; w.x = pk2(y[0], y[1]); w.y = pk2(y[2], y[3]); w.z = pk2(y[4], y[5]); w.w = pk2(y[6], y[7]);
                *(v4u*)((bf16*)(ws + WS_RG) + offs[k]) = w; } }
            GSYNCN(6);
            RETID();
            { pg8::Gemm g{(const bf16*)(ws + WS_RG), (const bf16*)(ws + WS_OOUT) + (size_t)li * 2 * DM * DM, M, DM, 2 * DM}; pg8::StaticOrder S; S.init(M, DM, G, bx);
              pg8::EpiRes<false> E{nullptr, XN, DM, SSF, nullptr}; pg8::gemm_phase<pg8::EpiRes<false>, pg8::StaticOrder, EPIRES_ALIGN, PG8_SP2>(lds, g, S, E); }
        }
        GSYNCN(7);
        RETID();
        if (PROBE_DOUBLE == 20) { const unsigned long long t0_ = __builtin_amdgcn_s_memrealtime(); while (__builtin_amdgcn_s_memrealtime() - t0_ < 25000ull) __builtin_amdgcn_s_sleep(16); }
        { pg8::Gemm g{XN, (const bf16*)(ws + WS_F1) + (size_t)layer * FF * DM, M, FF, DM}; pg8::StaticOrder S; S.init(M, FF, G, bx);
          pg8::EpiSplit<2> E{(bf16*)(ws + WS_H), FF, 0, 0, -1, 1.f, SSF};
          for (int rp = 0; rp < (PROBE_DOUBLE == 7 ? 2 : 1); ++rp) pg8::gemm_phase<pg8::EpiSplit<2>, pg8::StaticOrder, PG8_ALIGN, PG8_SP2, STREAM_F16 != 0>(lds, g, S, E); }
        GSYNCN(9);
        RETID();
        { pg8::Gemm g{(const bf16*)(ws + WS_H), (const bf16*)(ws + WS_F2) + (size_t)layer * FF * DM, M, DM, FF}; pg8::StaticOrder S; S.init(M, DM, G, bx);
          pg8::EpiRes<false> E{nullptr, XN, DM, SSM, SSF}; pg8::gemm_phase<pg8::EpiRes<false>, pg8::StaticOrder, EPIRES_ALIGN, PG8_SP2>(lds, g, S, E); }
        GSYNCN(10);
    }
    RETID();
    { f32x4 gv[4];
#pragma unroll
      for (int j = 0; j < 4; ++j) gv[j] = *((const f32x4*)in.gfin + lane + 64 * j);
      for (int m = gw; m < M; m += NGW) { const v2u* xr = (const v2u*)(XN + (size_t)m * DM) + lane; f32x4 v[4]; float s = 0.f;
#pragma unroll
          for (int j = 0; j < 4; ++j) { const v2u w = xr[64 * j]; v[j].x = pg8::st_lo(w.x); v[j].y = pg8::st_hi(w.x); v[j].z = pg8::st_lo(w.y); v[j].w = pg8::st_hi(w.y);
              s += (v[j].x * v[j].x + v[j].y * v[j].y) + (v[j].z * v[j].z + v[j].w * v[j].w); }
          const float rstd = 1.0f / sqrtf(wave_sum(s) * (1.f / DM) + RMS_EPS); f32x4* orow = (f32x4*)(out + (size_t)m * DM) + lane;
#pragma unroll
          for (int j = 0; j < 4; ++j) orow[64 * j] = v[j] * rstd * gv[j]; } }
    if (PROBE_T && bx == 0 && threadIdx.x == 0) { const unsigned long long t0_ = __builtin_amdgcn_s_memrealtime(), w_ = 10ull * tacc[0]; while (__builtin_amdgcn_s_memrealtime() - t0_ < w_) __builtin_amdgcn_s_sleep(8); }
}

extern "C" void kernel_launch(void* const* d_in, const int* in_sizes, int n_in, void* d_out, int out_size, void* d_ws, size_t ws_size, hipStream_t stream) {
    static int grid = 0;
    if (grid == 0) {
        if (n_in != 11 || in_sizes[0] != M * DM || out_size != M * DM || ws_size < WS_END) { fprintf(stderr, "kernel_launch: unexpected shapes (n_in %d, ws %zu)\n", n_in, ws_size); grid = -1; return; }
        if (hipFuncSetAttribute((const void*)fwd_mk, hipFuncAttributeMaxDynamicSharedMemorySize, LDS_BYTES) != hipSuccess) { fprintf(stderr, "kernel_launch: hipFuncSetAttribute failed\n"); grid = -1; return; }
        int dev = 0, cus = 0, per_cu = 0;
        hipGetDevice(&dev); hipDeviceGetAttribute(&cus, hipDeviceAttributeMultiprocessorCount, dev);
        hipOccupancyMaxActiveBlocksPerMultiprocessor(&per_cu, (const void*)fwd_mk, NWAVES * 64, LDS_BYTES);
        (void)hipGetLastError();
        if (per_cu < 1) per_cu = 1;
        grid = cus;
        if (grid != 256) { fprintf(stderr, "kernel_launch: built for a 256-CU device, found %d\n", cus); grid = -1; return; }
    }
    if (grid < 0) return;
    if (hipMemsetAsync(d_ws, 0, 16384, stream) != hipSuccess) { fprintf(stderr, "kernel_launch: memset failed\n"); return; }
    Args a{};
    for (int i = 0; i < 11; ++i) a.in[i] = (const float*)d_in[i];
    a.out = (float*)d_out; a.ws = (unsigned char*)d_ws;
    void* kargs[] = {&a};
    hipError_t e = hipLaunchCooperativeKernel((const void*)fwd_mk, dim3(grid), dim3(NWAVES * 64), kargs, LDS_BYTES, stream);
    if (e != hipSuccess) fprintf(stderr, "cooperative launch failed: %s (grid %d)\n", hipGetErrorString(e), grid);
}
```

```cpp
#include <hip/hip_runtime.h>
#include <cstdio>
#include <cstdint>
namespace pg8 {
#define PG8_LAS __attribute__((address_space(3)))
typedef unsigned short bf16_t;
typedef short bf16x8 __attribute__((ext_vector_type(8)));
typedef float f32x4 __attribute__((ext_vector_type(4)));
typedef unsigned u32x4 __attribute__((ext_vector_type(4)));
constexpr int BM = 256, BK = 64, HALF = 128, HTB = HALF * BK * 2  , STAGE_BYTES = 8 * HTB, NXCD = 8, WGM = 8;

__host__ __device__ __forceinline__ int lds_byte(int r, int c) { const int st = (r >> 4) * 2 + (c >> 5), rr = r & 15, cc = c & 31, ob = rr * 64 + cc * 2; return st * 1024 + (ob ^ (((ob >> 9) & 1) << 5)); }
__host__ __device__ __forceinline__ void stage_rc(int b, int& R, int& C) { const int st = b / 1024, sb = b % 1024, swz = sb ^ (((sb >> 9) & 1) << 5); R = (st >> 1) * 16 + swz / 64; C = (st & 1) * 32 + (swz % 64) / 2; }
__host__ __device__ __forceinline__ int perm32(int rho) { const int n = rho >> 4, i = rho & 15; return 8 * (i >> 2) + 4 * n + (i & 3); }

struct Unit { int pm, pn; };
struct Gemm { const bf16_t* A; const bf16_t* Bt; int M, N, K; };

struct StaticOrder {
    int nM, nN, nwg, G, c;
    __host__ __device__ void init(int M, int N, int G_, int c_) { nM = M / BM; nN = N / BM; nwg = nM * nN; G = G_; c = c_; }
    __host__ __device__ bool next(int i, Unit& u) const {
        const long L = (long)i * G + c; if (L >= nwg) return false;
        int wgid = (int)L; { const int q = nwg / NXCD, r = nwg % NXCD, xcd = wgid % NXCD, off = wgid / NXCD; wgid = (xcd < r ? xcd * (q + 1) : r * (q + 1) + (xcd - r) * q) + off; }
        const int nig = WGM * nN, gid = wgid / nig, fm = gid * WGM, gsz = (nM - fm) < WGM ? (nM - fm) : WGM;
        u.pm = fm + ((wgid % nig) % gsz); u.pn = (wgid % nig) / gsz; return true;
    }
    __device__ __forceinline__ void a_ready(const Unit&) const {}
    __device__ __forceinline__ void done(const Unit&) const {}
};

__device__ __forceinline__ unsigned cvt_pk_bf16(float lo, float hi) { unsigned r; asm volatile("v_cvt_pk_bf16_f32 %0, %1, %2" : "=v"(r) : "v"(lo), "v"(hi)); return r; }
typedef float f32x2 __attribute__((ext_vector_type(2)));
__device__ __forceinline__ f32x2 gelu_pk(f32x2 v) {
    const f32x2 av = __builtin_elementwise_abs(v), d = av * 0.2316418882f + 1.0f;
    f32x2 t; t.x = __builtin_amdgcn_rcpf(d.x); t.y = __builtin_amdgcn_rcpf(d.y);
    f32x2 q = t * 0.5307027145f + (-0.7265760135f); q = q * t + 0.7107068705f; q = q * t + (-0.142248368f); q = q * t + 0.127414796f; q = q * t;
    const f32x2 s = (v * v) * (-0.72134752044f);
    f32x2 e; e.x = __builtin_amdgcn_exp2f(s.x); e.y = __builtin_amdgcn_exp2f(s.y);
    const f32x2 m = v * (q * e), r = v - m;
    f32x2 o; o.x = v.x < 0.f ? m.x : r.x; o.y = v.y < 0.f ? m.y : r.y; return o;
}

template <int ACT  > struct EpiBf16 {
    static constexpr bool PERM = true, AFTER_DRAIN = false; static_assert(ACT == 0 || ACT == 1, "EpiBf16: ACT is 0 (none) or 1 (gelu_pk)");
    bf16_t* O; int ldc; const float* bias; int split_cols; size_t split_stride; float scale0;
    __device__ __forceinline__ void operator()(const f32x4 (&acc)[2][2][4][2], const Unit& u, int wr, int wc, int fr, int fq) const {
        const int row0 = u.pm * BM + wr * 64 + fr; int colt = u.pn * BM; bf16_t* base = O;
        float sc = 1.f; if (split_cols) { const int t = colt / split_cols; base += (size_t)t * split_stride; colt -= t * split_cols; if (t == 0) sc = scale0; }
        const int col0 = colt + wc * 32 + 8 * fq, bcol0 = u.pn * BM + wc * 32 + 8 * fq;
        f32x4 bv[2][2];
#pragma unroll
        for (int bj = 0; bj < 2; ++bj)
#pragma unroll
            for (int n = 0; n < 2; ++n) bv[bj][n] = bias ? *(const f32x4*)(bias + bcol0 + bj * HALF + 4 * n) : (f32x4){0.f, 0.f, 0.f, 0.f};
#pragma unroll
        for (int ai = 0; ai < 2; ++ai)
#pragma unroll
            for (int m = 0; m < 4; ++m) { bf16_t* rowp = base + (size_t)(row0 + ai * HALF + m * 16) * ldc + col0;
#pragma unroll
                for (int bj = 0; bj < 2; ++bj) { f32x4 v0 = acc[ai][bj][m][0] + bv[bj][0], v1 = acc[ai][bj][m][1] + bv[bj][1];
                    if (ACT == 1) { f32x2 a = gelu_pk((f32x2){v0[0], v0[1]}), b = gelu_pk((f32x2){v0[2], v0[3]}), c = gelu_pk((f32x2){v1[0], v1[1]}), d = gelu_pk((f32x2){v1[2], v1[3]});
                        v0 = (f32x4){a.x, a.y, b.x, b.y}; v1 = (f32x4){c.x, c.y, d.x, d.y}; }
                    v0 = v0 * sc; v1 = v1 * sc; u32x4 w; w.x = cvt_pk_bf16(v0[0], v0[1]); w.y = cvt_pk_bf16(v0[2], v0[3]); w.z = cvt_pk_bf16(v1[0], v1[1]); w.w = cvt_pk_bf16(v1[2], v1[3]);
                    *(u32x4*)(rowp + bj * HALF) = w; } }
    }
};

struct PanelStats {
    unsigned* xbuf;
    unsigned* cnt;
    unsigned* tmo;
    int ntn; float eps;
    unsigned code;
    __device__ __forceinline__ bool run(const f32x4 (&v)[2][2][4][2], const Unit& u, int wr, int wc, int fr, int fq, PG8_LAS unsigned char* lds, int wid, int lane) const {
        typedef float f32x2v __attribute__((ext_vector_type(2)));
        PG8_LAS f32x2v* P = (PG8_LAS f32x2v*)lds;
        PG8_LAS f32x2v* S = (PG8_LAS f32x2v*)(lds + 8192);
        PG8_LAS unsigned* flag = (PG8_LAS unsigned*)(lds + 8192 + 2048);
#pragma unroll
        for (int ai = 0; ai < 2; ++ai)
#pragma unroll
            for (int m = 0; m < 4; ++m) {
                float s = 0.f;
#pragma unroll
                for (int bj = 0; bj < 2; ++bj)
#pragma unroll
                    for (int n = 0; n < 2; ++n) { const f32x4 x = v[ai][bj][m][n]; s += (x[0] + x[1]) + (x[2] + x[3]); }
                s += __shfl_xor(s, 16); s += __shfl_xor(s, 32);
                const float mw = s * (1.0f / 64.0f); float q = 0.f;
#pragma unroll
                for (int bj = 0; bj < 2; ++bj)
#pragma unroll
                    for (int n = 0; n < 2; ++n) { const f32x4 d = v[ai][bj][m][n] - mw; q += (d[0] * d[0] + d[1] * d[1]) + (d[2] * d[2] + d[3] * d[3]); }
                q += __shfl_xor(q, 16); q += __shfl_xor(q, 32);
                if (fq == 0) P[(ai * HALF + wr * 64 + m * 16 + fr) * 4 + wc] = (f32x2v){mw, q};
            }
        asm volatile("s_waitcnt lgkmcnt(0)" ::: "memory"); __builtin_amdgcn_s_barrier(); asm volatile("" ::: "memory");
#if defined(BROKEN_EXCHANGE_NO_WAIT)
#warning BROKEN CONTROL BUILD: the row-statistics exchange does not wait; results are wrong by design
        if (blockIdx.x >= 64) { const long long t0_ = clock64(); while (clock64() - t0_ < 60000) __builtin_amdgcn_s_sleep(8); }
#endif
        const int row = wid * 32 + (lane & 31);
        if (lane < 32) {
            const f32x2v a = P[row * 4 + 0], b = P[row * 4 + 1], c = P[row * 4 + 2], d = P[row * 4 + 3];
            const float mt = (a.x + b.x + c.x + d.x) * 0.25f;
            const float da = a.x - mt, db = b.x - mt, dc = c.x - mt, dd = d.x - mt;
            const float m2 = (a.y + b.y) + (c.y + d.y) + 64.0f * ((da * da + db * db) + (dc * dc + dd * dd));
            unsigned long long* slot = (unsigned long long*)xbuf + ((size_t)(u.pm * BM + row) * 4 + u.pn);
            __hip_atomic_store(slot, ((unsigned long long)__float_as_uint(m2) << 32) | __float_as_uint(mt), __ATOMIC_RELAXED, __HIP_MEMORY_SCOPE_AGENT);
        }
        asm volatile("s_waitcnt vmcnt(0)" ::: "memory");
        if (lane == 0) __hip_atomic_fetch_add(cnt + 64 * u.pm, 1u, __ATOMIC_RELAXED, __HIP_MEMORY_SCOPE_AGENT);
        if (wid == 0) {
            bool dead = false; const unsigned long long t0 = __builtin_amdgcn_s_memrealtime(); const unsigned want = 8u * (unsigned)ntn;
            for (;;) {
#if defined(BROKEN_EXCHANGE_NO_WAIT)
                break;
#endif
                if ((unsigned)__builtin_amdgcn_readfirstlane(__hip_atomic_load(cnt + 64 * u.pm, __ATOMIC_RELAXED, __HIP_MEMORY_SCOPE_AGENT)) >= want) break;
                if (__builtin_amdgcn_s_memrealtime() - t0 > 2000000ull) {
                    if (lane == 0) { unsigned expect = 0u; __hip_atomic_compare_exchange_strong(tmo + 1, &expect, code | (unsigned)(u.pm & 0xff), __ATOMIC_RELAXED, __ATOMIC_RELAXED, __HIP_MEMORY_SCOPE_AGENT);
                                     __hip_atomic_store(tmo, 1u, __ATOMIC_RELAXED, __HIP_MEMORY_SCOPE_AGENT); }
                    dead = true; break; }
                __builtin_amdgcn_s_sleep(2);
            }
            __builtin_amdgcn_fence(__ATOMIC_ACQUIRE, "agent");
            if (lane == 0) flag[0] = dead ? 1u : 0u;
        }
        asm volatile("s_waitcnt vmcnt(0) lgkmcnt(0)" ::: "memory"); __builtin_amdgcn_s_barrier(); asm volatile("" ::: "memory");
        const bool bad = flag[0] != 0u;
        if (lane < 32) {
            const unsigned long long* slot = (const unsigned long long*)xbuf + (size_t)(u.pm * BM + row) * 4; float mt[4], m2[4]; float ms = 0.f;
#pragma unroll
            for (int t = 0; t < 4; ++t) { if (t < ntn) { const unsigned long long w = __hip_atomic_load(slot + t, __ATOMIC_RELAXED, __HIP_MEMORY_SCOPE_AGENT); mt[t] = __uint_as_float((unsigned)w); m2[t] = __uint_as_float((unsigned)(w >> 32)); } else { mt[t] = 0.f; m2[t] = 0.f; } ms += mt[t]; }
            const float mean = ms / (float)ntn; float q = 0.f;
#pragma unroll
            for (int t = 0; t < 4; ++t) if (t < ntn) { const float dm = mt[t] - mean; q += m2[t] + 256.0f * dm * dm; }
            S[row] = (f32x2v){mean, 1.0f / sqrtf(q / (256.0f * (float)ntn) + eps)};
        }
        asm volatile("s_waitcnt lgkmcnt(0)" ::: "memory"); __builtin_amdgcn_s_barrier(); asm volatile("" ::: "memory");
        return bad;
    }
};
struct EpiLnRes {
    static constexpr bool PERM = false, AFTER_DRAIN = true;
    const float* base; float* out; int ldc; const float* bias; PanelStats st; unsigned poison;
    __device__ __forceinline__ void fused(f32x4 (&acc)[2][2][4][2], const Unit& u, int wr, int wc, int fr, int fq, PG8_LAS unsigned char* lds, int wid, int lane) const {
        typedef float f32x2v __attribute__((ext_vector_type(2)));
        const PG8_LAS f32x2v* S = (const PG8_LAS f32x2v*)(lds + 8192);
        const int col0 = u.pn * BM + wc * 32 + 4 * fq;
#pragma unroll
        for (int bj = 0; bj < 2; ++bj)
#pragma unroll
            for (int n = 0; n < 2; ++n) { const f32x4 bv = bias ? *(const f32x4*)(bias + col0 + bj * HALF + n * 16) : (f32x4){0.f, 0.f, 0.f, 0.f};
#pragma unroll
                for (int ai = 0; ai < 2; ++ai)
#pragma unroll
                    for (int m = 0; m < 4; ++m) acc[ai][bj][m][n] += bv; }
        f32x4 pre[4][2][2];
#pragma unroll
        for (int m = 0; m < 4; ++m) { const size_t off = (size_t)(u.pm * BM + wr * 64 + m * 16 + fr) * ldc + col0;
#pragma unroll
            for (int bj = 0; bj < 2; ++bj)
#pragma unroll
                for (int n = 0; n < 2; ++n) pre[m][bj][n] = *(const f32x4*)(base + off + bj * HALF + n * 16); }
        const bool bad = st.run(acc, u, wr, wc, fr, fq, lds, wid, lane) || poison != 0u;
        const float qnan = __builtin_nanf("");
#pragma unroll
        for (int ai = 0; ai < 2; ++ai)
#pragma unroll
            for (int m = 0; m < 4; ++m) { const int r = ai * HALF + wr * 64 + m * 16 + fr; const f32x2v sr = S[r]; const size_t off = (size_t)(u.pm * BM + r) * ldc + col0;
#pragma unroll
                for (int bj = 0; bj < 2; ++bj)
#pragma unroll
                    for (int n = 0; n < 2; ++n) { const f32x4 bs = ai == 0 ? pre[m][bj][n] : *(const f32x4*)(base + off + bj * HALF + n * 16); f32x4 o = bs + (acc[ai][bj][m][n] - sr.x) * sr.y;
                        if (bad) o = (f32x4){qnan, qnan, qnan, qnan}; *(f32x4*)(out + off + bj * HALF + n * 16) = o; }
                if (m & 1) asm volatile("" ::: "memory"); }
    }
};
struct EpiLnResLn {
    static constexpr bool PERM = false, AFTER_DRAIN = true;
    const float* base; float* out; bf16_t* xn; int ldc; const float* bias; PanelStats st1, st2; unsigned poison;
    __device__ __forceinline__ void fused(f32x4 (&acc)[2][2][4][2], const Unit& u, int wr, int wc, int fr, int fq, PG8_LAS unsigned char* lds, int wid, int lane) const {
        typedef float f32x2v __attribute__((ext_vector_type(2))); typedef unsigned u32x2v __attribute__((ext_vector_type(2)));
        const PG8_LAS f32x2v* S = (const PG8_LAS f32x2v*)(lds + 8192);
        const int col0 = u.pn * BM + wc * 32 + 4 * fq;
#pragma unroll
        for (int bj = 0; bj < 2; ++bj)
#pragma unroll
            for (int n = 0; n < 2; ++n) { const f32x4 bv = bias ? *(const f32x4*)(bias + col0 + bj * HALF + n * 16) : (f32x4){0.f, 0.f, 0.f, 0.f};
#pragma unroll
                for (int ai = 0; ai < 2; ++ai)
#pragma unroll
                    for (int m = 0; m < 4; ++m) acc[ai][bj][m][n] += bv; }
        bool bad = st1.run(acc, u, wr, wc, fr, fq, lds, wid, lane) || poison != 0u;
        const float qnan = __builtin_nanf("");
#pragma unroll
        for (int ai = 0; ai < 2; ++ai)
#pragma unroll
            for (int m = 0; m < 4; ++m) { const int r = ai * HALF + wr * 64 + m * 16 + fr; const f32x2v sr = S[r]; const size_t off = (size_t)(u.pm * BM + r) * ldc + col0;
#pragma unroll
                for (int bj = 0; bj < 2; ++bj)
#pragma unroll
                    for (int n = 0; n < 2; ++n) { const f32x4 bs = *(const f32x4*)(base + off + bj * HALF + n * 16); acc[ai][bj][m][n] = bs + (acc[ai][bj][m][n] - sr.x) * sr.y; }
                asm volatile("" : "+v"(acc[ai][0][m][0]), "+v"(acc[ai][0][m][1]), "+v"(acc[ai][1][m][0]), "+v"(acc[ai][1][m][1]));
                if (m & 1) asm volatile("" ::: "memory"); }
        const bool bad1 = bad;
        bad = st2.run(acc, u, wr, wc, fr, fq, lds, wid, lane) || bad;
#pragma unroll
        for (int ai = 0; ai < 2; ++ai)
#pragma unroll
            for (int m = 0; m < 4; ++m) { const int r = ai * HALF + wr * 64 + m * 16 + fr; const f32x2v sr = S[r]; const size_t off = (size_t)(u.pm * BM + r) * ldc + col0;
#pragma unroll
                for (int bj = 0; bj < 2; ++bj)
#pragma unroll
                    for (int n = 0; n < 2; ++n) { const f32x4 x1 = acc[ai][bj][m][n]; *(f32x4*)(out + off + bj * HALF + n * 16) = bad1 ? (f32x4){qnan, qnan, qnan, qnan} : x1;
                        const f32x4 o = (x1 - sr.x) * sr.y; u32x2v w; w.x = cvt_pk_bf16(o[0], o[1]); w.y = cvt_pk_bf16(o[2], o[3]);
                        if (bad) { w.x = 0x7fc07fc0u; w.y = 0x7fc07fc0u; } *(u32x2v*)(xn + off + bj * HALF + n * 16) = w; }
                asm volatile("" ::: "memory"); }
    }
};

template <bool F16> __device__ __forceinline__ f32x4 mma16(bf16x8 b, bf16x8 a, f32x4 c) {
    if constexpr (F16) { typedef _Float16 h8_t __attribute__((ext_vector_type(8))); return __builtin_amdgcn_mfma_f32_16x16x32_f16(__builtin_bit_cast(h8_t, b), __builtin_bit_cast(h8_t, a), c, 0, 0, 0); }
    else return __builtin_amdgcn_mfma_f32_16x16x32_bf16(b, a, c, 0, 0, 0);
}
template <class Epi, class Sched, bool ALIGN_EPI = false, bool SP2 = false, bool F16 = false>
__device__ __forceinline__ void gemm_phase(PG8_LAS unsigned char* lds, const Gemm g, const Sched& S, const Epi& E) {
#ifdef NO_GEMM
    return;
#endif
    int tid_l = threadIdx.x; asm volatile("" : "+v"(tid_l));
    const int tid = tid_l, wid = __builtin_amdgcn_readfirstlane(tid >> 6), lane = tid & 63, wr = wid >> 2, wc = wid & 3, fr = lane & 15, fq = lane >> 4;
    const int K = g.K, nt = K / BK;
    unsigned voffA[2], voffB[2];
#pragma unroll
    for (int i = 0; i < 2; ++i) { int R, C; stage_rc(tid * 16 + i * 8192, R, C); const int Rb = Epi::PERM ? ((R & ~31) + perm32(R & 31)) : R;
        voffA[i] = (unsigned)(R * K + C) * 2u; voffB[i] = (unsigned)(Rb * K + C) * 2u; }
    const size_t kstep = (size_t)(BK * 2);
    const size_t hstep = (size_t)HALF * K * 2;
    const size_t tstep = 2 * hstep;
    const unsigned ldsw = (unsigned)wid * 1024u;
    const int aoff = lds_byte(wr * 64 + fr, fq * 8), boff = lds_byte(wc * 32 + fr, fq * 8);
#define PG8_SA(b, h) (((b) * 2 + (h)) * HTB)
#define PG8_SB(b, h) ((4 + (b) * 2 + (h)) * HTB)
#define PG8_STAGE(bufoff, gbase, voff) do { _Pragma("unroll") for (int _i = 0; _i < 2; ++_i) \
        __builtin_amdgcn_global_load_lds((const unsigned*)((const char*)(gbase) + (voff)[_i]), (PG8_LAS unsigned*)(lds + (bufoff) + ldsw + _i * 8192), 16, 0, 0); } while (0)
#define PG8_LDA(dst, b, h) do { _Pragma("unroll") for (int m = 0; m < 4; ++m) _Pragma("unroll") for (int k = 0; k < 2; ++k) dst[m][k] = *(const PG8_LAS bf16x8*)(lds + PG8_SA(b, h) + aoff + m * 2048 + k * 1024); } while (0)
#define PG8_LDB(dst, b, h) do { _Pragma("unroll") for (int n = 0; n < 2; ++n) _Pragma("unroll") for (int k = 0; k < 2; ++k) dst[n][k] = *(const PG8_LAS bf16x8*)(lds + PG8_SB(b, h) + boff + n * 2048 + k * 1024); } while (0)
#define PG8_MMA(ai, bj, At, Bt) do { __builtin_amdgcn_s_setprio(1); _Pragma("unroll") for (int m = 0; m < 4; ++m) _Pragma("unroll") for (int n = 0; n < 2; ++n) _Pragma("unroll") for (int k = 0; k < 2; ++k) \
        acc[ai][bj][m][n] = mma16<F16>(Bt[n][k], At[m][k], acc[ai][bj][m][n]); __builtin_amdgcn_s_setprio(0); } while (0)
#define PG8_WAIT_V(n) asm volatile("s_waitcnt vmcnt(" #n ")" ::: "memory")
#define PG8_WAIT_L(n) asm volatile("s_waitcnt lgkmcnt(" #n ")" ::: "memory")
#define PG8_BAR __builtin_amdgcn_s_barrier()
#define PG8_SCHED __builtin_amdgcn_sched_barrier(0)
    Unit cur, nxt; int ui = 0;
    if (!S.next(0, cur)) return;
    f32x4 acc[2][2][4][2];
#pragma unroll
    for (int a = 0; a < 2; ++a)
#pragma unroll
        for (int b = 0; b < 2; ++b)
#pragma unroll
            for (int m = 0; m < 4; ++m)
#pragma unroll
                for (int n = 0; n < 2; ++n) acc[a][b][m][n] = (f32x4){0.f, 0.f, 0.f, 0.f};
    bf16x8 At[4][2], B0[2][2], B1[2][2];
    const char* cA = (const char*)g.A + (size_t)cur.pm * tstep; const char* cB = (const char*)g.Bt + (size_t)cur.pn * tstep;
    S.a_ready(cur);
    if constexpr (SP2) {
        PG8_STAGE(PG8_SB(0, 0), cB, voffB); PG8_STAGE(PG8_SB(0, 1), cB + hstep, voffB); PG8_STAGE(PG8_SA(0, 0), cA, voffA); PG8_STAGE(PG8_SA(0, 1), cA + hstep, voffA);
        if (wr == 1) PG8_BAR;
        PG8_WAIT_V(2); PG8_BAR;
        PG8_STAGE(PG8_SB(1, 0), cB + kstep, voffB); PG8_STAGE(PG8_SA(1, 0), cA + kstep, voffA); PG8_STAGE(PG8_SB(1, 1), cB + hstep + kstep, voffB);
        PG8_WAIT_V(6); PG8_BAR;
    } else {
        PG8_STAGE(PG8_SB(0, 0), cB, voffB); PG8_STAGE(PG8_SA(0, 0), cA, voffA); PG8_STAGE(PG8_SB(0, 1), cB + hstep, voffB); PG8_STAGE(PG8_SA(0, 1), cA + hstep, voffA);
        if (wr == 1) PG8_BAR;
        PG8_WAIT_V(4); PG8_BAR;
        PG8_STAGE(PG8_SB(1, 0), cB + kstep, voffB); PG8_STAGE(PG8_SA(1, 0), cA + kstep, voffA); PG8_STAGE(PG8_SB(1, 1), cB + hstep + kstep, voffB);
        PG8_WAIT_V(6); PG8_BAR;
    }
    for (;;) {
        const bool has_next = S.next(ui + 1, nxt);
        const char* nA = has_next ? (const char*)g.A + (size_t)nxt.pm * tstep : cA; const char* nB = has_next ? (const char*)g.Bt + (size_t)nxt.pn * tstep : cB;
        for (int t = 0; t < nt; t += 2) {
            const bool last = (t == nt - 2);
            const char* a1 = cA + (size_t)(t + 1) * kstep;
            const char* a2 = last ? nA : cA + (size_t)(t + 2) * kstep; const char* b2 = last ? nB : cB + (size_t)(t + 2) * kstep;
            const char* a3 = a2 + kstep; const char* b3 = b2 + kstep;
            if (last && has_next) S.a_ready(nxt);
            if constexpr (SP2) {
            PG8_LDB(B0, 0, 0); PG8_LDB(B1, 0, 1); PG8_SCHED; PG8_LDA(At, 0, 0); PG8_STAGE(PG8_SA(1, 1), a1 + hstep, voffA);
            PG8_WAIT_V(8); PG8_WAIT_L(0); PG8_BAR; PG8_MMA(0, 0, At, B0); PG8_MMA(0, 1, At, B1); PG8_BAR; PG8_SCHED;
            PG8_LDA(At, 0, 1); PG8_STAGE(PG8_SB(0, 0), b2, voffB); PG8_STAGE(PG8_SB(0, 1), b2 + hstep, voffB); PG8_STAGE(PG8_SA(0, 0), a2, voffA);
            PG8_WAIT_V(8); PG8_WAIT_L(0); PG8_BAR; PG8_MMA(1, 0, At, B0); PG8_MMA(1, 1, At, B1); PG8_BAR; PG8_SCHED;
            PG8_LDB(B0, 1, 0); PG8_LDB(B1, 1, 1); PG8_SCHED; PG8_LDA(At, 1, 0); PG8_STAGE(PG8_SA(0, 1), a2 + hstep, voffA);
            PG8_WAIT_V(8); PG8_WAIT_L(0); PG8_BAR; PG8_MMA(0, 0, At, B0); PG8_MMA(0, 1, At, B1); PG8_BAR; PG8_SCHED;
            PG8_LDA(At, 1, 1); PG8_STAGE(PG8_SB(1, 0), b3, voffB); PG8_STAGE(PG8_SB(1, 1), b3 + hstep, voffB); PG8_STAGE(PG8_SA(1, 0), a3, voffA);
            PG8_WAIT_V(8); PG8_WAIT_L(0); PG8_BAR; PG8_MMA(1, 0, At, B0); PG8_MMA(1, 1, At, B1); PG8_BAR; PG8_SCHED;
            } else {
            PG8_LDB(B0, 0, 0); PG8_SCHED; PG8_LDA(At, 0, 0); PG8_STAGE(PG8_SA(1, 1), a1 + hstep, voffA);
            PG8_WAIT_L(8); PG8_BAR; PG8_WAIT_L(0); PG8_MMA(0, 0, At, B0); PG8_BAR; PG8_SCHED;
            PG8_LDB(B1, 0, 1); PG8_STAGE(PG8_SB(0, 0), b2, voffB);
            PG8_BAR; PG8_WAIT_L(0); PG8_MMA(0, 1, At, B1); PG8_BAR;
            PG8_LDA(At, 0, 1); PG8_STAGE(PG8_SA(0, 0), a2, voffA);
            PG8_BAR; PG8_WAIT_L(0); PG8_MMA(1, 0, At, B0); PG8_BAR; PG8_SCHED;
            PG8_STAGE(PG8_SB(0, 1), b2 + hstep, voffB);
            PG8_WAIT_V(6); PG8_BAR; PG8_MMA(1, 1, At, B1); PG8_BAR;
            PG8_LDB(B0, 1, 0); PG8_SCHED; PG8_LDA(At, 1, 0); PG8_STAGE(PG8_SA(0, 1), a2 + hstep, voffA);
            PG8_WAIT_L(8); PG8_BAR; PG8_WAIT_L(0); PG8_MMA(0, 0, At, B0); PG8_BAR; PG8_SCHED;
            PG8_LDB(B1, 1, 1); PG8_STAGE(PG8_SB(1, 0), b3, voffB);
            PG8_BAR; PG8_WAIT_L(0); PG8_MMA(0, 1, At, B1); PG8_BAR;
            PG8_LDA(At, 1, 1); PG8_STAGE(PG8_SA(1, 0), a3, voffA);
            PG8_BAR; PG8_WAIT_L(0); PG8_MMA(1, 0, At, B0); PG8_BAR; PG8_SCHED;
            PG8_STAGE(PG8_SB(1, 1), b3 + hstep, voffB);
            PG8_WAIT_V(6); PG8_BAR; PG8_MMA(1, 1, At, B1); PG8_BAR;
            }
        }
        if constexpr (ALIGN_EPI) { if (wr == 0) PG8_BAR; }
        if constexpr (!Epi::AFTER_DRAIN) { E(acc, cur, wr, wc, fr, fq); S.done(cur); }
        if (!has_next) break;
#pragma unroll
        for (int a = 0; a < 2; ++a)
#pragma unroll
            for (int b = 0; b < 2; ++b)
#pragma unroll
                for (int m = 0; m < 4; ++m)
#pragma unroll
                    for (int n = 0; n < 2; ++n) acc[a][b][m][n] = (f32x4){0.f, 0.f, 0.f, 0.f};
        cur = nxt; cA = nA; cB = nB; ++ui;
        if constexpr (ALIGN_EPI) { if (wr == 1) PG8_BAR; }
    }
    PG8_WAIT_V(0);
    if constexpr (!ALIGN_EPI) { if (wr == 0) PG8_BAR; }
    PG8_BAR;
    if constexpr (Epi::AFTER_DRAIN) { E.fused(acc, cur, wr, wc, fr, fq, lds, wid, lane); S.done(cur); }
#undef PG8_SA
#undef PG8_SB
#undef PG8_STAGE
#undef PG8_LDA
#undef PG8_LDB
#undef PG8_MMA
#undef PG8_WAIT_V
#undef PG8_WAIT_L
#undef PG8_BAR
#undef PG8_SCHED
}
}

#ifndef PG8_SP2
#define PG8_SP2 true
#endif
#ifndef PG8_ALIGN
#define PG8_ALIGN true
#endif
namespace pg8 {
template <int ACT> struct EpiSplit {
    static constexpr bool PERM = true, AFTER_DRAIN = false;
    bf16_t* O; int ldc; int split_cols; size_t split_stride; int scale_t; float scale0; const float* ss;
    __device__ __forceinline__ void operator()(const f32x4 (&acc)[2][2][4][2], const Unit& u, int wr, int wc, int fr, int fq) const {
        const int row0 = u.pm * BM + wr * 64 + fr; int colt = u.pn * BM; bf16_t* base = O;
        float sc = 1.f; if (split_cols) { const int t = colt / split_cols; base += (size_t)t * split_stride; colt -= t * split_cols; if (t == scale_t) sc = scale0; }
        const int col0 = colt + wc * 32 + 8 * fq;
        float rs[2][4];
        if (ACT != 2) { f32x4 pp[2][4];
#pragma unroll
        for (int ai = 0; ai < 2; ++ai)
#pragma unroll
            for (int m = 0; m < 4; ++m) pp[ai][m] = *(const f32x4*)(ss + (size_t)(row0 + ai * HALF + m * 16) * 16 + 4 * fq);
        asm volatile("" ::: "memory");
#pragma unroll
        for (int ai = 0; ai < 2; ++ai)
#pragma unroll
            for (int m = 0; m < 4; ++m) { const f32x4 p = pp[ai][m]; float sq = (p[0] + p[1]) + (p[2] + p[3]);
                sq += __uint_as_float((unsigned)__builtin_amdgcn_ds_swizzle((int)__float_as_uint(sq), (16 << 10) | 0x1f));
                { auto rr = __builtin_amdgcn_permlane32_swap(__float_as_uint(sq), __float_as_uint(sq), false, false); sq = __uint_as_float(rr[0]) + __uint_as_float(rr[1]); }
                rs[ai][m] = __builtin_amdgcn_rsqf(sq * (1.0f / 1024.0f) + 1e-6f); } }
        else {
#pragma unroll
            for (int ai = 0; ai < 2; ++ai)
#pragma unroll
                for (int m = 0; m < 4; ++m) rs[ai][m] = 1.0f; }
#pragma unroll
        for (int ai = 0; ai < 2; ++ai)
#pragma unroll
            for (int m = 0; m < 4; ++m) { bf16_t* rowp = base + (size_t)(row0 + ai * HALF + m * 16) * ldc + col0;
#pragma unroll
                for (int bj = 0; bj < 2; ++bj) { f32x4 v0 = acc[ai][bj][m][0] * rs[ai][m], v1 = acc[ai][bj][m][1] * rs[ai][m];
                    if (ACT == 2) {
#pragma unroll
                        for (int e = 0; e < 4; ++e) { const float a = fmaxf(v0[e], 0.f), b = fmaxf(v1[e], 0.f); v0[e] = a * a; v1[e] = b * b; } }
                    v0 = v0 * sc; v1 = v1 * sc; u32x4 w; w.x = cvt_pk_bf16(v0[0], v0[1]); w.y = cvt_pk_bf16(v0[2], v0[3]); w.z = cvt_pk_bf16(v1[0], v1[1]); w.w = cvt_pk_bf16(v1[2], v1[3]);
                    *(u32x4*)(rowp + bj * HALF) = w; } }
    }
};
struct EpiOddIn {
    static constexpr bool PERM = true, AFTER_DRAIN = false;
    bf16_t *Q, *K, *V, *G; const float* ss;
    __device__ __forceinline__ void operator()(const f32x4 (&acc)[2][2][4][2], const Unit& u, int wr, int wc, int fr, int fq) const {
        const int row0 = u.pm * BM + wr * 64 + fr; const int pn = u.pn; bf16_t* base; int ldc, colt;
        if (pn < 4) { base = Q; ldc = 1024; colt = pn * BM; } else if (pn < 8) { base = K; ldc = 1024; colt = (pn - 4) * BM; }
        else if (pn < 16) { base = V; ldc = 2048; colt = (pn - 8) * BM; } else { base = G; ldc = 2048; colt = (pn - 16) * BM; }
        const int col0 = colt + wc * 32 + 8 * fq;
        float rs[2][4]; f32x4 pp[2][4];
#pragma unroll
        for (int ai = 0; ai < 2; ++ai)
#pragma unroll
            for (int m = 0; m < 4; ++m) pp[ai][m] = *(const f32x4*)(ss + (size_t)(row0 + ai * HALF + m * 16) * 16 + 4 * fq);
        asm volatile("" ::: "memory");
#pragma unroll
        for (int ai = 0; ai < 2; ++ai)
#pragma unroll
            for (int m = 0; m < 4; ++m) { const f32x4 p = pp[ai][m]; float sq = (p[0] + p[1]) + (p[2] + p[3]);
                sq += __uint_as_float((unsigned)__builtin_amdgcn_ds_swizzle((int)__float_as_uint(sq), (16 << 10) | 0x1f));
                { auto rr = __builtin_amdgcn_permlane32_swap(__float_as_uint(sq), __float_as_uint(sq), false, false); sq = __uint_as_float(rr[0]) + __uint_as_float(rr[1]); }
                rs[ai][m] = __builtin_amdgcn_rsqf(sq * (1.0f / 1024.0f) + 1e-6f); }
#pragma unroll
        for (int ai = 0; ai < 2; ++ai)
#pragma unroll
            for (int m = 0; m < 4; ++m) { bf16_t* rowp = base + (size_t)(row0 + ai * HALF + m * 16) * ldc + col0;
#pragma unroll
                for (int bj = 0; bj < 2; ++bj) { const f32x4 v0 = acc[ai][bj][m][0] * rs[ai][m], v1 = acc[ai][bj][m][1] * rs[ai][m];
                    u32x4 w; w.x = cvt_pk_bf16(v0[0], v0[1]); w.y = cvt_pk_bf16(v0[2], v0[3]); w.z = cvt_pk_bf16(v1[0], v1[1]); w.w = cvt_pk_bf16(v1[2], v1[3]);
                    *(u32x4*)(rowp + bj * HALF) = w; } }
    }
};
__device__ __forceinline__ unsigned cvt_pk_f16(float lo, float hi) { typedef _Float16 h2_t __attribute__((ext_vector_type(2))); const h2_t v = {(_Float16)lo, (_Float16)hi}; return __builtin_bit_cast(unsigned, v); }
__device__ __forceinline__ float f16lo(unsigned w) { typedef _Float16 h2_t __attribute__((ext_vector_type(2))); return (float)__builtin_bit_cast(h2_t, w)[0]; }
__device__ __forceinline__ float f16hi(unsigned w) { typedef _Float16 h2_t __attribute__((ext_vector_type(2))); return (float)__builtin_bit_cast(h2_t, w)[1]; }
#ifndef STREAM_F16
#define STREAM_F16 0
#endif
__device__ __forceinline__ unsigned st_pk(float lo, float hi) { return STREAM_F16 ? cvt_pk_f16(lo, hi) : cvt_pk_bf16(lo, hi); }
__device__ __forceinline__ float st_lo(unsigned w) { return STREAM_F16 ? f16lo(w) : __uint_as_float(w << 16); }
__device__ __forceinline__ float st_hi(unsigned w) { return STREAM_F16 ? f16hi(w) : __uint_as_float(w & 0xffff0000u); }
template <bool BASEF32> struct EpiRes {
    static constexpr bool PERM = false, AFTER_DRAIN = false;
    const float* basef; bf16_t* xb; int ldc; float* ss; const float* ss2;
    __device__ __forceinline__ void operator()(const f32x4 (&acc)[2][2][4][2], const Unit& u, int wr, int wc, int fr, int fq) const {
        typedef unsigned u32x2e __attribute__((ext_vector_type(2)));
        const int col0 = u.pn * BM + wc * 32 + 4 * fq;
#pragma unroll
        for (int ai = 0; ai < 2; ++ai)
#pragma unroll
        for (int mh = 0; mh < 2; ++mh) {
            f32x4 bs[2][2][2], pq[2]; float r2[2];
#pragma unroll
            for (int mm = 0; mm < 2; ++mm) { const int m = 2 * mh + mm; const size_t row = (size_t)(u.pm * BM + ai * HALF + wr * 64 + m * 16 + fr), off = row * ldc + col0;
                if (ss2) pq[mm] = *(const f32x4*)(ss2 + row * 16 + 4 * fq);
#pragma unroll
                for (int bj = 0; bj < 2; ++bj)
#pragma unroll
                    for (int n = 0; n < 2; ++n) {
                        if (BASEF32) bs[mm][bj][n] = *(const f32x4*)(basef + off + bj * HALF + n * 16);
                        else { const u32x2e w = *(const u32x2e*)(xb + off + bj * HALF + n * 16);
                            bs[mm][bj][n] = (f32x4){st_lo(w.x), st_hi(w.x), st_lo(w.y), st_hi(w.y)}; } } }
            asm volatile("" ::: "memory");
#pragma unroll
            for (int mm = 0; mm < 2; ++mm) { r2[mm] = 1.0f;
                if (ss2) { const f32x4 p = pq[mm]; float t = (p[0] + p[1]) + (p[2] + p[3]);
                    t += __uint_as_float((unsigned)__builtin_amdgcn_ds_swizzle((int)__float_as_uint(t), (16 << 10) | 0x1f));
                    { auto rr = __builtin_amdgcn_permlane32_swap(__float_as_uint(t), __float_as_uint(t), false, false); t = __uint_as_float(rr[0]) + __uint_as_float(rr[1]); }
                    r2[mm] = __builtin_amdgcn_rcpf(t * (1.0f / 1024.0f) + 1e-6f); } }
#pragma unroll
            for (int mm = 0; mm < 2; ++mm) { const int m = 2 * mh + mm; const size_t row = (size_t)(u.pm * BM + ai * HALF + wr * 64 + m * 16 + fr), off = row * ldc + col0;
                float sq = 0.f;
#pragma unroll
                for (int bj = 0; bj < 2; ++bj)
#pragma unroll
                    for (int n = 0; n < 2; ++n) { const f32x4 xn = bs[mm][bj][n] + acc[ai][bj][m][n] * r2[mm];
                        u32x2e w; w.x = st_pk(xn[0], xn[1]); w.y = st_pk(xn[2], xn[3]); *(u32x2e*)(xb + off + bj * HALF + n * 16) = w;
                        sq += (xn[0] * xn[0] + xn[1] * xn[1]) + (xn[2] * xn[2] + xn[3] * xn[3]); }
                sq += __uint_as_float((unsigned)__builtin_amdgcn_ds_swizzle((int)__float_as_uint(sq), (16 << 10) | 0x1f));
                { auto rr = __builtin_amdgcn_permlane32_swap(__float_as_uint(sq), __float_as_uint(sq), false, false); sq = __uint_as_float(rr[0]) + __uint_as_float(rr[1]); }
                if (fq == 0) ss[row * 16 + u.pn * 4 + wc] = sq; }
            asm volatile("" ::: "memory");
        }
    }
};
}
#include <hip/hip_bf16.h>
#include <cmath>
namespace attn_body {
using bf16=__hip_bfloat16;
using bf16x8=__attribute__((ext_vector_type(8)))short;
using s16x4=__attribute__((ext_vector_type(4)))short;
using f32x16=__attribute__((ext_vector_type(16)))float;
using u32x4=__attribute__((ext_vector_type(4)))unsigned;
constexpr int BATCH=16,NHEAD=8,SEQ=4096,D=64,DM=NHEAD*D,ODM=1024;
constexpr int NW=8,QBLK=32,QB=QBLK*NW,KVBLK=64,NQB=SEQ/QB;
constexpr int ATTN_PITCH=DM, ATTN_UNIT_ROWS=QB;
__device__ __forceinline__ int crow(int r,int hi){return (r&3)+8*(r>>2)+4*hi;}
#define SBAR() __builtin_amdgcn_sched_barrier(0)
__device__ __forceinline__ void cmask(f32x16&p0,f32x16&p1,int jb,int qrel,int hi){
  const float NEG=-INFINITY; int kb=64*jb+4*hi;
  #pragma unroll
  for(int r=0;r<16;++r){int kv=kb+(r&3)+8*(r>>2); if(kv>qrel)p0[r]=NEG; if(kv+32>qrel)p1[r]=NEG;}
}

constexpr int NSLOT=3, SLOTB=8192;
constexpr int LDS_K=0, LDS_V=NSLOT*SLOTB, LDS_WS=2*NSLOT*SLOTB, LDS_OST=LDS_WS+NW*64*4, LDS_CUM=LDS_OST+NW*4096,LDS_KN=LDS_CUM+SEQ*4,LDS_BYTES=LDS_KN+256;
constexpr float C2=0.125f*1.4426950408889634f;
__device__ __forceinline__ void glds16(const void*gsrc,unsigned lds_dst){unsigned keep;
  asm volatile("s_mov_b32 %0, m0\n\ts_mov_b32 m0, %2\n\ts_nop 0\n\tglobal_load_lds_dwordx4 %1, off\n\ts_mov_b32 m0, %0":"=&s"(keep):"v"(gsrc),"s"(lds_dst):"memory");}
__device__ __forceinline__ float max3f(float a,float b,float c){float r;asm("v_max3_f32 %0, %1, %2, %3":"=v"(r):"v"(a),"v"(b),"v"(c));return r;}
__device__ __forceinline__ float max2f(float a,float b){float r;asm("v_max_f32_e32 %0, %1, %2":"=v"(r):"v"(a),"v"(b));return r;}
__device__ __forceinline__ float fadd_s(float a,float b){float r;asm("v_add_f32_e32 %0, %1, %2":"=v"(r):"v"(a),"v"(b));return r;}
__device__ __forceinline__ float fsub_s(float a,float b){float r;asm("v_sub_f32_e32 %0, %1, %2":"=v"(r):"v"(a),"v"(b));return r;}
typedef float f32x2_t __attribute__((ext_vector_type(2))); typedef __bf16 bf16x2_t __attribute__((ext_vector_type(2)));
__device__ __forceinline__ unsigned cvtpk_s(float lo,float hi){f32x2_t v={lo,hi};bf16x2_t b=__builtin_convertvector(v,bf16x2_t);return __builtin_bit_cast(unsigned,b);}
#define WAIT_BAR(N) asm volatile("s_waitcnt vmcnt(" #N ") lgkmcnt(0)\n\ts_barrier":::"memory")

__device__ __forceinline__ void qkt(f32x16&p0,f32x16&p1,const char*Kslot,const bf16x8*qr,const f32x16&negm,int r32,int hi){
  const char*kb=Kslot+hi*1024+r32*16;
  #pragma unroll
  for(int d0=0;d0<4;++d0){
    const bf16x8 b0=*reinterpret_cast<const bf16x8*>(kb+d0*2048);
    const bf16x8 b1=*reinterpret_cast<const bf16x8*>(kb+d0*2048+512);
    if(d0==0){p0=__builtin_amdgcn_mfma_f32_32x32x16_bf16(b0,qr[0],negm,0,0,0);p1=__builtin_amdgcn_mfma_f32_32x32x16_bf16(b1,qr[0],negm,0,0,0);}
    else{p0=__builtin_amdgcn_mfma_f32_32x32x16_bf16(b0,qr[d0],p0,0,0,0);p1=__builtin_amdgcn_mfma_f32_32x32x16_bf16(b1,qr[d0],p1,0,0,0);}}
}
typedef __attribute__((address_space(3))) const char* lds_cptr;
typedef short v4i16_t __attribute__((ext_vector_type(4)));
__device__ __forceinline__ void kload8(bf16x8*kf,lds_cptr kp){
  kf[0]=*(const __attribute__((address_space(3))) bf16x8*)(kp);      kf[1]=*(const __attribute__((address_space(3))) bf16x8*)(kp+512);
  kf[2]=*(const __attribute__((address_space(3))) bf16x8*)(kp+2048); kf[3]=*(const __attribute__((address_space(3))) bf16x8*)(kp+2560);
  kf[4]=*(const __attribute__((address_space(3))) bf16x8*)(kp+4096); kf[5]=*(const __attribute__((address_space(3))) bf16x8*)(kp+4608);
  kf[6]=*(const __attribute__((address_space(3))) bf16x8*)(kp+6144); kf[7]=*(const __attribute__((address_space(3))) bf16x8*)(kp+6656);
}
__device__ __forceinline__ void kload2(bf16x8*kf,lds_cptr kp,int j){ kf[2*j]=*(const __attribute__((address_space(3))) bf16x8*)(kp+j*2048); kf[2*j+1]=*(const __attribute__((address_space(3))) bf16x8*)(kp+j*2048+512); }
__device__ __forceinline__ s16x4 vtr(lds_cptr p){ return __builtin_bit_cast(s16x4,__builtin_amdgcn_ds_read_tr16_b64_v4i16((__attribute__((address_space(3))) v4i16_t*)p)); }
__device__ __forceinline__ float rowmax(const f32x16&p0,const f32x16&p1){
  float a=max3f(p0[0],p0[1],p1[0]),b=max3f(p0[2],p0[3],p1[1]);a=max3f(a,p1[2],p1[3]);
  #pragma unroll
  for(int r=4;r<16;r+=4){a=max3f(a,p0[r],p0[r+1]);b=max3f(b,p0[r+2],p0[r+3]);a=max3f(a,p1[r],p1[r+1]);b=max3f(b,p1[r+2],p1[r+3]);}
  const float m=max2f(a,b);
  auto rr=__builtin_amdgcn_permlane32_swap(__float_as_uint(m),__float_as_uint(m),false,false);
  return max2f(__uint_as_float(rr[0]),__uint_as_float(rr[1]));
}
__device__ __forceinline__ void pv(f32x16*o,int vb,bf16x8 pa0,bf16x8 pa1,bf16x8 pa2,bf16x8 pa3){
  #pragma unroll
  for(int d0=0;d0<2;++d0){s16x4 lo[4],hi[4];
    #pragma unroll
    for(int ks=0;ks<4;++ks){
      asm volatile("ds_read_b64_tr_b16 %0,%1 offset:%c2":"=&v"(lo[ks]):"v"(vb),"i"(d0*4096+ks*1024):"memory");
      asm volatile("ds_read_b64_tr_b16 %0,%1 offset:%c2":"=&v"(hi[ks]):"v"(vb),"i"(d0*4096+ks*1024+512):"memory");}
    asm volatile("s_waitcnt lgkmcnt(0)":::"memory");SBAR();
    #define PK(k) (bf16x8){lo[k][0],lo[k][1],lo[k][2],lo[k][3],hi[k][0],hi[k][1],hi[k][2],hi[k][3]}
    o[d0]=__builtin_amdgcn_mfma_f32_32x32x16_bf16(pa0,PK(0),o[d0],0,0,0);
    o[d0]=__builtin_amdgcn_mfma_f32_32x32x16_bf16(pa1,PK(1),o[d0],0,0,0);
    o[d0]=__builtin_amdgcn_mfma_f32_32x32x16_bf16(pa2,PK(2),o[d0],0,0,0);
    o[d0]=__builtin_amdgcn_mfma_f32_32x32x16_bf16(pa3,PK(3),o[d0],0,0,0);
    #undef PK
  }
}

#ifndef ATTN_STORE16
#define ATTN_STORE16(p,v) (*(u32x4*)(p)=(v))
#endif
template<int THRL> __device__ __forceinline__ void attn_unit(int b,int h,int qb,const bf16*Q,const bf16*__restrict__ K,const bf16*__restrict__ V,bf16*O,const float*__restrict__ cum,char*shm){
  int tid_l=threadIdx.x; asm volatile("":"+v"(tid_l)); const int tid=tid_l,lane=tid&63,r32=lane&31,hi=lane>>5; const int wid=__builtin_amdgcn_readfirstlane(tid>>6);
  const long rowbase=(long)b*SEQ; const int q0=qb*QB;
  const bf16*Qw=Q+(rowbase+q0+wid*QBLK)*DM+h*D;
  const bf16*Kh=K+rowbase*DM+h*D,*Vh=V+rowbase*DM+h*D;
  bf16x8 qr[4];
  _Pragma("unroll") for(int d0=0;d0<4;++d0)qr[d0]=*reinterpret_cast<const bf16x8*>(&Qw[(long)r32*DM+d0*16+hi*8]);
  typedef float f32x4c __attribute__((ext_vector_type(4)));
  __attribute__((address_space(3))) float* cks=(__attribute__((address_space(3))) float*)((__attribute__((address_space(3))) char*)shm+LDS_CUM);
  { const int nld=q0+QB, base=tid*8; f32x4c a=(f32x4c){0.f,0.f,0.f,0.f}, b4=a; if(base<nld){ a=*(const f32x4c*)(cum+base); b4=*(const f32x4c*)(cum+base+4); }
    a[1]+=a[0]; a[2]+=a[1]; a[3]+=a[2]; b4[0]+=a[3]; b4[1]+=b4[0]; b4[2]+=b4[1]; b4[3]+=b4[2];
    float inc=b4[3];
    _Pragma("unroll") for(int o_=1;o_<64;o_<<=1){ const float t_=__uint_as_float((unsigned)__builtin_amdgcn_ds_bpermute(((lane-o_)&63)*4,(int)__float_as_uint(inc))); if(lane>=o_)inc+=t_; }
    __attribute__((address_space(3))) float* wsum=(__attribute__((address_space(3))) float*)((__attribute__((address_space(3))) char*)shm+LDS_WS);
    if(lane==63)wsum[wid]=inc;
    { float ssq=0.f; _Pragma("unroll") for(int d0=0;d0<4;++d0) _Pragma("unroll") for(int e_=0;e_<8;++e_){ const float v_=__uint_as_float(((unsigned)(unsigned short)qr[d0][e_])<<16); ssq+=v_*v_; }
      { auto rr=__builtin_amdgcn_permlane32_swap(__float_as_uint(ssq),__float_as_uint(ssq),false,false); ssq=__uint_as_float(rr[0])+__uint_as_float(rr[1]); }
      #define SWMAX_(v,x) v=__builtin_fmaxf(v,__uint_as_float((unsigned)__builtin_amdgcn_ds_swizzle((int)__float_as_uint(v),((x)<<10)|0x1f)))
      SWMAX_(ssq,1); SWMAX_(ssq,2); SWMAX_(ssq,4); SWMAX_(ssq,8); SWMAX_(ssq,16);
      if(lane==0)wsum[8+wid]=ssq; }
    asm volatile("s_waitcnt lgkmcnt(0)\n\ts_barrier":::"memory");
    float off_=inc-b4[3]; _Pragma("unroll") for(int w_=0;w_<NW;++w_){ const float t_=wsum[w_]; if(w_<wid)off_+=t_; }
    if(base<nld){ const float L2E=1.4426950408889634f; *(__attribute__((address_space(3))) f32x4c*)(cks+base)=(a+off_)*L2E; *(__attribute__((address_space(3))) f32x4c*)(cks+base+4)=(b4+off_)*L2E; }
    asm volatile("s_waitcnt lgkmcnt(0)\n\ts_barrier":::"memory"); }
  int tstart=0;
  { const __attribute__((address_space(3))) float* wq=(const __attribute__((address_space(3))) float*)((__attribute__((address_space(3))) char*)shm+LDS_WS)+8;
    const __attribute__((address_space(3))) float* KN=(const __attribute__((address_space(3))) float*)((__attribute__((address_space(3))) char*)shm+LDS_KN);
    float qm=wq[0]; _Pragma("unroll") for(int w_=1;w_<NW;++w_)qm=__builtin_fmaxf(qm,wq[w_]);
    const int NT0=(q0+QB)/KVBLK, nb=NT0-4; const float kb=__builtin_fmaxf(__builtin_fmaxf(KN[NT0-4],KN[NT0-3]),__builtin_fmaxf(KN[NT0-2],KN[NT0-1]));
    const float floor_=-__builtin_sqrtf(qm*kb)-44.f, cq0=cks[q0]; bool skip=false;
    if(lane<nb){ const float ub=__builtin_sqrtf(qm*KN[lane])+cq0-cks[64*lane+63]; skip=ub<floor_; }
    const unsigned long long m_=__ballot(skip); int pre=(int)__builtin_ctzll(~m_); pre=pre<nb?pre:nb; tstart=__builtin_amdgcn_readfirstlane(pre&~1); }
  Kh+=(long)tstart*KVBLK*DM; Vh+=(long)tstart*KVBLK*DM;
  const __attribute__((address_space(3))) float* ckt=cks+tstart*KVBLK;
  #define CKSUB(P0,P1,t) do{ const __attribute__((address_space(3))) float* ckp_=ckt+(t)*64+4*hi; \
    _Pragma("unroll") for(int rr_=0;rr_<4;++rr_){ const f32x4c a_=*(const __attribute__((address_space(3))) f32x4c*)(ckp_+8*rr_); const f32x4c b_=*(const __attribute__((address_space(3))) f32x4c*)(ckp_+32+8*rr_); \
      _Pragma("unroll") for(int e_=0;e_<4;++e_){ P0[4*rr_+e_]-=a_[e_]; P1[4*rr_+e_]-=b_[e_]; } if(rr_==1)__builtin_amdgcn_sched_barrier(0); } }while(0)
  const unsigned lds0=(unsigned)(uintptr_t)shm;
  float*wsf=(float*)(shm+LDS_WS)+wid*64;
  const bf16*ksrc=Kh+(long)lane*DM+wid*8;
  const bf16*vsrc=Vh+(long)(16*(wid&3)+(lane>>2))*DM+(wid>>2)*32+(lane&3)*8;
  const unsigned kdst=lds0+LDS_K+wid*1024, vdst=lds0+LDS_V+wid*1024;
  #define DMA_K(t,slot) glds16(ksrc+(long)(t)*KVBLK*DM,(unsigned)__builtin_amdgcn_readfirstlane(kdst+(slot)))
  #define DMA_V(t,slot) glds16(vsrc+(long)(t)*KVBLK*DM,(unsigned)__builtin_amdgcn_readfirstlane(vdst+(slot)))
  const int vb0=(int)(lds0+LDS_V)+((lane>>4)&1)*32+(lane&3)*8+(4*hi+((lane&15)>>2))*64;
  const char*Kbase=shm+LDS_K; bf16x8 kf[8];
  const lds_cptr shm3=(lds_cptr)shm; const lds_cptr kp0=shm3+LDS_K+hi*1024+r32*16; const lds_cptr vp0=shm3+LDS_V+((lane>>4)&1)*32+(lane&3)*8+(4*hi+((lane&15)>>2))*64;
  const int NT=(q0+QB)/KVBLK-tstart;
  DMA_K(0,0);DMA_V(0,0);DMA_K(1,SLOTB);
  float mhat=-cks[q0+wid*QBLK+r32],l_reg=0.f;f32x16 o[2];o[0]=f32x16{};o[1]=f32x16{};f32x16 negm; _Pragma("unroll") for(int r=0;r<16;++r)negm[r]=-mhat; asm volatile("":"+v"(negm));
  const int qrel=wid*QBLK+r32;
  #define CMASK(P0,P1,t) do{int jb_=(t)-(NT-4); if(jb_>=0)cmask(P0,P1,jb_,qrel,hi);}while(0)
  bool resc=false;
  #define START(P0,P1) do{ const float rm=rowmax(P0,P1); resc=false; \
    { const float dl=rm; mhat=fadd_s(mhat,dl); \
      _Pragma("unroll") for(int r=0;r<16;++r){P0[r]=fsub_s(P0[r],dl);P1[r]=fsub_s(P1[r],dl);} \
      _Pragma("unroll") for(int r=0;r<16;++r)negm[r]=-mhat; asm volatile("":"+v"(negm)); } \
    _Pragma("unroll") for(int r=0;r<16;++r)P0[r]=__builtin_amdgcn_exp2f(P0[r]); }while(0)
  #define RESC() do{ if(resc){ asm volatile("s_waitcnt lgkmcnt(0)":::"memory"); \
      _Pragma("unroll") for(int d_=0;d_<2;++d_) _Pragma("unroll") for(int r=0;r<16;++r)o[d_][r]*=wsf[crow(r,hi)]; } }while(0)
  f32x16 pA0,pA1,pB0,pB1;
  int sl_prev=0,sl_cur=0,sl_next=SLOTB;
  #define ROT() do{sl_prev=sl_cur;sl_cur=sl_next;sl_next=(sl_next==(NSLOT-1)*SLOTB)?0:sl_next+SLOTB;}while(0)
  DMA_K(2,2*SLOTB);
  WAIT_BAR(3);
  qkt(pA0,pA1,Kbase,qr,negm,r32,hi);asm volatile("s_nop 15\n\ts_nop 7":"+v"(pA0),"+v"(pA1));CKSUB(pA0,pA1,0);CMASK(pA0,pA1,0);
  START(pA0,pA1);
  _Pragma("unroll") for(int r=0;r<16;++r)pA1[r]=__builtin_amdgcn_exp2f(pA1[r]);
  WAIT_BAR(0);
  DMA_K(3,0);DMA_V(1,SLOTB);
  ROT();
  kload8(kf,kp0+sl_cur);
  WAIT_BAR(2);
  s16x4 vlo[8],vhi[8]; u32x4 pw0,pw1,pw2,pw3;
  #define PKW(P,B) cvtpk_s(P[B],P[B+1])
  #define PAF(k) __builtin_bit_cast(bf16x8,pw##k)
  #define VFR(i) (bf16x8){vlo[i][0],vlo[i][1],vlo[i][2],vlo[i][3],vhi[i][0],vhi[i][1],vhi[i][2],vhi[i][3]}
  #define PIN(x) asm volatile("":"+v"(x))
  #define MX3(a,b,c) __builtin_fmaxf(__builtin_fmaxf((a),(b)),(c))
  #define GAPA(MF,A0,A1,A2,A3,W0,W1,PW) do{ MF; sacc+=A0; sacc+=A1; sacc+=A2; sacc+=A3; PIN(sacc); W0; W1; PIN(PW); SBAR(); }while(0)
  #define EX(v) __builtin_amdgcn_exp2f(v)
  #define GAPB(MF,X,B) do{ MF; X[B]=EX(X[B]); X[B+1]=EX(X[B+1]); X[B+2]=EX(X[B+2]); X[B+3]=EX(X[B+3]); PIN(X); SBAR(); }while(0)
  #define VRD(i) do{ vlo[i]=vtr(vp_+(((i)>>2)*4096+((i)&3)*1024)); vhi[i]=vtr(vp_+(((i)>>2)*4096+((i)&3)*1024+512)); }while(0)
  #define KRD(G,j) do{ if(G){ kload2(kf,kp0+sl_next,j); SBAR(); } }while(0)
  #define STEP(C0,C1,P0,P1,t,GK,GV,GL) do{ SBAR(); \
    const lds_cptr vp_=vp0+sl_prev; \
    VRD(0); SBAR(); float sacc=(P0[0]+P0[1]); \
    GAPA(C0=__builtin_amdgcn_mfma_f32_32x32x16_bf16(kf[0],qr[0],negm,0,0,0), P0[2],P0[3],P0[4],P0[5],     pw0[0]=PKW(P0,0), pw0[1]=PKW(P0,2), pw0); \
    VRD(4); SBAR(); GAPA(C1=__builtin_amdgcn_mfma_f32_32x32x16_bf16(kf[1],qr[0],negm,0,0,0), P0[6],P0[7],P0[8],P0[9],     pw0[2]=PKW(P0,4), pw0[3]=PKW(P0,6), pw0); \
    VRD(1); SBAR(); GAPA(C0=__builtin_amdgcn_mfma_f32_32x32x16_bf16(kf[2],qr[1],C0,0,0,0),   P0[10],P0[11],P0[12],P0[13], pw1[0]=PKW(P0,8), pw1[1]=PKW(P0,10), pw1); \
    VRD(5); SBAR(); GAPA(C1=__builtin_amdgcn_mfma_f32_32x32x16_bf16(kf[3],qr[1],C1,0,0,0),   P0[14],P0[15],P1[0],P1[1],   pw1[2]=PKW(P0,12),pw1[3]=PKW(P0,14), pw1); \
    VRD(2); SBAR(); GAPA(C0=__builtin_amdgcn_mfma_f32_32x32x16_bf16(kf[4],qr[2],C0,0,0,0),   P1[2],P1[3],P1[4],P1[5],     pw2[0]=PKW(P1,0), pw2[1]=PKW(P1,2), pw2); \
    VRD(6); SBAR(); GAPA(C1=__builtin_amdgcn_mfma_f32_32x32x16_bf16(kf[5],qr[2],C1,0,0,0),   P1[6],P1[7],P1[8],P1[9],     pw2[2]=PKW(P1,4), pw2[3]=PKW(P1,6), pw2); \
    VRD(3); SBAR(); GAPA(C0=__builtin_amdgcn_mfma_f32_32x32x16_bf16(kf[6],qr[3],C0,0,0,0),   P1[10],P1[11],P1[12],P1[13], pw3[0]=PKW(P1,8), pw3[1]=PKW(P1,10), pw3); \
    VRD(7); SBAR(); GAPA(C1=__builtin_amdgcn_mfma_f32_32x32x16_bf16(kf[7],qr[3],C1,0,0,0),   P1[14],P1[15],0.f,0.f,       pw3[2]=PKW(P1,12),pw3[3]=PKW(P1,14), pw3); \
    l_reg+=sacc; \
    if(GK){DMA_K((t)+3,sl_cur);} if(GV){DMA_V((t)+1,sl_next);} \
    CKSUB(C0,C1,t); CMASK(C0,C1,t); \
    { float a=MX3(C0[0],C0[1],C1[0]),b=MX3(C0[2],C0[3],C1[1]); a=MX3(a,C1[2],C1[3]); \
      _Pragma("unroll") for(int r=4;r<16;r+=4){a=MX3(a,C0[r],C0[r+1]);b=MX3(b,C0[r+2],C0[r+3]);a=MX3(a,C1[r],C1[r+1]);b=MX3(b,C1[r+2],C1[r+3]);} \
      float rm=__builtin_fmaxf(a,b); { auto rr=__builtin_amdgcn_permlane32_swap(__float_as_uint(rm),__float_as_uint(rm),false,false); rm=__builtin_fmaxf(__uint_as_float(rr[0]),__uint_as_float(rr[1])); } \
      resc=false; \
      if(__builtin_expect(__any(rm>(float)THRL),0)){ const float dl=__builtin_fmaxf(rm,0.f); mhat+=dl; \
        _Pragma("unroll") for(int r=0;r<16;++r){C0[r]-=dl;C1[r]-=dl;} \
        _Pragma("unroll") for(int r=0;r<16;++r)negm[r]=-mhat; asm volatile("":"+v"(negm)); \
        const float f=__builtin_amdgcn_exp2f(-dl); l_reg*=f; if(hi==0)wsf[r32]=f; resc=true; } } \
    SBAR(); \
    GAPB(o[0]=__builtin_amdgcn_mfma_f32_32x32x16_bf16(PAF(0),VFR(0),o[0],0,0,0), C0,0); \
    GAPB(o[1]=__builtin_amdgcn_mfma_f32_32x32x16_bf16(PAF(0),VFR(4),o[1],0,0,0), C0,4); \
    KRD(GL,0); GAPB(o[0]=__builtin_amdgcn_mfma_f32_32x32x16_bf16(PAF(1),VFR(1),o[0],0,0,0), C0,8); \
    KRD(GL,1); GAPB(o[1]=__builtin_amdgcn_mfma_f32_32x32x16_bf16(PAF(1),VFR(5),o[1],0,0,0), C0,12); \
    KRD(GL,2); GAPB(o[0]=__builtin_amdgcn_mfma_f32_32x32x16_bf16(PAF(2),VFR(2),o[0],0,0,0), C1,0); \
    KRD(GL,3); GAPB(o[1]=__builtin_amdgcn_mfma_f32_32x32x16_bf16(PAF(2),VFR(6),o[1],0,0,0), C1,4); \
    GAPB(o[0]=__builtin_amdgcn_mfma_f32_32x32x16_bf16(PAF(3),VFR(3),o[0],0,0,0), C1,8); \
    GAPB(o[1]=__builtin_amdgcn_mfma_f32_32x32x16_bf16(PAF(3),VFR(7),o[1],0,0,0), C1,12); \
    }while(0)
  int t=1;
  #undef CMASK
  #define CMASK(P0,P1,t) do{}while(0)
  for(;t+5<NT;t+=2){
    STEP(pB0,pB1,pA0,pA1,t,true,true,true);     WAIT_BAR(2); RESC(); ROT();
    STEP(pA0,pA1,pB0,pB1,t+1,true,true,true);   WAIT_BAR(2); RESC(); ROT();
  }
  #undef CMASK
  #define CMASK(P0,P1,t) do{int jb_=(t)-(NT-4); if(jb_>=0)cmask(P0,P1,jb_,qrel,hi);}while(0)
  #define ENDW(tt) do{ if((tt)+3<NT){WAIT_BAR(2);} else if((tt)+2<NT){WAIT_BAR(1);} else {WAIT_BAR(0);} }while(0)
  for(;t+1<NT;t+=2){
    STEP(pB0,pB1,pA0,pA1,t,(t+3<NT),(t+1<NT),(t+1<NT));       ENDW(t);   RESC(); ROT();
    STEP(pA0,pA1,pB0,pB1,t+1,(t+4<NT),(t+2<NT),(t+2<NT));     ENDW(t+1); RESC(); ROT();
  }
  STEP(pB0,pB1,pA0,pA1,NT-1,false,false,false); RESC();
  { float sacc=pB0[0]+pB0[1]; _Pragma("unroll") for(int r=2;r<16;++r)sacc+=pB0[r]; _Pragma("unroll") for(int r=0;r<16;++r)sacc+=pB1[r]; l_reg+=sacc;
    pw0=(u32x4){PKW(pB0,0),PKW(pB0,2),PKW(pB0,4),PKW(pB0,6)};pw1=(u32x4){PKW(pB0,8),PKW(pB0,10),PKW(pB0,12),PKW(pB0,14)};pw2=(u32x4){PKW(pB1,0),PKW(pB1,2),PKW(pB1,4),PKW(pB1,6)};pw3=(u32x4){PKW(pB1,8),PKW(pB1,10),PKW(pB1,12),PKW(pB1,14)};
    SBAR(); pv(o,vb0+sl_cur,PAF(0),PAF(1),PAF(2),PAF(3)); }
  #undef PKW
  #undef PAF
  #undef VFR
  #undef PIN
  #undef MX3
  #undef GAPA
  #undef GAPB
  #undef EX
  #undef VRD
  #undef KRD
  #undef STEP
  #undef ENDW
  {auto rr=__builtin_amdgcn_permlane32_swap(__float_as_uint(l_reg),__float_as_uint(l_reg),false,false);l_reg=__uint_as_float(rr[0])+__uint_as_float(rr[1]);}
  if(hi==0)wsf[32+r32]=l_reg;asm volatile("s_waitcnt lgkmcnt(0)":::"memory");
  float rli[16];
  #pragma unroll
  for(int r=0;r<16;++r)rli[r]=__builtin_amdgcn_rcpf(wsf[32+crow(r,hi)]);
  bf16*Ow=O+(rowbase+q0+wid*QBLK)*ODM+h*D;
  { bf16*stg=(bf16*)(shm+LDS_OST)+wid*2048;
    #pragma unroll
    for(int r=0;r<16;++r){const int orow=crow(r,hi);
      #pragma unroll
      for(int d0=0;d0<2;++d0)stg[orow*64+d0*32+r32]=__float2bfloat16(o[d0][r]*rli[r]);}
    asm volatile("s_waitcnt lgkmcnt(0)":::"memory");
    #pragma unroll
    for(int i=0;i<4;++i){const int row=i*8+(lane>>3),ch=lane&7; const u32x4 v=*(const u32x4*)(stg+row*64+ch*8); ATTN_STORE16(Ow+(long)row*ODM+ch*8,v);} }
  asm volatile("s_waitcnt lgkmcnt(0)\n\ts_barrier":::"memory");
  #undef CKSUB
  #undef DMA_K
  #undef DMA_V
  #undef CMASK
  #undef START
  #undef RESC
  #undef ROT
}
constexpr int ATTN_LDS_BYTES=LDS_BYTES;
struct AttnTensors { const bf16* Q; const bf16* K; const bf16* V; bf16* O; const float* CUM; };
struct AttnUnit { int bh; int qb; };
struct StaticOrder {
  int vcu;
  __device__ __forceinline__ explicit StaticOrder(int grid,int block):vcu((block%8)*(grid/8)+block/8){}
  __device__ __forceinline__ bool next(int i,AttnUnit&u)const{ if(i>=8)return false; const int s=vcu&1; u.bh=vcu>>1; const int j=7-i; u.qb=4*(j>>1)+(s==0?((j&1)?3:0):((j&1)?2:1)); return true; }
  __device__ __forceinline__ void a_ready(const AttnUnit&)const{}
  __device__ __forceinline__ void done(const AttnUnit&)const{}
};
__device__ __forceinline__ void kn_table(const bf16*K,int bh,char*shm){
  int tid_l=threadIdx.x; asm volatile("":"+v"(tid_l)); const int tid=tid_l,lane=tid&63; const bf16*kp=K+((long)(bh/NHEAD)*SEQ+8*tid)*DM+(bh%NHEAD)*D; float mx=0.f;
  _Pragma("unroll 2") for(int r=0;r<8;++r){ float ssq=0.f;
    _Pragma("unroll") for(int c=0;c<8;++c){ const u32x4 w=*reinterpret_cast<const u32x4*>(kp+(long)r*DM+c*8);
      _Pragma("unroll") for(int e_=0;e_<4;++e_){ const float lo_=__uint_as_float(w[e_]<<16), hi_=__uint_as_float(w[e_]&0xffff0000u); ssq+=lo_*lo_+hi_*hi_; } }
    mx=__builtin_fmaxf(mx,ssq); }
  #define SWMAXK_(v,x) v=__builtin_fmaxf(v,__uint_as_float((unsigned)__builtin_amdgcn_ds_swizzle((int)__float_as_uint(v),((x)<<10)|0x1f)))
  SWMAXK_(mx,1); SWMAXK_(mx,2); SWMAXK_(mx,4);
  if((lane&7)==0) ((__attribute__((address_space(3))) float*)((__attribute__((address_space(3))) char*)shm+LDS_KN))[tid>>3]=mx;
  asm volatile("s_waitcnt lgkmcnt(0)\n\ts_barrier":::"memory");
}
template<class Sched,int THRL=8> __device__ __forceinline__ void attn_phase(char*lds,const AttnTensors&T,const Sched&S){
  AttnUnit u;
  if(S.next(0,u)) kn_table(T.K,u.bh,lds);
  for(int i=0;S.next(i,u);++i){ S.a_ready(u); attn_unit<THRL>(u.bh/NHEAD,u.bh%NHEAD,u.qb,T.Q,T.K,T.V,T.O,T.CUM+(size_t)u.bh*SEQ,lds); S.done(u); }
}
#undef SBAR
#undef WAIT_BAR
}
#include <hip/hip_cooperative_groups.h>
namespace cg = cooperative_groups;
#define LAS __attribute__((address_space(3)))
typedef unsigned short bf16;
typedef unsigned v4u __attribute__((ext_vector_type(4)));
typedef unsigned v2u __attribute__((ext_vector_type(2)));
typedef float f32x4 __attribute__((ext_vector_type(4)));
typedef float f32x16 __attribute__((ext_vector_type(16)));
typedef short bf16x8 __attribute__((ext_vector_type(8)));
typedef short s16x4 __attribute__((ext_vector_type(4)));

constexpr int NWAVES = 8;
#ifndef EPIRES_ALIGN
#define EPIRES_ALIGN true
#endif
#ifndef PROBE_DOUBLE
#define PROBE_DOUBLE 0
#endif
constexpr int BATCH = 16, SEQ = 4096, DM = 1024, M = BATCH * SEQ, FF = 4096, DEPTH = 4;
constexpr int EVEN_IN = 3080, EVEN_N = 3072, ODD_IN = 6144;
constexpr float RMS_EPS = 1e-6f, GN_EPS = 1e-6f, LOG2E = 1.4426950408889634f;
constexpr size_t MiB = 1u << 20;
constexpr size_t WS_EIN = 1 * MiB, WS_EOUT = WS_EIN + 12 * MiB, WS_OIN = WS_EOUT + 4 * MiB, WS_OOUT = WS_OIN + 24 * MiB, WS_F1 = WS_OOUT + 8 * MiB, WS_F2 = WS_F1 + 32 * MiB;
constexpr size_t WS_LOGF = WS_F2 + 32 * MiB, WS_CUM = WS_LOGF + 2 * MiB, WS_LSE = WS_CUM + 2 * MiB, WS_XN = 124 * MiB, WS_ACT = 252 * MiB, WS_END = 1024 * MiB;
static_assert(WS_LSE + 6 * MiB <= WS_XN, "ws map");
constexpr size_t SEG = 64 * MiB, WS_OG = WS_ACT + 6 * SEG, WS_AO = WS_OG + 3 * SEG;
static_assert(WS_AO + 128 * MiB <= WS_END, "ws map even");
constexpr size_t WS_RQ = WS_ACT, WS_RK = WS_RQ + 128 * MiB, WS_RV = WS_RK + 128 * MiB, WS_RG = WS_RV + 256 * MiB;
static_assert(WS_RG + 256 * MiB <= WS_END, "ws map odd");
constexpr size_t WS_H = WS_ACT;
constexpr int LDS_BYTES = 147456;

__device__ __forceinline__ unsigned f2bf(float f) { unsigned u = __builtin_bit_cast(unsigned, f); return (u + 0x7fffu + ((u >> 16) & 1u)) >> 16; }
__device__ __forceinline__ unsigned pk2(float lo, float hi) { return attn_body::cvtpk_s(lo, hi); }
__device__ __forceinline__ unsigned pkh2(float lo, float hi) { return pg8::st_pk(lo, hi); }
__device__ __forceinline__ float bf2f(unsigned short b) { return __builtin_bit_cast(float, (unsigned)b << 16); }
__device__ __forceinline__ float xor32f(float v) { auto rr = __builtin_amdgcn_permlane32_swap(__float_as_uint(v), __float_as_uint(v), false, false); return __uint_as_float((threadIdx.x & 32) ? rr[0] : rr[1]); }
#define SWZ(v, x) __uint_as_float((unsigned)__builtin_amdgcn_ds_swizzle((int)__float_as_uint(v), ((x) << 10) | 0x1f))
__device__ __forceinline__ float wave_sum(float v) {
    v += SWZ(v, 1); v += SWZ(v, 2); v += SWZ(v, 4); v += SWZ(v, 8); v += SWZ(v, 16);
    auto rr = __builtin_amdgcn_permlane32_swap(__float_as_uint(v), __float_as_uint(v), false, false);
    return __uint_as_float(rr[0]) + __uint_as_float(rr[1]);
}
__device__ __forceinline__ int crow(int r, int hi) { return (r & 3) + 8 * (r >> 2) + 4 * hi; }
__device__ __forceinline__ s16x4 trrd(const LAS unsigned char* p) { typedef short v4i16_t __attribute__((ext_vector_type(4))); return __builtin_bit_cast(s16x4, __builtin_amdgcn_ds_read_tr16_b64_v4i16((LAS v4i16_t*)p)); }
#define CAT8(lo, hi) (bf16x8){lo[0], lo[1], lo[2], lo[3], hi[0], hi[1], hi[2], hi[3]}
#define LBAR() asm volatile("s_waitcnt lgkmcnt(0)\n\ts_barrier" ::: "memory")
#define MFMA32(a, b, c) __builtin_amdgcn_mfma_f32_32x32x16_bf16((a), (b), (c), 0, 0, 0)

__device__ __forceinline__ void p0_transpose_item(const float* W, int K, int N, int ldw, bf16* WT, LAS float* scr, int item, int lane, const float* gk = nullptr, bool f16 = false) {
    const int nblk = N / 32, kb = item / nblk, nb = item % nblk, k0 = 64 * kb, n0 = 32 * nb;
#pragma unroll
    for (int i = 0; i < 8; ++i) { const int idx = lane + 64 * i, kk = idx >> 3, c4 = idx & 7;
        f32x4 v = *(const f32x4*)(W + (size_t)(k0 + kk) * ldw + n0 + 4 * c4); if (gk) v = v * gk[k0 + kk];
        LAS float* d = scr + kk * 33 + 4 * c4; d[0] = v.x; d[1] = v.y; d[2] = v.z; d[3] = v.w; }
    asm volatile("s_waitcnt lgkmcnt(0)" ::: "memory");
    const int c = lane & 7;
#pragma unroll
    for (int j = 0; j < 4; ++j) { const int n = (lane >> 3) + 8 * j; const LAS float* s = scr + (8 * c) * 33 + n;
        v4u o; if (f16) { o.x = pkh2(s[0 * 33], s[1 * 33]); o.y = pkh2(s[2 * 33], s[3 * 33]); o.z = pkh2(s[4 * 33], s[5 * 33]); o.w = pkh2(s[6 * 33], s[7 * 33]); }
        else { o.x = pk2(s[0 * 33], s[1 * 33]); o.y = pk2(s[2 * 33], s[3 * 33]); o.z = pk2(s[4 * 33], s[5 * 33]); o.w = pk2(s[6 * 33], s[7 * 33]); }
        *(v4u*)(WT + (size_t)(n0 + n) * K + k0 + 8 * c) = o; }
    asm volatile("s_waitcnt lgkmcnt(0)" ::: "memory");
}
struct Ins { const float *x, *gmix, *gffn, *ewin, *ebf, *ewout, *owin, *owout, *f1, *f2, *gfin; };
__device__ __forceinline__ void p0_prologue(const Ins& in, unsigned char* ws, LAS unsigned char* lds, int gw, int NGW, int wave, int lane) {
    LAS float* scr = (LAS float*)(lds + wave * 16384);
    constexpr int I_EIN = 16 * 96, I_EOUT = 16 * 32, I_OIN = 16 * 192, I_OOUT = 32 * 32, I_F1 = 16 * 128, I_F2 = 64 * 32;
    constexpr int NITEMS = 2 * (I_EIN + I_EOUT + I_OIN + I_OOUT) + 4 * (I_F1 + I_F2);
    for (int it = gw; it < NITEMS; it += NGW) {
        int r = it;
        if (r < 2 * I_EIN) { const int i = r / I_EIN; p0_transpose_item(in.ewin + (size_t)i * DM * EVEN_IN, DM, EVEN_N, EVEN_IN, (bf16*)(ws + WS_EIN) + (size_t)i * EVEN_N * DM, scr, r % I_EIN, lane, in.gmix + (2 * i) * DM, STREAM_F16 != 0); continue; } r -= 2 * I_EIN;
        if (r < 2 * I_EOUT) { const int i = r / I_EOUT; p0_transpose_item(in.ewout + (size_t)i * DM * DM, DM, DM, DM, (bf16*)(ws + WS_EOUT) + (size_t)i * DM * DM, scr, r % I_EOUT, lane); continue; } r -= 2 * I_EOUT;
        if (r < 2 * I_OIN) { const int i = r / I_OIN; p0_transpose_item(in.owin + (size_t)i * DM * ODD_IN, DM, ODD_IN, ODD_IN, (bf16*)(ws + WS_OIN) + (size_t)i * ODD_IN * DM, scr, r % I_OIN, lane, in.gmix + (2 * i + 1) * DM, STREAM_F16 != 0); continue; } r -= 2 * I_OIN;
        if (r < 2 * I_OOUT) { const int i = r / I_OOUT; p0_transpose_item(in.owout + (size_t)i * 2 * DM * DM, 2 * DM, DM, DM, (bf16*)(ws + WS_OOUT) + (size_t)i * 2 * DM * DM, scr, r % I_OOUT, lane); continue; } r -= 2 * I_OOUT;
        if (r < 4 * I_F1) { const int i = r / I_F1; p0_transpose_item(in.f1 + (size_t)i * DM * FF, DM, FF, FF, (bf16*)(ws + WS_F1) + (size_t)i * FF * DM, scr, r % I_F1, lane, in.gffn + i * DM, STREAM_F16 != 0); continue; } r -= 4 * I_F1;
        { const int i = r / I_F2; p0_transpose_item(in.f2 + (size_t)i * FF * DM, FF, DM, DM, (bf16*)(ws + WS_F2) + (size_t)i * FF * DM, scr, r % I_F2, lane); }
    }
}

template <bool FIRST> __device__ __forceinline__ void gate_pass(const float* x, bf16* XB, float* SS, const float* g, const float* Wf  , const float* bfp, float* LOGF,
                                                               LAS unsigned char* lds, int gw, int NGW, int tid, int lane) {
    LAS float* wt = (LAS float*)lds;
    for (int idx = tid; idx < 8192; idx += NWAVES * 64) { const int k = idx >> 3, j = idx & 7; wt[j * 1024 + k] = Wf[(size_t)k * EVEN_IN + j] * g[k]; }
    __syncthreads();
    for (int m = gw; m < M; m += NGW) {
        f32x4 v[4]; float rstd;
        if (FIRST) { const f32x4* xr = (const f32x4*)(x + (size_t)m * DM) + lane; float s = 0.f;
#pragma unroll
            for (int j = 0; j < 4; ++j) { v[j] = xr[64 * j]; s += (v[j].x * v[j].x + v[j].y * v[j].y) + (v[j].z * v[j].z + v[j].w * v[j].w); }
            s = wave_sum(s); rstd = __builtin_amdgcn_rsqf(s * (1.f / DM) + RMS_EPS); if (lane < 16) SS[(size_t)m * 16 + lane] = (lane == 0) ? s : 0.f;
            v2u* o8 = (v2u*)(XB + (size_t)m * DM) + lane;
#pragma unroll
            for (int j = 0; j < 4; ++j) { v2u w; w.x = pkh2(v[j].x, v[j].y); w.y = pkh2(v[j].z, v[j].w); o8[64 * j] = w; }
        } else { const v2u* xr = (const v2u*)(XB + (size_t)m * DM) + lane;
#pragma unroll
            for (int j = 0; j < 4; ++j) { const v2u w = xr[64 * j]; v[j].x = pg8::st_lo(w.x); v[j].y = pg8::st_hi(w.x); v[j].z = pg8::st_lo(w.y); v[j].w = pg8::st_hi(w.y); }
            rstd = __builtin_amdgcn_rsqf(wave_sum((lane < 16) ? SS[(size_t)m * 16 + lane] : 0.f) * (1.f / DM) + RMS_EPS); }
        float mine = 0.f;
#pragma unroll
        for (int jj = 0; jj < 8; ++jj) { float d = 0.f;
#pragma unroll
            for (int j = 0; j < 4; ++j) { const f32x4 w = *((const LAS f32x4*)(wt + jj * 1024) + lane + 64 * j); d += (v[j].x * w.x + v[j].y * w.y) + (v[j].z * w.z + v[j].w * w.w); }
            d = wave_sum(d); if (lane == jj) mine = d; }
        if (lane < 8) { const float u = mine * rstd + bfp[lane]; LOGF[((size_t)(m >> 12) * 8 + lane) * SEQ + (m & (SEQ - 1))] = fminf(u, 0.f) - __logf(1.0f + __expf(-fabsf(u))); }
    }
    __syncthreads();
}

#define XB_TMO      128
#define XB_XCNT(j)  (256  + 64 * (j))
#define XB_XSUB(j)  (1280 + 64 * (j))
#define XB_XGEN(j)  (2304 + 64 * (j))
#define XB_TOP      3328
#define XB_TOPGEN   3392
#define XCD_BAR_WORDS 3456
#define XB_SPIN_CAP (1u << 18)

__device__ __forceinline__ unsigned xb_ld(unsigned* p)              { return __hip_atomic_load(p, __ATOMIC_RELAXED, __HIP_MEMORY_SCOPE_AGENT); }
__device__ __forceinline__ unsigned xb_add(unsigned* p, unsigned v) { return __hip_atomic_fetch_add(p, v, __ATOMIC_RELAXED, __HIP_MEMORY_SCOPE_AGENT); }
__device__ __forceinline__ unsigned xb_xcc_id() { return (unsigned)__builtin_amdgcn_s_getreg((3 << 11) | 20) & 0xFu; }
#define XB_SPIN(cond, bar) do { unsigned _sp = 0; while (cond) { __builtin_amdgcn_s_sleep(1); \
    if ((++_sp & 255u) == 0u) { if (xb_ld(&(bar)[XB_TMO])) break; if (_sp > XB_SPIN_CAP) { atomicAdd(&(bar)[XB_TMO], 1u); break; } } } } while (0)

struct XcdBarrier {
    unsigned* bar; unsigned x;
    volatile LAS unsigned* st;
};

__device__ __forceinline__ XcdBarrier xcd_barrier_post(unsigned* bar, volatile LAS unsigned* st) {
    XcdBarrier b; b.bar = bar; b.x = xb_xcc_id(); b.st = st;
    if (threadIdx.x == 0) (void)xb_add(&bar[XB_XCNT(b.x)], 1u);
    return b;
}
__device__ __forceinline__ void xcd_barrier_complete(unsigned* bar, unsigned x, unsigned& nloc, unsigned& nx) {
    const unsigned G = gridDim.x * gridDim.y * gridDim.z;
    unsigned sum, cnt, mine, sp = 0u;
    for (;;) {
        sum = 0u; cnt = 0u; mine = 0u;
#pragma unroll
        for (unsigned j = 0; j < 16; ++j) { const unsigned c = xb_ld(&bar[XB_XCNT(j)]); sum += c; cnt += (c > 0u) ? 1u : 0u; mine = (j == x) ? c : mine; }
        if (sum == G) break;
        __builtin_amdgcn_s_sleep(1);
        if ((++sp & 255u) == 0u) { if (xb_ld(&bar[XB_TMO])) break; if (sp > XB_SPIN_CAP) { atomicAdd(&bar[XB_TMO], 1u); break; } }
    }
    nloc = mine > 0u ? mine : 1u; nx = cnt > 0u ? cnt : 1u;
}

__device__ __forceinline__ void xcd_barrier(const XcdBarrier& b) {
    asm volatile("s_waitcnt vmcnt(0)" ::: "memory");
    __syncthreads();
    if (threadIdx.x == 0) {
        unsigned* bar = b.bar;
        __builtin_amdgcn_s_waitcnt(0);
        unsigned nloc = b.st[0], nx = b.st[1];
        unsigned bxx = b.x; asm volatile("" : "+s"(bxx));
        if (nloc == 0u) { xcd_barrier_complete(bar, bxx, nloc, nx); b.st[0] = nloc; b.st[1] = nx; }
        const unsigned old = xb_add(&bar[XB_XSUB(bxx)], 1u);
        const unsigned gen = old / nloc;
        if (old + 1u == (gen + 1u) * nloc) {
            __builtin_amdgcn_fence(__ATOMIC_RELEASE, "agent");
            asm volatile("s_waitcnt vmcnt(0)" ::: "memory");
            const unsigned og = xb_add(&bar[XB_TOP], 1u);
            const unsigned tg = og / nx;
            if (og + 1u == (tg + 1u) * nx) xb_add(&bar[XB_TOPGEN], 1u);
            else XB_SPIN(xb_ld(&bar[XB_TOPGEN]) == tg, bar);
            __builtin_amdgcn_fence(__ATOMIC_ACQUIRE, "agent");
            xb_add(&bar[XB_XGEN(bxx)], 1u);
            asm volatile("s_waitcnt vmcnt(0)" ::: "memory");
        } else {
            XB_SPIN(xb_ld(&bar[XB_XGEN(bxx)]) == gen, bar);
            __builtin_amdgcn_fence(__ATOMIC_ACQUIRE, "agent");
            asm volatile("s_waitcnt vmcnt(0)" ::: "memory");
        }
    }
    __syncthreads();
}

namespace dil {
constexpr int LK = 0, LV = 384 * 128, LSCR = LV + 384 * 144, LTOT = LSCR + NWAVES * 256;
static_assert(LTOT <= 131072, "dil lds");
struct U { int b, h, d, sr, win0; };
__device__ __forceinline__ U decode(int u) {
    U r; const int j = u & 15, g3 = (u >> 4) % 3, bh = u / 48; r.b = bh >> 3; r.h = bh & 7; int np;
    if (g3 == 0) { r.d = 1; r.sr = 0; np = j; } else if (g3 == 1) { r.d = 4; r.sr = j >> 2; np = j & 3; } else { r.d = 16; r.sr = j; np = 0; }
    r.win0 = (2 * np - 1) * 128; return r;
}
__device__ __forceinline__ void issue(const U& w, const bf16* Q, const bf16* K, const bf16* V, int tid, int wave, int lane, v4u (&kreg)[6], v4u (&vreg)[6], bf16x8 (&qr)[4]) {
    const unsigned rowbase = (unsigned)w.b * SEQ; const int r32 = lane & 31, hi = lane >> 5;
#pragma unroll
    for (int i = 0; i < 6; ++i) { const int idx = tid + 512 * i, j = idx >> 3, ch = idx & 7; const int sp = max(w.win0 + j, 0);
        const unsigned go = (rowbase + (unsigned)(sp * w.d + w.sr)) * 512u + w.h * 64 + ch * 8; kreg[i] = *(const v4u*)(K + go); vreg[i] = *(const v4u*)(V + go); }
    const unsigned tokq = rowbase + (unsigned)((w.win0 + 128 + 32 * wave + r32) * w.d + w.sr);
#pragma unroll
    for (int s = 0; s < 4; ++s) qr[s] = *(const bf16x8*)(Q + (tokq * 512u + w.h * 64 + 16 * s + 8 * hi));
}
__device__ __forceinline__ void stage(const U& w, LAS unsigned char* lds, int tid, const v4u (&kreg)[6], const v4u (&vreg)[6]) {
    unsigned zz_ = 0u; asm volatile("" : "+v"(zz_));
#pragma unroll
    for (int i = 0; i < 6; ++i) { const int idx = tid + 512 * i, j = idx >> 3, ch = idx & 7; const bool ok = (w.win0 + j) >= 0;
        v4u kv = kreg[i], vv = vreg[i]; if (!ok) { kv = (v4u){zz_, zz_, zz_, zz_}; vv = kv; }
        *(LAS v4u*)(lds + LK + j * 128 + ((ch ^ ((j >> 1) & 7)) * 16)) = kv;
        *(LAS v4u*)(lds + LV + j * 144 + ch * 16) = vv; }
}
__device__ __forceinline__ void compute(const U& w, int g3, const bf16x8 (&qr)[4], bf16* OG, float* LSE, LAS unsigned char* lds, int wave, int lane) {
    const int d = w.d, h = w.h, win0 = w.win0, sr = w.sr; const size_t rowbase = (size_t)w.b * SEQ; const int r32 = lane & 31, hi = lane >> 5;
    const int qrow = 128 + 32 * wave + r32; const size_t tokq = rowbase + (size_t)((win0 + qrow) * d + sr);
    f32x16 sc[5];
    const float csc = 0.125f * LOG2E, al = __builtin_amdgcn_exp2f(-(float)(h + 1)) * (float)d * LOG2E;
    const int sb = 128 + r32 - 4 * hi; const int stmax = min(128, win0 + qrow);
    const bool full = (win0 + 128 + 32 * wave) >= 128;
    float mx = -INFINITY;
#pragma unroll
    for (int j = 0; j < 5; ++j) { const int row = 32 * (wave + j) + r32; f32x16 a = {};
#pragma unroll
        for (int s = 0; s < 4; ++s) { const bf16x8 kf = *(const LAS bf16x8*)(lds + LK + row * 128 + (((2 * s + hi) ^ ((row >> 1) & 7)) * 16)); a = MFMA32(kf, qr[s], a); }
        int sbj = sb; asm volatile("" : "+v"(sbj) : "v"(a[15]));
        if (j >= 1 && j <= 3 && full) {
            const float b0 = -al * (float)sbj;
#pragma unroll
            for (int r = 0; r < 16; ++r) { const float x = __builtin_fmaf(a[r], csc, __builtin_fmaf(al, (float)(32 * j + (r & 3) + 8 * (r >> 2)), b0)); a[r] = x; mx = fmaxf(mx, x); }
        } else {
#pragma unroll
        for (int r = 0; r < 16; ++r) { const int st = sbj - (32 * j + (r & 3) + 8 * (r >> 2));
            const float x = ((unsigned)st <= (unsigned)stmax) ? (a[r] * csc - al * (float)st) : -INFINITY; a[r] = x; mx = fmaxf(mx, x); } }
        sc[j] = a; }
    { auto rr = __builtin_amdgcn_permlane32_swap(__float_as_uint(mx), __float_as_uint(mx), false, false); mx = fmaxf(__uint_as_float(rr[0]), __uint_as_float(rr[1])); }
    float l = 0.f;
#pragma unroll
    for (int j = 0; j < 5; ++j)
#pragma unroll
        for (int r = 0; r < 16; ++r) { const float p = __builtin_amdgcn_exp2f(sc[j][r] - mx); sc[j][r] = p; l += p; }
    { auto rr = __builtin_amdgcn_permlane32_swap(__float_as_uint(l), __float_as_uint(l), false, false); l = __uint_as_float(rr[0]) + __uint_as_float(rr[1]); }
    f32x16 o[2]; o[0] = f32x16{}; o[1] = f32x16{};
    const int blk = (lane >> 4) & 1, q4 = (lane & 15) >> 2, p4 = lane & 3;
#pragma unroll
    for (int j = 0; j < 5; ++j)
#pragma unroll
        for (int s = 0; s < 2; ++s) {
            v4u pw; pw.x = pk2(sc[j][8 * s + 0], sc[j][8 * s + 1]); pw.y = pk2(sc[j][8 * s + 2], sc[j][8 * s + 3]); pw.z = pk2(sc[j][8 * s + 4], sc[j][8 * s + 5]); pw.w = pk2(sc[j][8 * s + 6], sc[j][8 * s + 7]);
            const bf16x8 pa = __builtin_bit_cast(bf16x8, pw);
            const int R0 = 32 * (wave + j) + 16 * s + 4 * hi + q4;
#pragma unroll
            for (int c = 0; c < 2; ++c) { const LAS unsigned char* vp = lds + LV + R0 * 144 + (32 * c + 16 * blk) * 2 + 8 * p4;
                const s16x4 lo = trrd(vp), hh = trrd(vp + 8 * 144); o[c] = MFMA32(pa, CAT8(lo, hh), o[c]); } }
    LAS float* scr = (LAS float*)(lds + LSCR + wave * 256);
    if (hi == 0) scr[r32] = 1.0f / l;
    asm volatile("s_waitcnt lgkmcnt(0)" ::: "memory");
    if (hi == 0) LSE[tokq * 8 + h] = mx + __builtin_amdgcn_logf(l);
#pragma unroll
    for (int r = 0; r < 16; ++r) { const int qq = crow(r, hi); const float inv = scr[qq]; const size_t tok = rowbase + (size_t)((win0 + 128 + 32 * wave + qq) * d + sr);
        bf16* op = OG + tok * 512 + h * 64 + r32; op[0] = (bf16)f2bf(o[0][r] * inv); op[32] = (bf16)f2bf(o[1][r] * inv); }
}
}

namespace ret {
constexpr int C = 64, KR = 528, VR = 288, SR = 528, LK = 0, LV = C * KR, LST = LV + C * VR, LTOT = LST + 128 * SR, NCH = SEQ / C;
static_assert(LTOT <= 131072, "ret lds");
__device__ __forceinline__ void unit(int b, int h, int vs, const bf16* Q, const bf16* K, bf16* V  , LAS unsigned char* lds, int tid_, int wave, int lane_, bf16* Vst, unsigned stmask) {
    const float gam = 1.0f - __builtin_amdgcn_exp2f(-5.0f - (float)h), lg = __builtin_amdgcn_logf(gam);
    const int wr = wave >> 2, wc = wave & 3;
    asm volatile("" : "+v"(tid_));
    { unsigned zz_ = 0u; asm volatile("" : "+v"(zz_)); for (int i = tid_; i < 128 * SR / 16; i += NWAVES * 64) *(LAS v4u*)(lds + LST + i * 16) = (v4u){zz_, zz_, zz_, zz_}; }
    __builtin_amdgcn_sched_barrier(0);
    const size_t rowbase = (size_t)b * SEQ;
    f32x16 S[4];
#pragma unroll
    for (int t = 0; t < 4; ++t) S[t] = f32x16{};
    const float c0 = __builtin_amdgcn_exp2f(-lg * (float)C), gC = __builtin_amdgcn_exp2f(lg * (float)C);
    v4u kreg[4], vreg[2]; bf16x8 qr[16];
    { int tp_ = tid_; asm volatile("" : "+v"(tp_)); const int tid = tp_, r32 = tp_ & 31, hi = (tp_ >> 5) & 1;
    const unsigned kg = ((unsigned)rowbase + (unsigned)(tid >> 5)) * 1024u + h * 256 + (tid & 31) * 8;
    const unsigned vg = ((unsigned)rowbase + (unsigned)(tid >> 4)) * 2048u + h * 512 + vs * 128 + (tid & 15) * 8;
    const unsigned qg = ((unsigned)rowbase + (unsigned)(32 * wr + r32)) * 1024u + h * 256 + 8 * hi;
#pragma unroll
    for (int k = 0; k < 4; ++k) kreg[k] = *(const v4u*)(K + (kg + (unsigned)(16 * k) * 1024u));
#pragma unroll
    for (int k = 0; k < 2; ++k) vreg[k] = *(const v4u*)(V + (vg + (unsigned)(32 * k) * 2048u));
#pragma unroll
    for (int s = 0; s < 16; ++s) qr[s] = *(const bf16x8*)(Q + (qg + 16u * s)); }
    for (int ci = 0; ci < NCH; ++ci) {
        const size_t t0 = rowbase + (size_t)ci * C; const bool more = (ci + 1 < NCH);
        int tl = tid_; asm volatile("" : "+v"(tl));
        const int tid = tl, lane = tl & 63, r32 = lane & 31, hi = lane >> 5, blk = (lane >> 4) & 1, q4 = (lane & 15) >> 2, p4 = lane & 3;
        const unsigned kg = ((unsigned)rowbase + (unsigned)(tid >> 5)) * 1024u + h * 256 + (tid & 31) * 8;
        const unsigned vg = ((unsigned)rowbase + (unsigned)(tid >> 4)) * 2048u + h * 512 + vs * 128 + (tid & 15) * 8;
        const unsigned qg = ((unsigned)rowbase + (unsigned)(32 * wr + r32)) * 1024u + h * 256 + 8 * hi;
#pragma unroll
        for (int k = 0; k < 4; ++k) *(LAS v4u*)(lds + LK + ((tid >> 5) + 16 * k) * KR + (tid & 31) * 16) = kreg[k];
#pragma unroll
        for (int k = 0; k < 2; ++k) { const int t = (tid >> 4) + 32 * k; const v4u raw = vreg[k];
            const float kd = __builtin_amdgcn_exp2f(lg * (float)(C - 1 - t)) * 0.0625f; v4u w;
            w.x = pk2(__builtin_bit_cast(float, raw.x << 16) * kd, __builtin_bit_cast(float, raw.x & 0xffff0000u) * kd);
            w.y = pk2(__builtin_bit_cast(float, raw.y << 16) * kd, __builtin_bit_cast(float, raw.y & 0xffff0000u) * kd);
            w.z = pk2(__builtin_bit_cast(float, raw.z << 16) * kd, __builtin_bit_cast(float, raw.z & 0xffff0000u) * kd);
            w.w = pk2(__builtin_bit_cast(float, raw.w << 16) * kd, __builtin_bit_cast(float, raw.w & 0xffff0000u) * kd);
            *(LAS v4u*)(lds + LV + t * VR + (tid & 15) * 16) = w; }
        LBAR();
        f32x16 acc = f32x16{}, it0 = f32x16{}, it1 = f32x16{};
        const LAS unsigned char* sp = lds + LST + (32 * wc + r32) * SR + 16 * hi;
        const LAS unsigned char* kp = lds + LK + r32 * KR + 16 * hi;
        const unsigned qn = qg + (unsigned)(ci + 1) * C * 1024u;
#pragma unroll
        for (int g = 0; g < 4; ++g) {
#pragma unroll
            for (int s = 0; s < 4; ++s) { const int ks = 4 * g + s; acc = MFMA32(qr[ks], *(const LAS bf16x8*)(sp + 32 * ks), acc);
                it0 = MFMA32(*(const LAS bf16x8*)(kp + 32 * ks), qr[ks], it0); if (wr) it1 = MFMA32(*(const LAS bf16x8*)(kp + 32 * KR + 32 * ks), qr[ks], it1); }
                if (more) {
#pragma unroll
                for (int s = 0; s < 4; ++s) qr[4 * g + s] = *(const bf16x8*)(Q + (qn + 16u * (4 * g + s))); }
        }
#define PVSTEP(IT, J) do { int qv = 32 * wr + r32 - 4 * hi; asm volatile("" : "+v"(qv) : "v"(IT[15])); \
            _Pragma("unroll") for (int r = 0; r < 16; ++r) { IT[r] = ((32 * (J) + (r & 3) + 8 * (r >> 2)) <= qv) ? IT[r] * c0 : 0.f; } \
            _Pragma("unroll") for (int s = 0; s < 2; ++s) { \
                v4u pw; pw.x = pk2(IT[8 * s + 0], IT[8 * s + 1]); pw.y = pk2(IT[8 * s + 2], IT[8 * s + 3]); pw.z = pk2(IT[8 * s + 4], IT[8 * s + 5]); pw.w = pk2(IT[8 * s + 6], IT[8 * s + 7]); \
                const LAS unsigned char* vp = lds + LV + (32 * (J) + 16 * s + 4 * hi + q4) * VR + (32 * wc + 16 * blk) * 2 + 8 * p4; \
                const s16x4 lo = trrd(vp), hh = trrd(vp + 8 * VR); acc = MFMA32(__builtin_bit_cast(bf16x8, pw), CAT8(lo, hh), acc); } } while (0)
        PVSTEP(it0, 0);
        if (wr) PVSTEP(it1, 1);
#undef PVSTEP
        if (more) { const unsigned nr = (unsigned)(ci + 1) * C;
#pragma unroll
            for (int k = 0; k < 4; ++k) kreg[k] = *(const v4u*)(K + (kg + (nr + 16 * k) * 1024u));
#pragma unroll
            for (int k = 0; k < 2; ++k) vreg[k] = *(const v4u*)(V + (vg + (nr + 32 * k) * 2048u)); }
        { unsigned ob = ((unsigned)t0 + 32 * wr + 4 * hi) * 2048u + h * 512 + vs * 128 + 32 * wc + r32; asm volatile("" : "+v"(ob));
          float fb = lg * (float)(32 * wr + 4 * hi + 1); asm volatile("" : "+v"(fb));
          const float f0 = __builtin_amdgcn_exp2f(fb), g2 = gam * gam, g8 = (g2 * g2) * (g2 * g2);
          float fr4 = f0;
#pragma unroll
          for (int r4 = 0; r4 < 4; ++r4) { float f = fr4;
#pragma unroll
            for (int e = 0; e < 4; ++e) { const int r = 4 * r4 + e, dq = e + 8 * r4; Vst[(ob + (unsigned)dq * 2048u) & stmask] = (bf16)f2bf(acc[r] * f); f *= gam; }
            fr4 *= g8; } }
#pragma unroll
        for (int t = 0; t < 4; ++t) S[t] = S[t] * gC;
#pragma unroll
        for (int s = 0; s < 4; ++s) {
            const LAS unsigned char* ka = lds + LK + (16 * s + 8 * hi + q4) * KR + (32 * wave + 16 * blk) * 2 + 8 * p4;
            const s16x4 klo = trrd(ka), khi = trrd(ka + 4 * KR); const bf16x8 kf = CAT8(klo, khi);
#pragma unroll
            for (int t = 0; t < 4; ++t) { const LAS unsigned char* vb = lds + LV + (16 * s + 8 * hi + q4) * VR + (32 * t + 16 * blk) * 2 + 8 * p4;
                const s16x4 vlo = trrd(vb), vhi = trrd(vb + 4 * VR); S[t] = MFMA32(kf, CAT8(vlo, vhi), S[t]); } }
        LBAR();
#pragma unroll
        for (int t = 0; t < 4; ++t)
#pragma unroll
            for (int g4 = 0; g4 < 4; ++g4) { v2u w; w.x = pk2(S[t][4 * g4 + 0], S[t][4 * g4 + 1]); w.y = pk2(S[t][4 * g4 + 2], S[t][4 * g4 + 3]);
                *(LAS v2u*)(lds + LST + (32 * t + r32) * SR + (32 * wave + 8 * g4 + 4 * hi) * 2) = w; }
    }
    __syncthreads();
}
}

struct Args { const float* in[11]; float* out; unsigned char* ws; int pad0, pad1; };
__global__ void __launch_bounds__(NWAVES * 64, 2) fwd_mk(Args args) {
    extern __shared__ __attribute__((aligned(16))) unsigned char lds_raw[];
    cg::grid_group grid = cg::this_grid();
#define GSYNC() do { xcd_barrier(xbar); if (PROBE_DOUBLE == 11) xcd_barrier(xbar); } while (0)
#ifndef PROBE_T
#define PROBE_T 0
#endif
#define GSYNCN(id) do { GSYNC(); if (PROBE_T && bx == 0 && threadIdx.x == 0) { const unsigned long long t_ = __builtin_amdgcn_s_memrealtime(); if (PROBE_T == (id) + 1) tacc[0] += t_ - tacc[1]; tacc[1] = t_; } } while (0)
    LAS unsigned char* lds = (LAS unsigned char*)lds_raw;
    int tid = threadIdx.x, lane = tid & 63, wave = __builtin_amdgcn_readfirstlane(tid >> 6);
#define RETID() do { tid = threadIdx.x; asm volatile("" : "+v"(tid)); lane = tid & 63; wave = __builtin_amdgcn_readfirstlane(tid >> 6); bx = blockIdx.x; asm volatile("" : "+s"(bx)); vcu = (bx % 8) * (G / 8) + bx / 8; gw = vcu * NWAVES + wave; RELOAD(); } while (0)
    constexpr int G = 256; int bx = blockIdx.x, vcu = (bx % 8) * (G / 8) + bx / 8;
    int gw = vcu * NWAVES + wave; constexpr int NGW = G * NWAVES;
    LAS unsigned long long* ptab = (LAS unsigned long long*)(lds + LDS_BYTES - 128);
    LAS unsigned long long* tacc = (LAS unsigned long long*)(lds + LDS_BYTES - 160);
    if (PROBE_T && threadIdx.x == 0) { tacc[0] = 0; tacc[1] = __builtin_amdgcn_s_memrealtime(); }
    if (tid == 0) {
        ptab[0] = (unsigned long long)args.in[0]; ptab[1] = (unsigned long long)args.in[1]; ptab[2] = (unsigned long long)args.in[2]; ptab[3] = (unsigned long long)args.in[3];
        ptab[4] = (unsigned long long)args.in[4]; ptab[5] = (unsigned long long)args.in[5]; ptab[6] = (unsigned long long)args.in[6]; ptab[7] = (unsigned long long)args.in[7];
        ptab[8] = (unsigned long long)args.in[8]; ptab[9] = (unsigned long long)args.in[9]; ptab[10] = (unsigned long long)args.in[10]; ptab[11] = (unsigned long long)args.out; ptab[12] = (unsigned long long)args.ws; }
    __syncthreads();
#define GASP(T, i) ((T*)(__attribute__((address_space(1))) T*)LDP(i))
#define LDP(i) ({ const unsigned long long v_ = ptab[(i) + pz_]; (((unsigned long long)(unsigned)__builtin_amdgcn_readfirstlane((int)(v_ >> 32))) << 32) | (unsigned long long)(unsigned)__builtin_amdgcn_readfirstlane((int)(unsigned)v_); })
#define RELOAD() do { int pz_ = 0; asm volatile("" : "+v"(pz_) :: "memory"); ws = GASP(unsigned char, 12); out = GASP(float, 11); in.x = GASP(const float, 0); in.gmix = GASP(const float, 1); in.gffn = GASP(const float, 2); in.ewin = GASP(const float, 3); in.ebf = GASP(const float, 4); \
        in.ewout = GASP(const float, 5); in.owin = GASP(const float, 6); in.owout = GASP(const float, 7); in.f1 = GASP(const float, 8); in.f2 = GASP(const float, 9); in.gfin = GASP(const float, 10); \
        XN = (bf16*)(ws + WS_XN); LOGF = (float*)(ws + WS_LOGF); SSM = (float*)(ws + 1020 * MiB); SSF = (float*)(ws + WS_LSE);     LSE = (float*)(ws + WS_LSE); } while (0)
    unsigned char* ws; float* out; Ins in; bf16* XN; float* LOGF; float* SSM; float* SSF; float* LSE;
    RELOAD();
    volatile LAS unsigned* xst = (volatile LAS unsigned*)(lds + LDS_BYTES - 192);
    if (threadIdx.x == 0) { xst[0] = 0u; xst[1] = 0u; }
    __syncthreads();
    XcdBarrier xbar = xcd_barrier_post((unsigned*)ws, xst);
    p0_prologue(in, ws, lds, gw, NGW, wave, lane);
    if (PROBE_DOUBLE == 10) p0_prologue(in, ws, lds, gw, NGW, wave, lane);
    __syncthreads();
#pragma unroll 1
    for (int layer = 0; layer < DEPTH; ++layer) {
        const int li = layer >> 1; const bool even = (layer & 1) == 0;
        RETID();
#define XIN ((layer == 0) ? in.x : out)
        if (layer == 0) {
            gate_pass<true>(in.x, XN, SSM, in.gmix, in.ewin + EVEN_N, in.ebf, LOGF, lds, gw, NGW, tid, lane);
            grid.sync();
            if (PROBE_T && bx == 0 && threadIdx.x == 0) { const unsigned long long t_ = __builtin_amdgcn_s_memrealtime(); if (PROBE_T == 1) tacc[0] += t_ - tacc[1]; tacc[1] = t_; }
            RETID();
        }
#define ZERO_SS(P) do { for (int i_ = vcu * (NWAVES * 64) + tid; i_ < M; i_ += G * NWAVES * 64) (P)[i_] = 0.f; } while (0)
        if (even) {
            if (layer != 0) { gate_pass<false>(nullptr, XN, SSM, in.gmix + layer * DM, in.ewin + (size_t)li * DM * EVEN_IN + EVEN_N, in.ebf + li * 8, LOGF, lds, gw, NGW, tid, lane); RETID(); }
            { pg8::Gemm g{XN, (const bf16*)(ws + WS_EIN) + (size_t)li * EVEN_N * DM, M, EVEN_N, DM}; pg8::StaticOrder S; S.init(M, EVEN_N, G, bx);
              pg8::EpiSplit<0> E{(bf16*)(ws + WS_ACT), 512, 512, SEG / 2, 3, attn_body::C2, SSM};
              for (int rp = 0; rp < (PROBE_DOUBLE == 9 ? 2 : 1); ++rp) pg8::gemm_phase<pg8::EpiSplit<0>, pg8::StaticOrder, PG8_ALIGN, PG8_SP2, STREAM_F16 != 0>(lds, g, S, E); }
            GSYNCN(1);
            { const attn_body::AttnTensors AT{(const attn_body::bf16*)(ws + WS_ACT + 3 * SEG), (const attn_body::bf16*)(ws + WS_ACT + 4 * SEG), (const attn_body::bf16*)(ws + WS_ACT + 5 * SEG),
                                              (attn_body::bf16*)(ws + WS_AO) + 512, LOGF};
              const attn_body::StaticOrder S(G, bx);
              for (int rp = 0; rp < (PROBE_DOUBLE == 2 ? 2 : 1); ++rp) attn_body::attn_phase<attn_body::StaticOrder>((char*)lds_raw, AT, S);
 }
            __syncthreads(); RETID();
            for (int rp = 0; rp < (PROBE_DOUBLE == 1 ? 2 : 1); ++rp) {
                constexpr int NU = BATCH * 8 * 3 * 16; const bf16* QA = (const bf16*)(ws + WS_ACT); const bf16* KA = (const bf16*)(ws + WS_ACT + SEG); const bf16* VA = (const bf16*)(ws + WS_ACT + 2 * SEG);
                v4u kreg[6], vreg[6]; bf16x8 qn[4];
                dil::U cur = dil::decode(vcu); dil::issue(cur, QA, KA, VA, tid, wave, lane, kreg, vreg, qn);
                for (int u = vcu; u < NU; u += G) {
                    dil::stage(cur, lds, tid, kreg, vreg);
                    bf16x8 qc[4];
#pragma unroll
                    for (int s_ = 0; s_ < 4; ++s_) qc[s_] = qn[s_];
                    LBAR();
                    const int g3 = (u >> 4) % 3; const dil::U me = cur;
                    if (u + G < NU) { cur = dil::decode(u + G); dil::issue(cur, QA, KA, VA, tid, wave, lane, kreg, vreg, qn); }
                    dil::compute(me, g3, qc, (bf16*)(ws + WS_OG + (size_t)g3 * SEG), LSE + (size_t)g3 * M * 8, lds, wave, lane);
                    LBAR();
                }
            }
            GSYNCN(2);
            RETID();
            for (int rp = 0; rp < (PROBE_DOUBLE == 5 ? 2 : 1); ++rp)
            for (int m0 = gw; m0 < M; m0 += 4 * NGW) { const int hh = lane >> 3;
                float l0s[4], l1s[4], l2s[4]; v4u as[4], bs_[4], cs[4];
#pragma unroll
                for (int k = 0; k < 4; ++k) { const size_t m = (size_t)(m0 + k * NGW);
                    l0s[k] = LSE[m * 8 + hh]; l1s[k] = LSE[(size_t)M * 8 + m * 8 + hh]; l2s[k] = LSE[(size_t)2 * M * 8 + m * 8 + hh];
                    as[k] = *((const v4u*)((const bf16*)(ws + WS_OG) + m * 512) + lane); bs_[k] = *((const v4u*)((const bf16*)(ws + WS_OG + SEG) + m * 512) + lane); cs[k] = *((const v4u*)((const bf16*)(ws + WS_OG + 2 * SEG) + m * 512) + lane); }
                asm volatile("" ::: "memory");
#pragma unroll
                for (int k = 0; k < 4; ++k) { const size_t m = (size_t)(m0 + k * NGW); const float l0 = l0s[k], l1 = l1s[k], l2 = l2s[k]; const v4u a = as[k], bq = bs_[k], c = cs[k];
                const float mx = fmaxf(l0, fmaxf(l1, l2)); float w0 = __builtin_amdgcn_exp2f(l0 - mx), w1 = __builtin_amdgcn_exp2f(l1 - mx), w2 = __builtin_amdgcn_exp2f(l2 - mx); const float inv = 1.0f / (w0 + w1 + w2); w0 *= inv; w1 *= inv; w2 *= inv;
                v4u o;
#define CMB(f) { const float lo = w0 * __builtin_bit_cast(float, a.f << 16) + w1 * __builtin_bit_cast(float, bq.f << 16) + w2 * __builtin_bit_cast(float, c.f << 16); \
                 const float hi_ = w0 * __builtin_bit_cast(float, a.f & 0xffff0000u) + w1 * __builtin_bit_cast(float, bq.f & 0xffff0000u) + w2 * __builtin_bit_cast(float, c.f & 0xffff0000u); o.f = pk2(lo, hi_); }
                CMB(x) CMB(y) CMB(z) CMB(w)
#undef CMB
                *((v4u*)((bf16*)(ws + WS_AO) + m * 1024) + lane) = o; } }
            GSYNCN(3);
            RETID();
            { pg8::Gemm g{(const bf16*)(ws + WS_AO), (const bf16*)(ws + WS_EOUT) + (size_t)li * DM * DM, M, DM, DM}; pg8::StaticOrder S; S.init(M, DM, G, bx);
              if (layer == 0) { pg8::EpiRes<true> E{in.x, XN, DM, SSF, nullptr}; pg8::gemm_phase<pg8::EpiRes<true>, pg8::StaticOrder, EPIRES_ALIGN, PG8_SP2>(lds, g, S, E); }
              else { pg8::EpiRes<false> E{nullptr, XN, DM, SSF, nullptr}; pg8::gemm_phase<pg8::EpiRes<false>, pg8::StaticOrder, EPIRES_ALIGN, PG8_SP2>(lds, g, S, E); } }
        } else {
            RETID();
            { pg8::Gemm g{XN, (const bf16*)(ws + WS_OIN) + (size_t)li * ODD_IN * DM, M, ODD_IN, DM}; pg8::StaticOrder S; S.init(M, ODD_IN, G, bx);
              pg8::EpiOddIn E{(bf16*)(ws + WS_RQ), (bf16*)(ws + WS_RK), (bf16*)(ws + WS_RV), (bf16*)(ws + WS_RG), SSM};
              for (int rp = 0; rp < (PROBE_DOUBLE == 13 ? 2 : 1); ++rp) pg8::gemm_phase<pg8::EpiOddIn, pg8::StaticOrder, PG8_ALIGN, PG8_SP2, STREAM_F16 != 0>(lds, g, S, E); }
            GSYNCN(4);
            RETID();
            for (int u = vcu; u < BATCH * 4 * 4; u += G) { const int vs = u & 3, bh = u >> 2;
                for (int rp = (PROBE_DOUBLE == 3 ? 0 : 1); rp < 2; ++rp) ret::unit(bh >> 2, bh & 3, vs, (const bf16*)(ws + WS_RQ), (const bf16*)(ws + WS_RK), (bf16*)(ws + WS_RV), lds, tid, wave, lane, (rp == 0) ? (bf16*)ws : (bf16*)(ws + WS_RV), (rp == 0) ? 0x7ffffu : 0xffffffffu); }
            GSYNCN(5);
            RETID();
            for (int it = gw; it < M * 4; it += 4 * NGW) {
                v4u ovs[4], gvs[4]; size_t offs[4];
#pragma unroll
                for (int k = 0; k < 4; ++k) { const int i2 = it + k * NGW; offs[k] = (size_t)(i2 >> 2) * 2048 + (i2 & 3) * 512 + lane * 8;
                    ovs[k] = *(const v4u*)((const bf16*)(ws + WS_RV) + offs[k]); gvs[k] = *(const v4u*)((const bf16*)(ws + WS_RG) + offs[k]); }
                asm volatile("" ::: "memory");
#pragma unroll
                for (int k = 0; k < 4; ++k) { const v4u ov = ovs[k], gv = gvs[k];
                float o[8], gg[8];
                o[0] = __builtin_bit_cast(float, ov.x << 16); o[1] = __builtin_bit_cast(float, ov.x & 0xffff0000u); o[2] = __builtin_bit_cast(float, ov.y << 16); o[3] = __builtin_bit_cast(float, ov.y & 0xffff0000u);
                o[4] = __builtin_bit_cast(float, ov.z << 16); o[5] = __builtin_bit_cast(float, ov.z & 0xffff0000u); o[6] = __builtin_bit_cast(float, ov.w << 16); o[7] = __builtin_bit_cast(float, ov.w & 0xffff0000u);
                gg[0] = __builtin_bit_cast(float, gv.x << 16); gg[1] = __builtin_bit_cast(float, gv.x & 0xffff0000u); gg[2] = __builtin_bit_cast(float, gv.y << 16); gg[3] = __builtin_bit_cast(float, gv.y & 0xffff0000u);
                gg[4] = __builtin_bit_cast(float, gv.z << 16); gg[5] = __builtin_bit_cast(float, gv.z & 0xffff0000u); gg[6] = __builtin_bit_cast(float, gv.w << 16); gg[7] = __builtin_bit_cast(float, gv.w & 0xffff0000u);
                float s = 0.f;
#pragma unroll
                for (int e = 0; e < 8; ++e) s += o[e];
                const float mu = wave_sum(s) * (1.f / 512.f); float q = 0.f;
#pragma unroll
                for (int e = 0; e < 8; ++e) { o[e] -= mu; q += o[e] * o[e]; }
                const float rs = 1.0f / sqrtf(wave_sum(q) * (1.f / 512.f) + GN_EPS);
                float y[8];
#pragma unroll
                for (int e = 0; e < 8; ++e) y[e] = gg[e] / (1.0f + __expf(-gg[e])) * (o[e] * rs);
                v4u w; w.x = pk2(y[0], y[1]); w.y = pk2(y[2], y[3]); w.z = pk2(y[4], y[5]); w.w = pk2(y[6], y[7]);
                *(v4u*)((bf16*)(ws + WS_RG) + offs[k]) = w; } }
            GSYNCN(6);
            RETID();
            { pg8::Gemm g{(const bf16*)(ws + WS_RG), (const bf16*)(ws + WS_OOUT) + (size_t)li * 2 * DM * DM, M, DM, 2 * DM}; pg8::StaticOrder S; S.init(M, DM, G, bx);
              pg8::EpiRes<false> E{nullptr, XN, DM, SSF, nullptr}; pg8::gemm_phase<pg8::EpiRes<false>, pg8::StaticOrder, EPIRES_ALIGN, PG8_SP2>(lds, g, S, E); }
        }
        GSYNCN(7);
        RETID();
        if (PROBE_DOUBLE == 20) { const unsigned long long t0_ = __builtin_amdgcn_s_memrealtime(); while (__builtin_amdgcn_s_memrealtime() - t0_ < 25000ull) __builtin_amdgcn_s_sleep(16); }
        { pg8::Gemm g{XN, (const bf16*)(ws + WS_F1) + (size_t)layer * FF * DM, M, FF, DM}; pg8::StaticOrder S; S.init(M, FF, G, bx);
          pg8::EpiSplit<2> E{(bf16*)(ws + WS_H), FF, 0, 0, -1, 1.f, SSF};
          for (int rp = 0; rp < (PROBE_DOUBLE == 7 ? 2 : 1); ++rp) pg8::gemm_phase<pg8::EpiSplit<2>, pg8::StaticOrder, PG8_ALIGN, PG8_SP2, STREAM_F16 != 0>(lds, g, S, E); }
        GSYNCN(9);
        RETID();
        { pg8::Gemm g{(const bf16*)(ws + WS_H), (const bf16*)(ws + WS_F2) + (size_t)layer * FF * DM, M, DM, FF}; pg8::StaticOrder S; S.init(M, DM, G, bx);
          pg8::EpiRes<false> E{nullptr, XN, DM, SSM, SSF}; pg8::gemm_phase<pg8::EpiRes<false>, pg8::StaticOrder, EPIRES_ALIGN, PG8_SP2>(lds, g, S, E); }
        GSYNCN(10);
    }
    RETID();
    { f32x4 gv[4];
#pragma unroll
      for (int j = 0; j < 4; ++j) gv[j] = *((const f32x4*)in.gfin + lane + 64 * j);
      for (int m = gw; m < M; m += NGW) { const v2u* xr = (const v2u*)(XN + (size_t)m * DM) + lane; f32x4 v[4]; float s = 0.f;
#pragma unroll
          for (int j = 0; j < 4; ++j) { const v2u w = xr[64 * j]; v[j].x = pg8::st_lo(w.x); v[j].y = pg8::st_hi(w.x); v[j].z = pg8::st_lo(w.y); v[j].w = pg8::st_hi(w.y);
              s += (v[j].x * v[j].x + v[j].y * v[j].y) + (v[j].z * v[j].z + v[j].w * v[j].w); }
          const float rstd = 1.0f / sqrtf(wave_sum(s) * (1.f / DM) + RMS_EPS); f32x4* orow = (f32x4*)(out + (size_t)m * DM) + lane;
#pragma unroll
          for (int j = 0; j < 4; ++j) orow[64 * j] = v[j] * rstd * gv[j]; } }
    if (PROBE_T && bx == 0 && threadIdx.x == 0) { const unsigned long long t0_ = __builtin_amdgcn_s_memrealtime(), w_ = 10ull * tacc[0]; while (__builtin_amdgcn_s_memrealtime() - t0_ < w_) __builtin_amdgcn_s_sleep(8); }
}

extern "C" void kernel_launch(void* const* d_in, const int* in_sizes, int n_in, void* d_out, int out_size, void* d_ws, size_t ws_size, hipStream_t stream) {
    static int grid = 0;
    if (grid == 0) {
        if (n_in != 11 || in_sizes[0] != M * DM || out_size != M * DM || ws_size < WS_END) { fprintf(stderr, "kernel_launch: unexpected shapes (n_in %d, ws %zu)\n", n_in, ws_size); grid = -1; return; }
        if (hipFuncSetAttribute((const void*)fwd_mk, hipFuncAttributeMaxDynamicSharedMemorySize, LDS_BYTES) != hipSuccess) { fprintf(stderr, "kernel_launch: hipFuncSetAttribute failed\n"); grid = -1; return; }
        int dev = 0, cus = 0, per_cu = 0;
        hipGetDevice(&dev); hipDeviceGetAttribute(&cus, hipDeviceAttributeMultiprocessorCount, dev);
        hipOccupancyMaxActiveBlocksPerMultiprocessor(&per_cu, (const void*)fwd_mk, NWAVES * 64, LDS_BYTES);
        (void)hipGetLastError();
        if (per_cu < 1) per_cu = 1;
        grid = cus;
        if (grid != 256) { fprintf(stderr, "kernel_launch: built for a 256-CU device, found %d\n", cus); grid = -1; return; }
    }
    if (grid < 0) return;
    if (hipMemsetAsync(d_ws, 0, 16384, stream) != hipSuccess) { fprintf(stderr, "kernel_launch: memset failed\n"); return; }
    Args a{};
    for (int i = 0; i < 11; ++i) a.in[i] = (const float*)d_in[i];
    a.out = (float*)d_out; a.ws = (unsigned char*)d_ws;
    void* kargs[] = {&a};
    hipError_t e = hipLaunchCooperativeKernel((const void*)fwd_mk, dim3(grid), dim3(NWAVES * 64), kargs, LDS_BYTES, stream);
    if (e != hipSuccess) fprintf(stderr, "cooperative launch failed: %s (grid %d)\n", hipGetErrorString(e), grid);
}
```
